# Optimizing an MI355X kernel written in HIP

```python
import math
import jax, jax.numpy as jnp
from jax import lax
import numpy as np

D_MODEL = 1024
BATCH = 8
SEQ = 8192
DEPTH = 1

DIFF_HEADS = 4
DIFF_HEAD_DIM = 64
DIFF_VAL_DIM = 2 * DIFF_HEAD_DIM
RET_HEADS = 4
RET_KEY_DIM = 64
RET_VAL_DIM = 128
D_FF = 256 * ((8 * D_MODEL // 3 + 255) // 256)
CONV_WIDTH = 3
Q_BLOCK = 128
RET_CHUNK = 128
NORM_EPS = 1e-6
SUBLN_EPS = 1e-5

SPLIT_SIZES = (
    DIFF_HEADS * DIFF_HEAD_DIM,
    DIFF_HEADS * DIFF_HEAD_DIM,
    DIFF_HEADS * DIFF_HEAD_DIM,
    DIFF_HEADS * DIFF_HEAD_DIM,
    DIFF_HEADS * DIFF_VAL_DIM,
    RET_HEADS * RET_KEY_DIM,
    RET_HEADS * RET_KEY_DIM,
    RET_HEADS * RET_VAL_DIM,
    RET_HEADS * RET_VAL_DIM,
    D_MODEL,
    D_MODEL,
)
D_IN = sum(SPLIT_SIZES)

kernel_name = 'hybrid_diffattn_retention_convffn'


def _rms(x, eps):
    xf = x.astype(jnp.float32)
    return xf * lax.rsqrt(jnp.mean(xf * xf, axis=-1, keepdims=True) + eps)


def rms_norm(x, g, eps=NORM_EPS):
    return (_rms(x, eps) * g.astype(jnp.float32)).astype(x.dtype)


def diff_attention(q1, q2, k1, k2, v, lam):
    B, S, H, d = q1.shape
    dv = v.shape[-1]
    nb = S // Q_BLOCK
    scale = d ** -0.5
    slopes = 2.0 ** (-8.0 * (jnp.arange(H, dtype=jnp.float32) + 1.0) / H)
    tk = jnp.arange(S)
    k1f, k2f, vf = k1.astype(jnp.float32), k2.astype(jnp.float32), v.astype(jnp.float32)

    def block(args):
        q1b, q2b, i = args
        tq = i * Q_BLOCK + jnp.arange(Q_BLOCK)
        dist = (tq[:, None] - tk[None, :]).astype(jnp.float32)
        bias = jnp.where(dist >= 0, -slopes[:, None, None] * dist, -jnp.inf)
        s1 = jnp.einsum('bqhd,bkhd->bhqk', q1b.astype(jnp.float32), k1f) * scale + bias
        s2 = jnp.einsum('bqhd,bkhd->bhqk', q2b.astype(jnp.float32), k2f) * scale + bias
        a = jax.nn.softmax(s1, axis=-1) - lam * jax.nn.softmax(s2, axis=-1)
        return jnp.einsum('bhqk,bkhe->bqhe', a, vf)

    q1b = q1.reshape(B, nb, Q_BLOCK, H, d).transpose(1, 0, 2, 3, 4)
    q2b = q2.reshape(B, nb, Q_BLOCK, H, d).transpose(1, 0, 2, 3, 4)
    out = lax.map(block, (q1b, q2b, jnp.arange(nb)))
    return out.transpose(1, 0, 2, 3, 4).reshape(B, S, H, dv)


def retention(q, k, v):
    B, S, H, dk = q.shape
    dv = v.shape[-1]
    C = RET_CHUNK
    nc = S // C
    gammas = 1.0 - 2.0 ** (-5.0 - jnp.arange(H, dtype=jnp.float32))
    log_g = jnp.log(gammas)
    idx = jnp.arange(C, dtype=jnp.float32)
    rel = idx[:, None] - idx[None, :]
    inner_decay = jnp.where(rel >= 0, jnp.exp(log_g[:, None, None] * jnp.maximum(rel, 0.0)), 0.0)
    q_decay = jnp.exp(log_g[:, None] * (idx + 1.0))[..., None]
    k_decay = jnp.exp(log_g[:, None] * (C - 1.0 - idx))[..., None]
    chunk_decay = jnp.exp(log_g * C)[None, :, None, None]

    def to_chunks(t):
        return t.astype(jnp.float32).reshape(B, nc, C, H, -1).transpose(1, 0, 3, 2, 4)

    qc, kc, vc = to_chunks(q), to_chunks(k) * (dk ** -0.5), to_chunks(v)

    def step(state, inp):
        qi, ki, vi = inp
        scores = jnp.einsum('bhqd,bhkd->bhqk', qi, ki) * inner_decay
        o = jnp.einsum('bhqk,bhke->bhqe', scores, vi) + jnp.einsum('bhqd,bhde->bhqe', qi * q_decay, state)
        state = state * chunk_decay + jnp.einsum('bhkd,bhke->bhde', ki * k_decay, vi)
        return state, o

    s0 = jnp.zeros((B, H, dk, dv), jnp.float32)
    _, o = lax.scan(step, s0, (qc, kc, vc))
    return o.transpose(1, 0, 3, 2, 4).reshape(B, S, H, dv)


def causal_dwconv(u, w, b):
    K = w.shape[0]
    S = u.shape[1]
    up = jnp.pad(u, ((0, 0), (K - 1, 0), (0, 0)))
    y = b + up[:, K - 1:K - 1 + S] * w[K - 1]
    for j in range(K - 1):
        y = y + up[:, j:j + S] * w[j]
    return y


def setup_inputs(seed: int = 0) -> dict:
    key = jax.random.key(seed)
    ks = jax.random.split(key, 20)
    L, D, F = DEPTH, D_MODEL, D_FF
    nrm = lambda k, shape, fan: jax.random.normal(k, shape, jnp.float32) * (fan ** -0.5)
    gain = lambda k, shape: 1.0 + 0.02 * jax.random.normal(k, shape, jnp.float32)
    return {
        'x': jax.random.normal(ks[0], (BATCH, SEQ, D), jnp.float32),
        'g_mix': gain(ks[1], (L, D)),
        'w_in': nrm(ks[2], (L, D, D_IN), D),
        'lam_q1': 0.1 * jax.random.normal(ks[3], (L, DIFF_HEAD_DIM), jnp.float32),
        'lam_k1': 0.1 * jax.random.normal(ks[4], (L, DIFF_HEAD_DIM), jnp.float32),
        'lam_q2': 0.1 * jax.random.normal(ks[5], (L, DIFF_HEAD_DIM), jnp.float32),
        'lam_k2': 0.1 * jax.random.normal(ks[6], (L, DIFF_HEAD_DIM), jnp.float32),
        'g_diff_sub': gain(ks[7], (L, DIFF_VAL_DIM)),
        'w_diff_proj': nrm(ks[8], (L, DIFF_HEADS * DIFF_VAL_DIM, D), DIFF_HEADS * DIFF_VAL_DIM),
        'w_ret_proj': nrm(ks[9], (L, RET_HEADS * RET_VAL_DIM, D), RET_HEADS * RET_VAL_DIM),
        'w_out': nrm(ks[10], (L, D, D), D),
        'g_ffn': gain(ks[11], (L, D)),
        'w_up': nrm(ks[12], (L, D, 2 * F), D),
        'conv_w': nrm(ks[13], (L, CONV_WIDTH, 2 * F), CONV_WIDTH),
        'conv_b': 0.01 * jax.random.normal(ks[14], (L, 2 * F), jnp.float32),
        'w_down': nrm(ks[15], (L, F, D), F),
        'g_final': gain(ks[16], (D,)),
    }


def reference(x, g_mix, w_in, lam_q1, lam_k1, lam_q2, lam_k2, g_diff_sub, w_diff_proj, w_ret_proj,
              w_out, g_ffn, w_up, conv_w, conv_b, w_down, g_final):
    B, S, _ = x.shape
    dt = x.dtype
    split_idx = np.cumsum(SPLIT_SIZES)[:-1].tolist()
    for l in range(DEPTH):
        h = rms_norm(x, g_mix[l])
        proj = h @ w_in[l]
        q1, q2, k1, k2, va, qr, kr, vr, gr, gate_a, gate_r = jnp.split(proj, split_idx, axis=-1)

        lam_init = 0.8 - 0.6 * math.exp(-0.3 * l)
        lam = (jnp.exp(jnp.sum(lam_q1[l].astype(jnp.float32) * lam_k1[l].astype(jnp.float32)))
               - jnp.exp(jnp.sum(lam_q2[l].astype(jnp.float32) * lam_k2[l].astype(jnp.float32))) + lam_init)
        a = diff_attention(q1.reshape(B, S, DIFF_HEADS, DIFF_HEAD_DIM), q2.reshape(B, S, DIFF_HEADS, DIFF_HEAD_DIM),
                           k1.reshape(B, S, DIFF_HEADS, DIFF_HEAD_DIM), k2.reshape(B, S, DIFF_HEADS, DIFF_HEAD_DIM),
                           va.reshape(B, S, DIFF_HEADS, DIFF_VAL_DIM), lam)
        a = (_rms(a, SUBLN_EPS) * g_diff_sub[l].astype(jnp.float32) * (1.0 - lam_init)).reshape(B, S, -1).astype(dt)

        r = retention(qr.reshape(B, S, RET_HEADS, RET_KEY_DIM), kr.reshape(B, S, RET_HEADS, RET_KEY_DIM),
                      vr.reshape(B, S, RET_HEADS, RET_VAL_DIM))
        r = (_rms(r, SUBLN_EPS).reshape(B, S, -1) * jax.nn.silu(gr.astype(jnp.float32))).astype(dt)

        merged = jax.nn.sigmoid(gate_a) * (a @ w_diff_proj[l]) + jax.nn.sigmoid(gate_r) * (r @ w_ret_proj[l])
        x = x + merged @ w_out[l]

        h2 = rms_norm(x, g_ffn[l])
        z = causal_dwconv(h2 @ w_up[l], conv_w[l], conv_b[l])
        zg, zu = jnp.split(z, 2, axis=-1)
        x = x + (jax.nn.silu(zg) * zu) @ w_down[l]
    return rms_norm(x, g_final)
```

```cpp
#include <hip/hip_runtime.h>
#include <cstdio>
#include <cstdint>
#include <cmath>

typedef unsigned short bf16;
typedef short bf16x8 __attribute__((ext_vector_type(8)));
typedef float f32x4 __attribute__((ext_vector_type(4)));
typedef float f32x16 __attribute__((ext_vector_type(16)));
typedef unsigned u32x4 __attribute__((ext_vector_type(4)));
typedef unsigned u32x2 __attribute__((ext_vector_type(2)));

constexpr int BATCH = 8, SEQ = 8192, DM = 1024, M = BATCH * SEQ;
constexpr int NH = 4, HD = 64, DV = 128;
constexpr int DIN = 5120, PP = 4096;
constexpr int FF = 2816, FF2 = 5632;
constexpr int C_Q1 = 0, C_Q2 = 256, C_QR = 512, C_KR = 768, C_VR = 1024, C_GR = 1536, C_GA = 2048, C_GB = 3072;
constexpr float LOG2E = 1.4426950408889634f;
constexpr float C2 = 0.125f * LOG2E;
constexpr float NORM_EPS = 1e-6f, SUBLN_EPS = 1e-5f;
constexpr float LAM_INIT = 0.2f;

constexpr size_t MiB = 1u << 20;
constexpr size_t WS_CTL = 0;
constexpr size_t WS_CONV = 512 * 1024;
constexpr size_t WS_SSQ1 = 2 * MiB;
constexpr size_t WS_SSQ2 = 6 * MiB;
constexpr size_t WS_GST = 10 * MiB;
constexpr size_t WS_WIN = 20 * MiB, WS_WD = 30 * MiB, WS_WR = 31 * MiB, WS_WO = 32 * MiB, WS_WUP = 34 * MiB, WS_WDN = 45 * MiB;
constexpr size_t WS_XN = 64 * MiB;
constexpr size_t WS_PROJ = 192 * MiB;
constexpr size_t WS_KVP = 704 * MiB;
constexpr size_t WS_A = 864 * MiB, WS_R = 928 * MiB;
constexpr size_t WS_X1B = 192 * MiB;
constexpr size_t WS_G = 320 * MiB;
constexpr size_t WS_U = 672 * MiB;
constexpr size_t WS_HB = 672 * MiB;
constexpr size_t WS_END = 1024 * MiB;

__device__ __forceinline__ unsigned f2bf(float f) { unsigned u = __builtin_bit_cast(unsigned, f); return (u + 0x7fffu + ((u >> 16) & 1u)) >> 16; }
__device__ __forceinline__ unsigned pk2(float lo, float hi) { return f2bf(lo) | (f2bf(hi) << 16); }
__device__ __forceinline__ float bf2f(unsigned short b) { return __builtin_bit_cast(float, (unsigned)b << 16); }
__device__ __forceinline__ float bflo(unsigned w) { return __builtin_bit_cast(float, w << 16); }
__device__ __forceinline__ float bfhi(unsigned w) { return __builtin_bit_cast(float, w & 0xffff0000u); }
__device__ __forceinline__ float wave_sum(float v) {
#pragma unroll
    for (int o = 1; o < 64; o <<= 1) v += __shfl_xor(v, o);
    return v;
}
__device__ __forceinline__ float wave_max(float v) {
#pragma unroll
    for (int o = 1; o < 64; o <<= 1) v = fmaxf(v, __shfl_xor(v, o));
    return v;
}
__device__ __forceinline__ float sigmoidf_(float x) { return 1.f / (1.f + __expf(-x)); }
__device__ __forceinline__ float siluf_(float x) { return x / (1.f + __expf(-x)); }
__device__ __forceinline__ float alibi_sl2(int h) { return h == 0 ? 0.36067376022224085f : h == 1 ? 0.09016844005556021f : h == 2 ? 0.022542110013890053f : 0.005635527503472513f; }
__device__ __forceinline__ float ret_lg2(int h) { return h == 0 ? -0.04580368961312479f : h == 1 ? -0.02272007650008353f : h == 2 ? -0.011315313227834146f : -0.005646563141142063f; }

__device__ __forceinline__ int wt_src_col(int n, int mode) {
    if (mode == 0) return n;
    const int t = n >> 8, w = n & 255;
    return (w < 128) ? (t * 128 + w) : (FF + t * 128 + (w - 128));
}
__device__ __forceinline__ int lane_now() { int l; asm volatile("v_mbcnt_lo_u32_b32 %0, -1, 0\n\tv_mbcnt_hi_u32_b32 %0, -1, %0" : "=v"(l)); return l; }
namespace pg8 {
#define PG8_LAS __attribute__((address_space(3)))
typedef unsigned short bf16_t;
typedef short bf16x8 __attribute__((ext_vector_type(8)));
typedef float f32x4 __attribute__((ext_vector_type(4)));
typedef unsigned u32x4 __attribute__((ext_vector_type(4)));
constexpr int BM = 256, BK = 64, HALF = 128, HTB = HALF * BK * 2  , STAGE_BYTES = 8 * HTB, NXCD = 8, WGM = 8;

__host__ __device__ __forceinline__ int lds_byte(int r, int c) { const int st = (r >> 4) * 2 + (c >> 5), rr = r & 15, cc = c & 31, ob = rr * 64 + cc * 2; return st * 1024 + (ob ^ (((ob >> 9) & 1) << 5)); }
__host__ __device__ __forceinline__ void stage_rc(int b, int& R, int& C) { const int st = b / 1024, sb = b % 1024, swz = sb ^ (((sb >> 9) & 1) << 5); R = (st >> 1) * 16 + swz / 64; C = (st & 1) * 32 + (swz % 64) / 2; }
__host__ __device__ __forceinline__ int perm32(int rho) { const int n = rho >> 4, i = rho & 15; return 8 * (i >> 2) + 4 * n + (i & 3); }

struct Unit { int pm, pn, seg; };
struct Gemm { const bf16_t* A; const bf16_t* Bt; int M, N, K; const bf16_t* A2; const bf16_t* Bt2; };

struct StaticOrder {
    int nM, nN, nwg, G, c;
    __host__ __device__ void init(int M, int N, int G_, int c_) { nM = M / BM; nN = N / BM; nwg = nM * nN; G = G_; c = c_; }
    __host__ __device__ bool next(int i, Unit& u) const {
        const long L = (long)i * G + c; if (L >= nwg) return false;
        int wgid = (int)L; { const int q = nwg / NXCD, r = nwg % NXCD, xcd = wgid % NXCD, off = wgid / NXCD; wgid = (xcd < r ? xcd * (q + 1) : r * (q + 1) + (xcd - r) * q) + off; }
        const int nig = WGM * nN, gid = wgid / nig, fm = gid * WGM, gsz = (nM - fm) < WGM ? (nM - fm) : WGM;
        u.pm = fm + ((wgid % nig) % gsz); u.pn = (wgid % nig) / gsz; u.seg = 0; return true;
    }
    __device__ __forceinline__ void a_ready(const Unit&) const {}
    __device__ __forceinline__ void done(const Unit&) const {}
};

struct DualOrder {
    StaticOrder S;
    __host__ __device__ void init(int M, int N, int G_, int c_) { S.init(M, N, G_, c_); }
    __host__ __device__ bool next(int i, Unit& u) const { if (!S.next(i >> 1, u)) return false; u.seg = i & 1; return true; }
    __device__ __forceinline__ void a_ready(const Unit&) const {}
    __device__ __forceinline__ void done(const Unit&) const {}
};

typedef float f32x2 __attribute__((ext_vector_type(2))); typedef __bf16 bf16x2_t __attribute__((ext_vector_type(2)));
__device__ __forceinline__ unsigned cvt_pk_bf16(float lo, float hi) { f32x2 v = {lo, hi}; bf16x2_t b = __builtin_convertvector(v, bf16x2_t); return __builtin_bit_cast(unsigned, b); }
__device__ __forceinline__ float fast_sigmoid(float x) { return __builtin_amdgcn_rcpf(1.f + __builtin_amdgcn_exp2f(-1.4426950408889634f * x)); }
__device__ __forceinline__ u32x4 pack8(const f32x4 a, const f32x4 b) { u32x4 w; w.x = cvt_pk_bf16(a[0], a[1]); w.y = cvt_pk_bf16(a[2], a[3]); w.z = cvt_pk_bf16(b[0], b[1]); w.w = cvt_pk_bf16(b[2], b[3]); return w; }
__device__ __forceinline__ void unpack8(const u32x4 w, f32x4& a, f32x4& b) {
    a[0] = __builtin_bit_cast(float, w.x << 16); a[1] = __builtin_bit_cast(float, w.x & 0xffff0000u); a[2] = __builtin_bit_cast(float, w.y << 16); a[3] = __builtin_bit_cast(float, w.y & 0xffff0000u);
    b[0] = __builtin_bit_cast(float, w.z << 16); b[1] = __builtin_bit_cast(float, w.z & 0xffff0000u); b[2] = __builtin_bit_cast(float, w.w << 16); b[3] = __builtin_bit_cast(float, w.w & 0xffff0000u); }

__device__ __forceinline__ unsigned sig4_u8(const f32x4 v) { unsigned w = 0u;
#pragma unroll
    for (int i = 0; i < 4; ++i) { const float e = __builtin_amdgcn_exp2f(-1.4426950408889634f * v[i]); const unsigned q = (unsigned)(__builtin_amdgcn_rcpf(__builtin_fmaf(e, 1.f / 255.f, 1.f / 255.f)) + 0.5f); w |= q << (8 * i); }
    return w; }
__device__ __forceinline__ f32x4 u8x4_f32(const unsigned w) { return (f32x4){(float)(w & 255u), (float)((w >> 8) & 255u), (float)((w >> 16) & 255u), (float)(w >> 24)} * (1.f / 255.f); }
struct EpiProj {
    static constexpr bool PERM = true, AFTER_DRAIN = false, PERMA = false, PREFETCH = false, DUAL = false;
    bf16_t* P; bf16_t* KV; unsigned* KN;
    __device__ __forceinline__ void operator()(const f32x4 (&acc)[2][2][4][2], const Unit& u, int wr, int wc, int fr, int fq) const {
        const int pn = u.pn, pm = u.pm;
        if (pn >= 2 && pn < 6) {
            const size_t tile0 = ((size_t)(pm >> 5) * 4 * 128 + (size_t)((pm & 31) * 4 + wr)) * 16384;
            if (pn < 4) {
#pragma unroll
                for (int bj = 0; bj < 2; ++bj) { bf16_t* hb = KV + tile0 + (size_t)(2 * bj + (wc >> 1)) * 128 * 16384 + (pn == 3 ? 4096 : 0) + ((wc & 1) * 4 + fq) * 512 + fr * 8;
#pragma unroll
                    for (int ai = 0; ai < 2; ++ai)
#pragma unroll
                        for (int m = 0; m < 4; ++m) *(u32x4*)(hb + (size_t)ai * 2 * 16384 + m * 128) = pack8(acc[ai][bj][m][0], acc[ai][bj][m][1]); }
#pragma unroll
                for (int bj = 0; bj < 2; ++bj) { float hm = 0.f;
#pragma unroll
                    for (int ai = 0; ai < 2; ++ai)
#pragma unroll
                        for (int m = 0; m < 4; ++m) { const f32x4 a = acc[ai][bj][m][0], b = acc[ai][bj][m][1];
                            float q = (a[0] * a[0] + a[1] * a[1]) + (a[2] * a[2] + a[3] * a[3]) + (b[0] * b[0] + b[1] * b[1]) + (b[2] * b[2] + b[3] * b[3]);
                            q += __shfl_xor(q, 16); q += __shfl_xor(q, 32); hm = fmaxf(hm, q); }
                    hm = fmaxf(hm, __shfl_xor(hm, 1)); hm = fmaxf(hm, __shfl_xor(hm, 2)); hm = fmaxf(hm, __shfl_xor(hm, 4)); hm = fmaxf(hm, __shfl_xor(hm, 8));
                    if (fr == 0 && fq == 0) atomicMax(KN + ((pm >> 5) * 4 + 2 * bj + (wc >> 1)) * 2 + (pn - 2), __float_as_uint(hm * 1.01f)); }
            } else {
#pragma unroll
                for (int bj = 0; bj < 2; ++bj) { const int head = (pn - 4) * 2 + bj; const float sl = alibi_sl2(head);
                    bf16_t* hb = KV + tile0 + (size_t)head * 128 * 16384 + 8192 + wc * 2048 + fr * 32 + fq * 8;
#pragma unroll
                    for (int m = 0; m < 4; ++m) { const float sc = __builtin_amdgcn_exp2f(sl * (float)((fr + 16 * m) - 63));
#pragma unroll
                        for (int ai = 0; ai < 2; ++ai) *(u32x4*)(hb + (size_t)ai * 2 * 16384 + m * 512) = pack8(acc[ai][bj][m][0] * sc, acc[ai][bj][m][1] * sc); } }
            }
        } else {
            const int cpn = (pn < 2) ? pn : pn - 4;
            bf16_t* base = P + (size_t)(pm * BM + wr * 64 + fr) * PP + cpn * BM + wc * 32 + 8 * fq;
            if (pn >= 12) {
                unsigned char* gq = (unsigned char*)(P + (size_t)(pm * BM + wr * 64 + fr) * PP + C_GA) + (pn - 12) * 256 + wc * 64 + fq * 16;
#pragma unroll
                for (int ai = 0; ai < 2; ++ai)
#pragma unroll
                    for (int m = 0; m < 4; ++m) { u32x4 w; w.x = sig4_u8(acc[ai][0][m][0]); w.y = sig4_u8(acc[ai][0][m][1]); w.z = sig4_u8(acc[ai][1][m][0]); w.w = sig4_u8(acc[ai][1][m][1]);
                        *(u32x4*)(gq + (size_t)(ai * HALF + m * 16) * (PP * 2)) = w; }
            } else if (pn >= 10) {
#pragma unroll
                for (int ai = 0; ai < 2; ++ai)
#pragma unroll
                    for (int m = 0; m < 4; ++m)
#pragma unroll
                        for (int bj = 0; bj < 2; ++bj) { f32x4 a = acc[ai][bj][m][0], b = acc[ai][bj][m][1];
#pragma unroll
                            for (int i = 0; i < 4; ++i) { a[i] *= fast_sigmoid(a[i]); b[i] *= fast_sigmoid(b[i]); }
                            *(u32x4*)(base + (size_t)(ai * HALF + m * 16) * PP + bj * HALF) = pack8(a, b); }
            } else {
            const float sc = (pn < 2) ? C2 : (pn == 7) ? 0.125f : 1.f;
#pragma unroll
            for (int ai = 0; ai < 2; ++ai)
#pragma unroll
                for (int m = 0; m < 4; ++m)
#pragma unroll
                    for (int bj = 0; bj < 2; ++bj) *(u32x4*)(base + (size_t)(ai * HALF + m * 16) * PP + bj * HALF) = pack8(acc[ai][bj][m][0] * sc, acc[ai][bj][m][1] * sc);
            if (pn < 2) {
#pragma unroll
                for (int bj = 0; bj < 2; ++bj) { float hm = 0.f;
#pragma unroll
                    for (int ai = 0; ai < 2; ++ai)
#pragma unroll
                        for (int m = 0; m < 4; ++m) { const f32x4 a = acc[ai][bj][m][0], b = acc[ai][bj][m][1];
                            float q = (a[0] * a[0] + a[1] * a[1]) + (a[2] * a[2] + a[3] * a[3]) + (b[0] * b[0] + b[1] * b[1]) + (b[2] * b[2] + b[3] * b[3]);
                            q += __shfl_xor(q, 16); q += __shfl_xor(q, 32); hm = fmaxf(hm, q); }
                    hm = fmaxf(hm, __shfl_xor(hm, 1)); hm = fmaxf(hm, __shfl_xor(hm, 2)); hm = fmaxf(hm, __shfl_xor(hm, 4)); hm = fmaxf(hm, __shfl_xor(hm, 8));
                    if (fr == 0 && fq == 0) atomicMax(KN + 64 + ((pm >> 5) * 4 + 2 * bj + (wc >> 1)) * 2 + pn, __float_as_uint(hm * (C2 * C2) * 1.01f)); }
            }
            }
        }
    }
};
struct EpiMerge2 {
    static constexpr bool PERM = true, AFTER_DRAIN = false, PERMA = false, PREFETCH = false, DUAL = true;
    const bf16_t* P; bf16_t* MG;
    static __device__ __forceinline__ f32x4 u8f(const unsigned w) { return (f32x4){(float)(w & 255u), (float)((w >> 8) & 255u), (float)((w >> 16) & 255u), (float)(w >> 24)}; }
    static __device__ __forceinline__ f32x4 max1(const f32x4 v) { return (f32x4){fmaxf(v[0], 1.f), fmaxf(v[1], 1.f), fmaxf(v[2], 1.f), fmaxf(v[3], 1.f)}; }
    __device__ __forceinline__ void mid(f32x4 (&acc)[2][2][4][2], const Unit& u, int wr, int wc, int fr, int fq) const {
        const unsigned char* gq = (const unsigned char*)(P + (size_t)(u.pm * BM + wr * 64 + fr) * PP + C_GA) + u.pn * 256 + wc * 64 + fq * 16;
#pragma unroll
        for (int ai = 0; ai < 2; ++ai)
#pragma unroll
            for (int m = 0; m < 4; ++m) { const u32x4 wa = *(const u32x4*)(gq + (size_t)(ai * HALF + m * 16) * (PP * 2)), wq = *(const u32x4*)(gq + 1024 + (size_t)(ai * HALF + m * 16) * (PP * 2));
#pragma unroll
                for (int bj = 0; bj < 2; ++bj)
#pragma unroll
                    for (int n = 0; n < 2; ++n) { const unsigned da = bj ? (n ? wa.w : wa.z) : (n ? wa.y : wa.x), dr = bj ? (n ? wq.w : wq.z) : (n ? wq.y : wq.x);
                        const f32x4 qa = u8f(da), qr = max1(u8f(dr));
#pragma unroll
                        for (int i = 0; i < 4; ++i) acc[ai][bj][m][n][i] *= qa[i] * __builtin_amdgcn_rcpf(qr[i]); } }
    }
    __device__ __forceinline__ void operator()(const f32x4 (&acc)[2][2][4][2], const Unit& u, int wr, int wc, int fr, int fq) const {
        const int row0 = u.pm * BM + wr * 64 + fr, col0 = u.pn * BM + wc * 32 + 8 * fq;
        const unsigned char* gq = (const unsigned char*)(P + (size_t)row0 * PP + C_GA) + 1024 + u.pn * 256 + wc * 64 + fq * 16;
#pragma unroll
        for (int ai = 0; ai < 2; ++ai)
#pragma unroll
            for (int m = 0; m < 4; ++m) { const int row = row0 + ai * HALF + m * 16;
                const u32x4 wq = *(const u32x4*)(gq + (size_t)(ai * HALF + m * 16) * (PP * 2));
#pragma unroll
                for (int bj = 0; bj < 2; ++bj) { const f32x4 s0 = max1(u8f(bj ? wq.z : wq.x)) * (1.f / 255.f), s1 = max1(u8f(bj ? wq.w : wq.y)) * (1.f / 255.f);
                    *(u32x4*)(MG + (size_t)row * DM + col0 + bj * HALF) = pack8(acc[ai][bj][m][0] * s0, acc[ai][bj][m][1] * s1); } }
    }
};
__device__ __forceinline__ void store_ssq(float* SSQ, float a, float b, int row0, int slot, int fq) {
    const int ra = row0 + (fq >> 1) * HALF + (fq & 1) * 32;
    SSQ[(size_t)ra * 16 + slot] = a; SSQ[(size_t)(ra + 16) * 16 + slot] = b;
}
struct EpiOutProj {
    static constexpr bool PERM = true, AFTER_DRAIN = false, PERMA = false, PREFETCH = false, DUAL = false;
    const float* X; bf16_t* X1B; float* SSQ;
    __device__ __forceinline__ void operator()(const f32x4 (&acc)[2][2][4][2], const Unit& u, int wr, int wc, int fr, int fq) const {
        const int row0 = u.pm * BM + wr * 64 + fr, col0 = u.pn * BM + wc * 32 + 8 * fq;
        float sa = 0.f, sb = 0.f;
#pragma unroll
        for (int ai = 0; ai < 2; ++ai)
#pragma unroll
            for (int m = 0; m < 4; ++m) { const int row = row0 + ai * HALF + m * 16; float s = 0.f;
#pragma unroll
                for (int bj = 0; bj < 2; ++bj) { const size_t off = (size_t)row * DM + col0 + bj * HALF;
                    const f32x4 v0 = *(const f32x4*)(X + off) + acc[ai][bj][m][0], v1 = *(const f32x4*)(X + off + 4) + acc[ai][bj][m][1];
                    *(u32x4*)(X1B + off) = pack8(v0, v1);
                    s += (v0[0] * v0[0] + v0[1] * v0[1]) + (v0[2] * v0[2] + v0[3] * v0[3]) + (v1[0] * v1[0] + v1[1] * v1[1]) + (v1[2] * v1[2] + v1[3] * v1[3]); }
                s += __shfl_xor(s, 16); s += __shfl_xor(s, 32); if (((ai * 4 + m) >> 1) == fq) { if (m & 1) sb = s; else sa = s; } }
        store_ssq(SSQ, sa, sb, row0, u.pn * 4 + wc, fq);
    }
};
__device__ __forceinline__ float dpp_shr1(float x) { return __builtin_bit_cast(float, __builtin_amdgcn_update_dpp(0, __builtin_bit_cast(int, x), 0x111, 0xf, 0xf, true)); }
__device__ __forceinline__ f32x4 row_shr1(const f32x4 v) {
    const float a = v[0], b = v[1], c = v[2], d = v[3];
    return (f32x4){dpp_shr1(a), dpp_shr1(b), dpp_shr1(c), dpp_shr1(d)};
}
struct EpiUpConv {
    static constexpr bool PERM = true, AFTER_DRAIN = false, PERMA = true, PREFETCH = true, DUAL = false;
    const float* SSQ; bf16_t* G; float* HB; const float* cw; const float* cb; PG8_LAS float* halo;
    __device__ __forceinline__ void prefetch(const Unit& u, int ui, int wid, int lane) const {
        const int fr = lane & 15, fq = lane >> 4;
#pragma unroll
        for (int i = 0; i < 2; ++i) { const int k = 2 * wid + i;
            __builtin_amdgcn_global_load_lds((const unsigned*)(SSQ + (size_t)(u.pm * BM + (k >> 3) * 128 + fr * 8 + (k & 7)) * 16 + 4 * fq), (PG8_LAS unsigned*)(halo + 2560 + k * 256), 16, 0, 0); }
        const int w = wid & 3, row = 2 * w + (lane >> 5), c = (lane & 31) * 4, gcb = u.pn * HALF;
        const float* src = (row < 6) ? cw + (row >> 1) * FF2 + (row & 1) * FF + gcb + c : cb + (row & 1) * FF + gcb + c;
        __builtin_amdgcn_global_load_lds((const unsigned*)src, (PG8_LAS unsigned*)(halo + 512 + (ui & 1) * 1024 + w * 256), 16, 0, 0);
    }
    __device__ __forceinline__ void operator()(f32x4 (&acc)[2][2][4][2], const Unit& u, int wr, int wc, int fr, int fq, int ui) const {
        const int pn = u.pn, pm = u.pm, tok0 = pm * BM + wr * 128 + fr * 8, cl = wc * 32 + 8 * fq;
        const bool seq_start = (pm & 31) == 0;
        PG8_LAS float* wt = halo + 512 + (ui & 1) * 1024;
#pragma unroll
        for (int ai = 0; ai < 2; ++ai)
#pragma unroll
            for (int m = 0; m < 4; ++m) { const f32x4 a = *(const PG8_LAS f32x4*)(halo + 2560 + ((wr * 8 + 4 * ai + m) * 64 + fq * 16 + fr) * 4);
                float sq = (a[0] + a[1]) + (a[2] + a[3]); sq += __shfl_xor(sq, 16); sq += __shfl_xor(sq, 32);
                const float r = rsqrtf(sq * (1.f / DM) + NORM_EPS);
#pragma unroll
                for (int bj = 0; bj < 2; ++bj)
#pragma unroll
                    for (int n = 0; n < 2; ++n) acc[ai][bj][m][n] = acc[ai][bj][m][n] * r; }
        if (fr == 15) {
#pragma unroll
            for (int bj = 0; bj < 2; ++bj)
#pragma unroll
                for (int n = 0; n < 2; ++n)
#pragma unroll
                    for (int q = 0; q < 2; ++q) { const f32x4 v = acc[1][bj][2 + q][n];
                        if (wr == 0) *(PG8_LAS f32x4*)(halo + q * 256 + bj * HALF + cl + 4 * n) = v;
                        else *(f32x4*)(HB + ((size_t)pm * 4 + 2 + q) * FF2 + pn * BM + bj * HALF + cl + 4 * n) = v; }
        }
        if (fr == 0 && wr == 0) {
#pragma unroll
            for (int bj = 0; bj < 2; ++bj)
#pragma unroll
                for (int n = 0; n < 2; ++n)
#pragma unroll
                    for (int q = 0; q < 2; ++q) *(f32x4*)(HB + ((size_t)pm * 4 + q) * FF2 + pn * BM + bj * HALF + cl + 4 * n) = acc[0][bj][q][n];
        }
        asm volatile("s_waitcnt lgkmcnt(0)\n\ts_barrier" ::: "memory");
        const int gc = pn * HALF + cl;
        const float hk = (wr == 1 && fr == 0) ? 1.f : 0.f;
#pragma unroll
        for (int jh = 0; jh < 2; ++jh) {
            u32x2 gpk[4];
#pragma unroll
            for (int n = 0; n < 2; ++n) {
                f32x4 g6 = {}, g7 = {}, u6 = {}, u7 = {};
                if (jh == 0) {
                    g6 = row_shr1(acc[1][0][2][n]); g7 = row_shr1(acc[1][0][3][n]); u6 = row_shr1(acc[1][1][2][n]); u7 = row_shr1(acc[1][1][3][n]);
                    g6 = g6 + *(const PG8_LAS f32x4*)(halo + cl + 4 * n) * hk; g7 = g7 + *(const PG8_LAS f32x4*)(halo + 256 + cl + 4 * n) * hk;
                    u6 = u6 + *(const PG8_LAS f32x4*)(halo + HALF + cl + 4 * n) * hk; u7 = u7 + *(const PG8_LAS f32x4*)(halo + 256 + HALF + cl + 4 * n) * hk;
                }
                const f32x4 wg0 = *(const PG8_LAS f32x4*)(wt + 0 * 128 + cl + 4 * n), wg1 = *(const PG8_LAS f32x4*)(wt + 2 * 128 + cl + 4 * n), wg2 = *(const PG8_LAS f32x4*)(wt + 4 * 128 + cl + 4 * n), bg = *(const PG8_LAS f32x4*)(wt + 6 * 128 + cl + 4 * n);
                const f32x4 wu0 = *(const PG8_LAS f32x4*)(wt + 1 * 128 + cl + 4 * n), wu1 = *(const PG8_LAS f32x4*)(wt + 3 * 128 + cl + 4 * n), wu2 = *(const PG8_LAS f32x4*)(wt + 5 * 128 + cl + 4 * n), bu = *(const PG8_LAS f32x4*)(wt + 7 * 128 + cl + 4 * n);
#pragma unroll
                for (int jj = 0; jj < 4; ++jj) { const int j = 4 * jh + jj;
                    const f32x4 vg = acc[j >> 2][0][j & 3][n], vu = acc[j >> 2][1][j & 3][n];
                    const int j1 = (j >= 1) ? j - 1 : 0, j2 = (j >= 2) ? j - 2 : 0;
                    const f32x4 pg1 = (j >= 1) ? acc[j1 >> 2][0][j1 & 3][n] : g7, pg2 = (j >= 2) ? acc[j2 >> 2][0][j2 & 3][n] : (j == 1 ? g7 : g6);
                    const f32x4 pu1 = (j >= 1) ? acc[j1 >> 2][1][j1 & 3][n] : u7, pu2 = (j >= 2) ? acc[j2 >> 2][1][j2 & 3][n] : (j == 1 ? u7 : u6);
                    f32x4 zg = bg + wg2 * vg + wg1 * pg1 + wg0 * pg2; asm volatile("" : "+v"(zg));
                    f32x4 zu = bu + wu2 * vu + wu1 * pu1 + wu0 * pu2; asm volatile("" : "+v"(zu));
                    f32x4 r;
#pragma unroll
                    for (int i = 0; i < 4; ++i) r[i] = (zg[i] * zu[i]) * __builtin_amdgcn_rcpf(1.f + __builtin_amdgcn_exp2f(zg[i]));
                    u32x2 w; w.x = cvt_pk_bf16(r[0], r[1]); w.y = cvt_pk_bf16(r[2], r[3]);
                    const bool skip = (wr == 0) && (fr == 0) && (j < 2) && !seq_start;
                    if (n == 0) { gpk[jj] = w; asm volatile("" : "+v"(gpk[jj].x), "+v"(gpk[jj].y)); }
                    else if (!skip) *(u32x4*)(G + (size_t)(tok0 + j) * FF + gc) = (u32x4){gpk[jj].x, gpk[jj].y, w.x, w.y};
                }
                __builtin_amdgcn_sched_barrier(0);
            }
        }
    }
};
struct EpiDown {
    static constexpr bool PERM = true, AFTER_DRAIN = false, PERMA = false, PREFETCH = false, DUAL = false;
    const bf16_t* X1B; bf16_t* X2B; float* SSQ;
    __device__ __forceinline__ void operator()(const f32x4 (&acc)[2][2][4][2], const Unit& u, int wr, int wc, int fr, int fq) const {
        const int row0 = u.pm * BM + wr * 64 + fr, col0 = u.pn * BM + wc * 32 + 8 * fq;
        float sa = 0.f, sb = 0.f;
#pragma unroll
        for (int ai = 0; ai < 2; ++ai)
#pragma unroll
            for (int m = 0; m < 4; ++m) { const int row = row0 + ai * HALF + m * 16; float s = 0.f;
#pragma unroll
                for (int bj = 0; bj < 2; ++bj) { const size_t off = (size_t)row * DM + col0 + bj * HALF;
                    f32x4 v0, v1; unpack8(*(const u32x4*)(X1B + off), v0, v1); v0 = v0 + acc[ai][bj][m][0]; v1 = v1 + acc[ai][bj][m][1];
                    *(u32x4*)(X2B + off) = pack8(v0, v1);
                    s += (v0[0] * v0[0] + v0[1] * v0[1]) + (v0[2] * v0[2] + v0[3] * v0[3]) + (v1[0] * v1[0] + v1[1] * v1[1]) + (v1[2] * v1[2] + v1[3] * v1[3]); }
                s += __shfl_xor(s, 16); s += __shfl_xor(s, 32); if (((ai * 4 + m) >> 1) == fq) { if (m & 1) sb = s; else sa = s; } }
        store_ssq(SSQ, sa, sb, row0, u.pn * 4 + wc, fq);
    }
};
template <class Epi, class Sched, bool ALIGN_EPI = false, bool SP2 = false>
__device__ __forceinline__ void gemm_phase(PG8_LAS unsigned char* lds, const Gemm g, const Sched& S, const Epi& E, const int wid) {
    const int lane = lane_now(), tid = wid * 64 + lane, wr = wid >> 2, wc = wid & 3, fr = lane & 15, fq = lane >> 4;
    const int K = g.K, nt = K / BK;
    unsigned voffA[2], voffB[2];
#pragma unroll
    for (int i = 0; i < 2; ++i) { int R, C; stage_rc(tid * 16 + i * 8192, R, C); const int Rb = Epi::PERM ? ((R & ~31) + perm32(R & 31)) : R;
        const int Ra = Epi::PERMA ? (128 * ((R >> 6) & 1) + 8 * (R & 15) + ((R >> 4) & 3)) : R;
        voffA[i] = (unsigned)(Ra * K + C) * 2u; voffB[i] = (unsigned)(Rb * K + C) * 2u; }
    const size_t kstep = (size_t)(BK * 2);
    const size_t hstep = (size_t)HALF * K * 2;
    const size_t tstep = 2 * hstep;
    const size_t hstepA = Epi::PERMA ? (size_t)4 * K * 2 : hstep;
    const unsigned ldsw = (unsigned)wid * 1024u;
    const int aoff = lds_byte(wr * 64 + fr, fq * 8), boff = lds_byte(wc * 32 + fr, fq * 8);
#define PG8_SA(b, h) (((b) * 2 + (h)) * HTB)
#define PG8_SB(b, h) ((4 + (b) * 2 + (h)) * HTB)
#define PG8_STAGE(bufoff, gbase, voff) do { _Pragma("unroll") for (int _i = 0; _i < 2; ++_i) \
        __builtin_amdgcn_global_load_lds((const unsigned*)((const char*)(gbase) + (voff)[_i]), (PG8_LAS unsigned*)(lds + (bufoff) + ldsw + _i * 8192), 16, 0, 0); } while (0)
#define PG8_LDA(dst, b, h) do { _Pragma("unroll") for (int m = 0; m < 4; ++m) _Pragma("unroll") for (int k = 0; k < 2; ++k) dst[m][k] = *(const PG8_LAS bf16x8*)(lds + PG8_SA(b, h) + aoff + m * 2048 + k * 1024); } while (0)
#define PG8_LDB(dst, b, h) do { _Pragma("unroll") for (int n = 0; n < 2; ++n) _Pragma("unroll") for (int k = 0; k < 2; ++k) dst[n][k] = *(const PG8_LAS bf16x8*)(lds + PG8_SB(b, h) + boff + n * 2048 + k * 1024); } while (0)
#define PG8_MMA(ai, bj, At, Bt) do { __builtin_amdgcn_s_setprio(1); _Pragma("unroll") for (int m = 0; m < 4; ++m) _Pragma("unroll") for (int n = 0; n < 2; ++n) _Pragma("unroll") for (int k = 0; k < 2; ++k) \
        acc[ai][bj][m][n] = __builtin_amdgcn_mfma_f32_16x16x32_bf16(Bt[n][k], At[m][k], acc[ai][bj][m][n], 0, 0, 0); __builtin_amdgcn_s_setprio(0); } while (0)
#define PG8_WAIT_V(n) asm volatile("s_waitcnt vmcnt(" #n ")" ::: "memory")
#define PG8_WAIT_L(n) asm volatile("s_waitcnt lgkmcnt(" #n ")" ::: "memory")
#define PG8_BAR __builtin_amdgcn_s_barrier()
#define PG8_SCHED __builtin_amdgcn_sched_barrier(0)
    Unit cur, nxt; int ui = 0;
    if (!S.next(0, cur)) return;
    f32x4 acc[2][2][4][2];
#pragma unroll
    for (int a = 0; a < 2; ++a)
#pragma unroll
        for (int b = 0; b < 2; ++b)
#pragma unroll
            for (int m = 0; m < 4; ++m)
#pragma unroll
                for (int n = 0; n < 2; ++n) acc[a][b][m][n] = (f32x4){0.f, 0.f, 0.f, 0.f};
    bf16x8 At[4][2], B0[2][2], B1[2][2];
    const char* cA = (const char*)((Epi::DUAL && cur.seg) ? g.A2 : g.A) + (size_t)cur.pm * tstep; const char* cB = (const char*)((Epi::DUAL && cur.seg) ? g.Bt2 : g.Bt) + (size_t)cur.pn * tstep;
    S.a_ready(cur);
    if constexpr (Epi::PREFETCH) E.prefetch(cur, 0, wid, lane);
    if constexpr (SP2) {
        PG8_STAGE(PG8_SB(0, 0), cB, voffB); PG8_STAGE(PG8_SB(0, 1), cB + hstep, voffB); PG8_STAGE(PG8_SA(0, 0), cA, voffA); PG8_STAGE(PG8_SA(0, 1), cA + hstepA, voffA);
        if (wr == 1) PG8_BAR;
        PG8_WAIT_V(2); PG8_BAR;
        PG8_STAGE(PG8_SB(1, 0), cB + kstep, voffB); PG8_STAGE(PG8_SA(1, 0), cA + kstep, voffA); PG8_STAGE(PG8_SB(1, 1), cB + hstep + kstep, voffB);
        PG8_WAIT_V(6); PG8_BAR;
    } else {
        PG8_STAGE(PG8_SB(0, 0), cB, voffB); PG8_STAGE(PG8_SA(0, 0), cA, voffA); PG8_STAGE(PG8_SB(0, 1), cB + hstep, voffB); PG8_STAGE(PG8_SA(0, 1), cA + hstepA, voffA);
        if (wr == 1) PG8_BAR;
        PG8_WAIT_V(4); PG8_BAR;
        PG8_STAGE(PG8_SB(1, 0), cB + kstep, voffB); PG8_STAGE(PG8_SA(1, 0), cA + kstep, voffA); PG8_STAGE(PG8_SB(1, 1), cB + hstep + kstep, voffB);
        PG8_WAIT_V(6); PG8_BAR;
    }
    for (;;) {
        const bool has_next = S.next(ui + 1, nxt);
        const char* nA = has_next ? (const char*)((Epi::DUAL && nxt.seg) ? g.A2 : g.A) + (size_t)nxt.pm * tstep : cA; const char* nB = has_next ? (const char*)((Epi::DUAL && nxt.seg) ? g.Bt2 : g.Bt) + (size_t)nxt.pn * tstep : cB;
        for (int t = 0; t < nt; t += 2) {
            const bool last = (t == nt - 2);
            const char* a1 = cA + (size_t)(t + 1) * kstep;
            const char* a2 = last ? nA : cA + (size_t)(t + 2) * kstep; const char* b2 = last ? nB : cB + (size_t)(t + 2) * kstep;
            const char* a3 = a2 + kstep; const char* b3 = b2 + kstep;
            if (last && has_next) S.a_ready(nxt);
            if constexpr (SP2) {
            PG8_LDB(B0, 0, 0); PG8_LDB(B1, 0, 1); PG8_SCHED; PG8_LDA(At, 0, 0); PG8_STAGE(PG8_SA(1, 1), a1 + hstepA, voffA);
            PG8_WAIT_V(8); PG8_WAIT_L(0); PG8_BAR; PG8_MMA(0, 0, At, B0); PG8_MMA(0, 1, At, B1); PG8_BAR; PG8_SCHED;
            PG8_LDA(At, 0, 1); PG8_STAGE(PG8_SB(0, 0), b2, voffB); PG8_STAGE(PG8_SB(0, 1), b2 + hstep, voffB); PG8_STAGE(PG8_SA(0, 0), a2, voffA);
            PG8_WAIT_V(8); PG8_WAIT_L(0); PG8_BAR; PG8_MMA(1, 0, At, B0); PG8_MMA(1, 1, At, B1); PG8_BAR; PG8_SCHED;
            PG8_LDB(B0, 1, 0); PG8_LDB(B1, 1, 1); PG8_SCHED; PG8_LDA(At, 1, 0); PG8_STAGE(PG8_SA(0, 1), a2 + hstepA, voffA);
            PG8_WAIT_V(8); PG8_WAIT_L(0); PG8_BAR; PG8_MMA(0, 0, At, B0); PG8_MMA(0, 1, At, B1); PG8_BAR; PG8_SCHED;
            PG8_LDA(At, 1, 1); PG8_STAGE(PG8_SB(1, 0), b3, voffB); PG8_STAGE(PG8_SB(1, 1), b3 + hstep, voffB); PG8_STAGE(PG8_SA(1, 0), a3, voffA);
            PG8_WAIT_V(8); PG8_WAIT_L(0); PG8_BAR; PG8_MMA(1, 0, At, B0); PG8_MMA(1, 1, At, B1); PG8_BAR; PG8_SCHED;
            } else {
            PG8_LDB(B0, 0, 0); PG8_SCHED; PG8_LDA(At, 0, 0); PG8_STAGE(PG8_SA(1, 1), a1 + hstepA, voffA);
            PG8_WAIT_L(8); PG8_BAR; PG8_WAIT_L(0); PG8_MMA(0, 0, At, B0); PG8_BAR; PG8_SCHED;
            PG8_LDB(B1, 0, 1); PG8_STAGE(PG8_SB(0, 0), b2, voffB);
            PG8_BAR; PG8_WAIT_L(0); PG8_MMA(0, 1, At, B1); PG8_BAR;
            PG8_LDA(At, 0, 1); PG8_STAGE(PG8_SA(0, 0), a2, voffA);
            PG8_BAR; PG8_WAIT_L(0); PG8_MMA(1, 0, At, B0); PG8_BAR; PG8_SCHED;
            PG8_STAGE(PG8_SB(0, 1), b2 + hstep, voffB);
            PG8_WAIT_V(6); PG8_BAR; PG8_MMA(1, 1, At, B1); PG8_BAR;
            PG8_LDB(B0, 1, 0); PG8_SCHED; PG8_LDA(At, 1, 0); PG8_STAGE(PG8_SA(0, 1), a2 + hstepA, voffA);
            PG8_WAIT_L(8); PG8_BAR; PG8_WAIT_L(0); PG8_MMA(0, 0, At, B0); PG8_BAR; PG8_SCHED;
            PG8_LDB(B1, 1, 1); PG8_STAGE(PG8_SB(1, 0), b3, voffB);
            PG8_BAR; PG8_WAIT_L(0); PG8_MMA(0, 1, At, B1); PG8_BAR;
            PG8_LDA(At, 1, 1); PG8_STAGE(PG8_SA(1, 0), a3, voffA);
            PG8_BAR; PG8_WAIT_L(0); PG8_MMA(1, 0, At, B0); PG8_BAR; PG8_SCHED;
            PG8_STAGE(PG8_SB(1, 1), b3 + hstep, voffB);
            PG8_WAIT_V(6); PG8_BAR; PG8_MMA(1, 1, At, B1); PG8_BAR;
            }
        }
        if constexpr (ALIGN_EPI) { if (wr == 0) PG8_BAR; }
        if constexpr (!Epi::AFTER_DRAIN) { if constexpr (Epi::PREFETCH) E(acc, cur, wr, wc, fr, fq, ui); else if constexpr (Epi::DUAL) { if (cur.seg == 0) E.mid(acc, cur, wr, wc, fr, fq); else E(acc, cur, wr, wc, fr, fq); } else E(acc, cur, wr, wc, fr, fq); S.done(cur); }
        if (!has_next) break;
        if (!(Epi::DUAL && cur.seg == 0))
#pragma unroll
        for (int a = 0; a < 2; ++a)
#pragma unroll
            for (int b = 0; b < 2; ++b)
#pragma unroll
                for (int m = 0; m < 4; ++m)
#pragma unroll
                    for (int n = 0; n < 2; ++n) acc[a][b][m][n] = (f32x4){0.f, 0.f, 0.f, 0.f};
        cur = nxt; cA = nA; cB = nB; ++ui;
        if constexpr (Epi::PREFETCH) E.prefetch(cur, ui, wid, lane);
        if constexpr (ALIGN_EPI) { if (wr == 1) PG8_BAR; }
    }
    PG8_WAIT_V(0);
    if constexpr (!ALIGN_EPI) { if (wr == 0) PG8_BAR; }
    PG8_BAR;
    if constexpr (Epi::AFTER_DRAIN) { E.fused(acc, cur, wr, wc, fr, fq, lds, wid, lane); S.done(cur); }
#undef PG8_SA
#undef PG8_SB
#undef PG8_STAGE
#undef PG8_LDA
#undef PG8_LDB
#undef PG8_MMA
#undef PG8_WAIT_V
#undef PG8_WAIT_L
#undef PG8_BAR
#undef PG8_SCHED
}
}

#define GAS __attribute__((address_space(1)))
#define LAS __attribute__((address_space(3)))
typedef GAS unsigned gu32;
typedef GAS unsigned long long gu64;
#define RLX_AGENT __ATOMIC_RELAXED, __HIP_MEMORY_SCOPE_AGENT
#define LDS_WAIT() asm volatile("s_waitcnt lgkmcnt(0)" ::: "memory")
#define VM_WAIT() asm volatile("s_waitcnt vmcnt(0)" ::: "memory")
#define XB_TMO      128
#define XB_XCNT(j)  (256  + 64 * (j))
#define XB_XSUB(j)  (1280 + 64 * (j))
#define XB_XGEN(j)  (2304 + 64 * (j))
#define XB_TOP      3328
#define XB_TOPGEN   3392
#define XB_LSUB(j)  (3456 + 64 * (j))
#define XB_LGEN(j)  (4480 + 64 * (j))
#define XCD_BAR_WORDS 5504
#define XB_SPIN_CAP (1u << 18)

__device__ __forceinline__ unsigned xb_ld(unsigned* p)              { return __hip_atomic_load(p, __ATOMIC_RELAXED, __HIP_MEMORY_SCOPE_AGENT); }
__device__ __forceinline__ unsigned xb_add(unsigned* p, unsigned v) { return __hip_atomic_fetch_add(p, v, __ATOMIC_RELAXED, __HIP_MEMORY_SCOPE_AGENT); }
__device__ __forceinline__ unsigned xb_xcc_id() { return (unsigned)__builtin_amdgcn_s_getreg((3 << 11) | 20) & 0xFu; }
#define XB_SPIN(cond, bar) do { unsigned _sp = 0; while (cond) { __builtin_amdgcn_s_sleep(1); \
    if ((++_sp & 255u) == 0u) { if (xb_ld(&(bar)[XB_TMO])) break; if (_sp > XB_SPIN_CAP) { atomicAdd(&(bar)[XB_TMO], 1u); break; } } } } while (0)

struct XcdBarrier {
    unsigned* bar; unsigned x; int wv;
    volatile LAS unsigned* st;
};

__device__ __forceinline__ XcdBarrier xcd_barrier_post(unsigned* bar, volatile LAS unsigned* st, int wv) {
    XcdBarrier b; b.bar = bar; b.x = xb_xcc_id(); b.st = st; b.wv = wv;
    if (wv == 0 && lane_now() == 0) (void)xb_add(&bar[XB_XCNT(b.x)], 1u);
    return b;
}
__device__ __forceinline__ void xcd_barrier_complete(unsigned* bar, unsigned x, unsigned& nloc, unsigned& nx) {
    const unsigned G = gridDim.x * gridDim.y * gridDim.z;
    unsigned sum, cnt, mine, sp = 0u;
    for (;;) {
        sum = 0u; cnt = 0u; mine = 0u;
#pragma unroll
        for (unsigned j = 0; j < 16; ++j) { const unsigned c = xb_ld(&bar[XB_XCNT(j)]); sum += c; cnt += (c > 0u) ? 1u : 0u; mine = (j == x) ? c : mine; }
        if (sum == G) break;
        __builtin_amdgcn_s_sleep(1);
        if ((++sp & 255u) == 0u) { if (xb_ld(&bar[XB_TMO])) break; if (sp > XB_SPIN_CAP) { atomicAdd(&bar[XB_TMO], 1u); break; } }
    }
    nloc = mine > 0u ? mine : 1u; nx = cnt > 0u ? cnt : 1u;
}

__device__ __forceinline__ void xcd_barrier(const XcdBarrier& b) {
    asm volatile("s_waitcnt vmcnt(0)" ::: "memory");
    __syncthreads();
    if (b.wv == 0 && lane_now() == 0) {
        unsigned* bar = b.bar;
        __builtin_amdgcn_s_waitcnt(0);
        unsigned nloc = b.st[0], nx = b.st[1];
        if (nloc == 0u) { xcd_barrier_complete(bar, b.x, nloc, nx); b.st[0] = nloc; b.st[1] = nx; }
        const unsigned old = xb_add(&bar[XB_XSUB(b.x)], 1u);
        const unsigned gen = old / nloc;
        if (old + 1u == (gen + 1u) * nloc) {
            __builtin_amdgcn_fence(__ATOMIC_RELEASE, "agent");
            asm volatile("s_waitcnt vmcnt(0)" ::: "memory");
            const unsigned og = xb_add(&bar[XB_TOP], 1u);
            const unsigned tg = og / nx;
            if (og + 1u == (tg + 1u) * nx) xb_add(&bar[XB_TOPGEN], 1u);
            else XB_SPIN(xb_ld(&bar[XB_TOPGEN]) == tg, bar);
            __builtin_amdgcn_fence(__ATOMIC_ACQUIRE, "agent");
            xb_add(&bar[XB_XGEN(b.x)], 1u);
            asm volatile("s_waitcnt vmcnt(0)" ::: "memory");
        } else {
            XB_SPIN(xb_ld(&bar[XB_XGEN(b.x)]) == gen, bar);
            __builtin_amdgcn_fence(__ATOMIC_ACQUIRE, "agent");
            asm volatile("s_waitcnt vmcnt(0)" ::: "memory");
        }
    }
    __syncthreads();
}
__device__ __forceinline__ void xcd_barrier_local(const XcdBarrier& b) {
    asm volatile("s_waitcnt vmcnt(0)" ::: "memory");
    __syncthreads();
    if (b.wv == 0 && lane_now() == 0) {
        unsigned* bar = b.bar;
        __builtin_amdgcn_s_waitcnt(0);
        const unsigned nloc = b.st[0];
        const unsigned old = xb_add(&bar[XB_LSUB(b.x)], 1u);
        const unsigned gen = old / nloc;
        if (old + 1u == (gen + 1u) * nloc) xb_add(&bar[XB_LGEN(b.x)], 1u);
        else XB_SPIN(xb_ld(&bar[XB_LGEN(b.x)]) == gen, bar);
        __builtin_amdgcn_fence(__ATOMIC_ACQUIRE, "agent");
        asm volatile("s_waitcnt vmcnt(0)" ::: "memory");
    }
    __syncthreads();
}

namespace ret {
typedef short s16x4 __attribute__((ext_vector_type(4)));
typedef short v4i16_t __attribute__((ext_vector_type(4)));
typedef LAS const unsigned char* lptr;
constexpr int QS_STRIDE = 144, KD_STRIDE = 192, VS_STRIDE = 320, OUT_STRIDE = 528;
constexpr int OFF_QS = 0, OFF_ST = 18432, OFF_KS = 36864, OFF_KD = 55296, OFF_VS = 79872, OFF_END = 120832, OFF_OUT = OFF_KS, OFF_SSQ = OFF_END;
static_assert(OFF_OUT + 128 * OUT_STRIDE <= OFF_END && OFF_SSQ + 1024 <= 131072, "retention LDS map");
__device__ __forceinline__ s16x4 vtr(lptr p) { return __builtin_bit_cast(s16x4, __builtin_amdgcn_ds_read_tr16_b64_v4i16((LAS v4i16_t*)p)); }
__device__ __forceinline__ bf16x8 cat8(const s16x4 lo, const s16x4 hi) { return (bf16x8){lo[0], lo[1], lo[2], lo[3], hi[0], hi[1], hi[2], hi[3]}; }

__device__ __forceinline__ void stage_chunk(LAS unsigned char* lds, const bf16* rowbase, int h, float lg, int tid, bool with_qk) {
#pragma unroll
    for (int i = 0; i < 2; ++i) { const int it = tid + 512 * i, row = it >> 3, ch = it & 7;
        const u32x4 k = *(const u32x4*)(rowbase + (size_t)row * PP + C_KR + h * HD + ch * 8);
        f32x4 a, b; pg8::unpack8(k, a, b); const float d = __builtin_amdgcn_exp2f(lg * (float)(127 - row));
        *(LAS u32x4*)(lds + OFF_KD + row * KD_STRIDE + ch * 16) = pg8::pack8(a * d, b * d);
        if (with_qk) { *(LAS u32x4*)(lds + OFF_KS + row * QS_STRIDE + ch * 16) = k;
            *(LAS u32x4*)(lds + OFF_QS + row * QS_STRIDE + ch * 16) = *(const u32x4*)(rowbase + (size_t)row * PP + C_QR + h * HD + ch * 8); } }
#pragma unroll
    for (int i = 0; i < 4; ++i) { const int it = tid + 512 * i, row = it >> 4, ch = it & 15;
        *(LAS u32x4*)(lds + OFF_VS + row * VS_STRIDE + ch * 16) = *(const u32x4*)(rowbase + (size_t)row * PP + C_VR + h * DV + ch * 8); }
}
__device__ __forceinline__ void state_update(f32x16& st, lptr lds, int dkb, int dvb, float gC, int lane) {
    const int hi = lane >> 5, g = (lane >> 4) & 1, qq = (lane & 15) >> 2, pp = lane & 3;
    lptr ka = lds + OFF_KD + (8 * hi + qq) * KD_STRIDE + (32 * dkb + 16 * g + 4 * pp) * 2;
    lptr va = lds + OFF_VS + (8 * hi + qq) * VS_STRIDE + (32 * dvb + 16 * g + 4 * pp) * 2;
#pragma unroll
    for (int r = 0; r < 16; ++r) st[r] *= gC;
#pragma unroll
    for (int ks = 0; ks < 8; ++ks) {
        const bf16x8 a = cat8(vtr(ka + ks * 16 * KD_STRIDE), vtr(ka + (ks * 16 + 4) * KD_STRIDE));
        const bf16x8 b = cat8(vtr(va + ks * 16 * VS_STRIDE), vtr(va + (ks * 16 + 4) * VS_STRIDE));
        st = __builtin_amdgcn_mfma_f32_32x32x16_bf16(a, b, st, 0, 0, 0);
    }
}

__device__ __forceinline__ void ret_group_state(LAS unsigned char* lds, const bf16* PROJ, float* GST, int ui, int tid) {
    const int lane = tid & 63, wave = __builtin_amdgcn_readfirstlane(tid >> 6), hi = lane >> 5;
    const int bh = ui >> 3, s = ui & 7, h = bh & 3, b = bh >> 2, dkb = wave & 1, dvb = wave >> 1;
    const float lg = ret_lg2(h), gC = __builtin_amdgcn_exp2f(lg * 128.f);
    f32x16 st = {};
    const bf16* rb0 = PROJ + ((size_t)b * SEQ + (size_t)(8 * s) * 128) * PP;
    const size_t koff0 = (size_t)(tid >> 3) * PP + C_KR + h * HD + (tid & 7) * 8, voff0 = (size_t)(tid >> 4) * PP + C_VR + h * DV + (tid & 15) * 8;
    u32x4 kk[3][2], vv[3][4];
#pragma unroll
    for (int c = 0; c < 3; ++c) { const bf16* rb = rb0 + (size_t)c * 128 * PP;
#pragma unroll
        for (int i = 0; i < 2; ++i) kk[c][i] = *(const u32x4*)(rb + koff0 + (size_t)(64 * i) * PP);
#pragma unroll
        for (int i = 0; i < 4; ++i) vv[c][i] = *(const u32x4*)(rb + voff0 + (size_t)(32 * i) * PP); }
#pragma unroll
    for (int c = 0; c < 8; ++c) { const int q = c % 3;
        __syncthreads();
#pragma unroll
        for (int i = 0; i < 2; ++i) { const int row = (tid >> 3) + 64 * i, ch = tid & 7;
            f32x4 a, bq; pg8::unpack8(kk[q][i], a, bq); const float d = __builtin_amdgcn_exp2f(lg * (float)(127 - row));
            *(LAS u32x4*)(lds + OFF_KD + row * KD_STRIDE + ch * 16) = pg8::pack8(a * d, bq * d); }
#pragma unroll
        for (int i = 0; i < 4; ++i) { const int row = (tid >> 4) + 32 * i, ch = tid & 15; *(LAS u32x4*)(lds + OFF_VS + row * VS_STRIDE + ch * 16) = vv[q][i]; }
        if (c + 3 < 8) { const bf16* rb = rb0 + (size_t)(c + 3) * 128 * PP;
#pragma unroll
            for (int i = 0; i < 2; ++i) kk[q][i] = *(const u32x4*)(rb + koff0 + (size_t)(64 * i) * PP);
#pragma unroll
            for (int i = 0; i < 4; ++i) vv[q][i] = *(const u32x4*)(rb + voff0 + (size_t)(32 * i) * PP); }
        __syncthreads();
        state_update(st, (lptr)lds, dkb, dvb, gC, lane);
    }
    float* gp = GST + (size_t)ui * (HD * DV) + (size_t)(32 * dkb) * DV + 32 * dvb + (lane & 31);
#pragma unroll
    for (int r = 0; r < 16; ++r) gp[(size_t)((r & 3) + 8 * (r >> 2) + 4 * hi) * DV] = st[r];
    __syncthreads();
}

__device__ __forceinline__ void ret_outputs(LAS unsigned char* lds, const bf16* PROJ, const float* GST, bf16* RB, int ui, int tid) {
    const int lane = tid & 63, wave = __builtin_amdgcn_readfirstlane(tid >> 6), hi = lane >> 5, l31 = lane & 31;
    const int g = (lane >> 4) & 1, qq = (lane & 15) >> 2, pp = lane & 3;
    const int bh = ui >> 3, s = ui & 7, h = bh & 3, b = bh >> 2, dkb = wave & 1, dvb = wave >> 1;
    const int qblk = wave & 3, dvh = wave >> 2;
    const float lg = ret_lg2(h), gC = __builtin_amdgcn_exp2f(lg * 128.f);
    f32x16 st = {};
    for (int sp = 0; sp < s; ++sp) {
        const float w = __builtin_amdgcn_exp2f(lg * 1024.f * (float)(s - 1 - sp));
        const float* gp = GST + (size_t)(bh * 8 + sp) * (HD * DV) + (size_t)(32 * dkb) * DV + 32 * dvb + l31;
#pragma unroll
        for (int r = 0; r < 16; ++r) st[r] += w * gp[(size_t)((r & 3) + 8 * (r >> 2) + 4 * hi) * DV];
    }
    const float qdec = __builtin_amdgcn_exp2f(lg * (float)(32 * qblk + l31 + 1));
    const bf16* rb0 = PROJ + ((size_t)b * SEQ + (size_t)(8 * s) * 128) * PP;
    const size_t qoff0 = (size_t)(tid >> 3) * PP + h * HD + (tid & 7) * 8, voff0 = (size_t)(tid >> 4) * PP + C_VR + h * DV + (tid & 15) * 8;
    u32x4 kk[2], qv[2], vv[4];
#pragma unroll
    for (int i = 0; i < 2; ++i) { kk[i] = *(const u32x4*)(rb0 + qoff0 + C_KR + (size_t)(64 * i) * PP); qv[i] = *(const u32x4*)(rb0 + qoff0 + C_QR + (size_t)(64 * i) * PP); }
#pragma unroll
    for (int i = 0; i < 4; ++i) vv[i] = *(const u32x4*)(rb0 + voff0 + (size_t)(32 * i) * PP);
    for (int c = 0; c < 8; ++c) {
        const size_t row0 = (size_t)b * SEQ + (size_t)(8 * s + c) * 128;
        __syncthreads();
#pragma unroll
        for (int gq = 0; gq < 4; ++gq) { u32x2 w; w.x = pg8::cvt_pk_bf16(st[4 * gq], st[4 * gq + 1]); w.y = pg8::cvt_pk_bf16(st[4 * gq + 2], st[4 * gq + 3]);
            *(LAS u32x2*)(lds + OFF_ST + (32 * dvb + l31) * QS_STRIDE + (32 * dkb + 8 * gq + 4 * hi) * 2) = w; }
#pragma unroll
        for (int i = 0; i < 2; ++i) { const int row = (tid >> 3) + 64 * i, ch = tid & 7;
            f32x4 a, bq; pg8::unpack8(kk[i], a, bq); const float d = __builtin_amdgcn_exp2f(lg * (float)(127 - row));
            *(LAS u32x4*)(lds + OFF_KD + row * KD_STRIDE + ch * 16) = pg8::pack8(a * d, bq * d);
            *(LAS u32x4*)(lds + OFF_KS + row * QS_STRIDE + ch * 16) = kk[i]; *(LAS u32x4*)(lds + OFF_QS + row * QS_STRIDE + ch * 16) = qv[i]; }
#pragma unroll
        for (int i = 0; i < 4; ++i) { const int row = (tid >> 4) + 32 * i, ch = tid & 15; *(LAS u32x4*)(lds + OFF_VS + row * VS_STRIDE + ch * 16) = vv[i]; }
        if (c + 1 < 8) { const bf16* rb = rb0 + (size_t)(c + 1) * 128 * PP;
#pragma unroll
            for (int i = 0; i < 2; ++i) { kk[i] = *(const u32x4*)(rb + qoff0 + C_KR + (size_t)(64 * i) * PP); qv[i] = *(const u32x4*)(rb + qoff0 + C_QR + (size_t)(64 * i) * PP); }
#pragma unroll
            for (int i = 0; i < 4; ++i) vv[i] = *(const u32x4*)(rb + voff0 + (size_t)(32 * i) * PP); }
        __syncthreads();
        bf16x8 qf[4];
#pragma unroll
        for (int d0 = 0; d0 < 4; ++d0) qf[d0] = *(const LAS bf16x8*)(lds + OFF_QS + (32 * qblk + l31) * QS_STRIDE + (16 * d0 + 8 * hi) * 2);
        f32x16 o[2];
#pragma unroll
        for (int d = 0; d < 2; ++d) { o[d] = f32x16{};
#pragma unroll
            for (int d0 = 0; d0 < 4; ++d0) { const bf16x8 a = *(const LAS bf16x8*)(lds + OFF_ST + (32 * (2 * dvh + d) + l31) * QS_STRIDE + (16 * d0 + 8 * hi) * 2);
                o[d] = __builtin_amdgcn_mfma_f32_32x32x16_bf16(a, qf[d0], o[d], 0, 0, 0); }
#pragma unroll
            for (int r = 0; r < 16; ++r) o[d][r] *= qdec; }
        for (int kb = 0; kb <= qblk; ++kb) {
            f32x16 sT = {};
#pragma unroll
            for (int d0 = 0; d0 < 4; ++d0) { const bf16x8 a = *(const LAS bf16x8*)(lds + OFF_KS + (32 * kb + l31) * QS_STRIDE + (16 * d0 + 8 * hi) * 2);
                sT = __builtin_amdgcn_mfma_f32_32x32x16_bf16(a, qf[d0], sT, 0, 0, 0); }
            const int dq = 32 * (qblk - kb) + l31;
#pragma unroll
            for (int r = 0; r < 16; ++r) { const int dist = dq - ((r & 3) + 8 * (r >> 2) + 4 * hi); sT[r] = (dist >= 0) ? sT[r] * __builtin_amdgcn_exp2f(lg * (float)dist) : 0.f; }
            u32x4 pw[2];
#pragma unroll
            for (int sx = 0; sx < 2; ++sx) { pw[sx].x = pg8::cvt_pk_bf16(sT[8 * sx], sT[8 * sx + 1]); pw[sx].y = pg8::cvt_pk_bf16(sT[8 * sx + 2], sT[8 * sx + 3]);
                pw[sx].z = pg8::cvt_pk_bf16(sT[8 * sx + 4], sT[8 * sx + 5]); pw[sx].w = pg8::cvt_pk_bf16(sT[8 * sx + 6], sT[8 * sx + 7]); }
#pragma unroll
            for (int d = 0; d < 2; ++d)
#pragma unroll
                for (int sx = 0; sx < 2; ++sx) { lptr vp = (lptr)lds + OFF_VS + (32 * kb + 16 * sx + 4 * hi + qq) * VS_STRIDE + (32 * (2 * dvh + d) + 16 * g + 4 * pp) * 2;
                    const bf16x8 a = cat8(vtr(vp), vtr(vp + 8 * VS_STRIDE));
                    o[d] = __builtin_amdgcn_mfma_f32_32x32x16_bf16(a, __builtin_bit_cast(bf16x8, pw[sx]), o[d], 0, 0, 0); }
        }
        state_update(st, (lptr)lds, dkb, dvb, gC, lane);
        float ss = 0.f;
#pragma unroll
        for (int d = 0; d < 2; ++d)
#pragma unroll
            for (int r = 0; r < 16; ++r) ss += o[d][r] * o[d][r];
        ss += __shfl_xor(ss, 32);
        __syncthreads();
#pragma unroll
        for (int d = 0; d < 2; ++d)
#pragma unroll
            for (int gq = 0; gq < 4; ++gq) *(LAS f32x4*)(lds + OFF_OUT + (32 * qblk + l31) * OUT_STRIDE + (32 * (2 * dvh + d) + 8 * gq + 4 * hi) * 4) = (f32x4){o[d][4 * gq], o[d][4 * gq + 1], o[d][4 * gq + 2], o[d][4 * gq + 3]};
        if (hi == 0) *(LAS float*)(lds + OFF_SSQ + (dvh * 128 + 32 * qblk + l31) * 4) = ss;
        __syncthreads();
        { const int row = tid >> 2, seg = tid & 3;
          const float rstd = rsqrtf((*(const LAS float*)(lds + OFF_SSQ + row * 4) + *(const LAS float*)(lds + OFF_SSQ + (128 + row) * 4)) * (1.f / DV) + SUBLN_EPS);
          const bf16* gsrc = PROJ + (row0 + row) * PP + C_GR + h * DV + seg * 32; bf16* dst = RB + (row0 + row) * 512 + h * DV + seg * 32;
#pragma unroll
          for (int cc = 0; cc < 4; ++cc) { const f32x4 v0 = *(const LAS f32x4*)(lds + OFF_OUT + row * OUT_STRIDE + (seg * 32 + cc * 8) * 4), v1 = *(const LAS f32x4*)(lds + OFF_OUT + row * OUT_STRIDE + (seg * 32 + cc * 8 + 4) * 4);
              f32x4 g0, g1; pg8::unpack8(*(const u32x4*)(gsrc + cc * 8), g0, g1); f32x4 r0, r1;
#pragma unroll
              for (int i = 0; i < 4; ++i) { r0[i] = v0[i] * rstd * g0[i]; r1[i] = v1[i] * rstd * g1[i]; }
              *(u32x4*)(dst + cc * 8) = pg8::pack8(r0, r1); } }
    }
    __syncthreads();
}
}

namespace attn {
typedef short s16x4 __attribute__((ext_vector_type(4)));
typedef short v4i16_t __attribute__((ext_vector_type(4)));
typedef LAS const unsigned char* lptr;
constexpr int KSLOT = 16384, L_K2 = 8192, L_V = 65536, VSLOT = 16384;
#ifndef ATT_SKIP
#define ATT_SKIP 1
#endif
#ifndef ATT_THR
#define ATT_THR 60.0f
#endif
__device__ __forceinline__ void glds16s(const void* sbase, unsigned voff, unsigned lds_dst) { unsigned keep;
    asm volatile("s_mov_b32 %0, m0\n\ts_mov_b32 m0, %3\n\ts_nop 0\n\tglobal_load_lds_dwordx4 %1, %2\n\ts_mov_b32 m0, %0" : "=&s"(keep) : "v"(voff), "s"(sbase), "s"(lds_dst) : "memory"); }
__device__ __forceinline__ void glds16(const void* gsrc, unsigned lds_dst) { unsigned keep;
    asm volatile("s_mov_b32 %0, m0\n\ts_mov_b32 m0, %2\n\ts_nop 0\n\tglobal_load_lds_dwordx4 %1, off\n\ts_mov_b32 m0, %0" : "=&s"(keep) : "v"(gsrc), "s"(lds_dst) : "memory"); }
__device__ __forceinline__ s16x4 vtr(lptr p) { return __builtin_bit_cast(s16x4, __builtin_amdgcn_ds_read_tr16_b64_v4i16((LAS v4i16_t*)p)); }
__device__ __forceinline__ bf16x8 cat8(const s16x4 lo, const s16x4 hi) { return (bf16x8){lo[0], lo[1], lo[2], lo[3], hi[0], hi[1], hi[2], hi[3]}; }
#define ATT_WAIT_BAR() asm volatile("s_waitcnt vmcnt(0) lgkmcnt(0)\n\ts_barrier" ::: "memory")
#define ATT_WAIT_BAR4() asm volatile("s_waitcnt vmcnt(4) lgkmcnt(0)\n\ts_barrier" ::: "memory")

#define ATT_SB() __builtin_amdgcn_sched_barrier(0)
__device__ __forceinline__ float max3f(float a, float b, float c) { float r; asm("v_max3_f32 %0, %1, %2, %3" : "=v"(r) : "v"(a), "v"(b), "v"(c)); return r; }
__device__ __forceinline__ bf16x8 vfrag(lptr vp, int ks, int d) { const lptr va = vp + d * 4096 + (32 * (ks >> 1) + 16 * (ks & 1)) * 64; return cat8(vtr(va), vtr(va + 8 * 64)); }
__device__ __forceinline__ void vload4(bf16x8 (&buf)[8], int half, lptr vp, int ks) {
#pragma unroll
    for (int d = 0; d < 4; ++d) buf[4 * half + d] = vfrag(vp, ks, d);
}
__device__ __forceinline__ void pv_step(f32x16 (&o)[4], const u32x4& pwk, const bf16x8 (&buf)[8], int half) {
    const bf16x8 pb = __builtin_bit_cast(bf16x8, pwk);
#pragma unroll
    for (int d = 0; d < 4; ++d) o[d] = __builtin_amdgcn_mfma_f32_32x32x16_bf16(buf[4 * half + d], pb, o[d], 0, 0, 0);
}
__device__ __forceinline__ void kload8(bf16x8 (&kf)[8], lptr kp) {
#pragma unroll
    for (int d0 = 0; d0 < 4; ++d0) { kf[2 * d0] = *(const LAS bf16x8*)(kp + d0 * 2048); kf[2 * d0 + 1] = *(const LAS bf16x8*)(kp + d0 * 2048 + 512); }
}
__device__ __forceinline__ void kload4(bf16x8 (&kf)[8], lptr kp, int half) {
#pragma unroll
    for (int d0 = 2 * half; d0 < 2 * half + 2; ++d0) { kf[2 * d0] = *(const LAS bf16x8*)(kp + d0 * 2048); kf[2 * d0 + 1] = *(const LAS bf16x8*)(kp + d0 * 2048 + 512); }
}
template <int MODE> __device__ __forceinline__ void qk_scores(const bf16x8 (&kf)[8], const bf16x8 (&qr)[4], f32x16 (&o)[4], f32x16& p0, f32x16& p1, float& cinit, float shift, bool band, int kb, int qrel, lptr vp, bf16x8 (&tmp)[8]) {
#pragma unroll
    for (int r = 0; r < 16; ++r) { p0[r] = cinit; p1[r] = cinit; }
#pragma unroll
    for (int d0 = 0; d0 < 4; ++d0) {
        p0 = __builtin_amdgcn_mfma_f32_32x32x16_bf16(kf[2 * d0], qr[d0], p0, 0, 0, 0);
        p1 = __builtin_amdgcn_mfma_f32_32x32x16_bf16(kf[2 * d0 + 1], qr[d0], p1, 0, 0, 0);
    }
    ATT_SB();
    vload4(tmp, 0, vp, 0); vload4(tmp, 1, vp, 1);
    ATT_SB();
}
template <int MODE> __device__ __forceinline__ void softmax_head(f32x16 (&o)[4], float& lsum, f32x16& p0, f32x16& p1, float& cinit, float shift, bool band, int kb, int qrel) {
    if (!(MODE & 2)) {
    if (band) {
#pragma unroll
        for (int r = 0; r < 16; ++r) { const int kv = kb + (r & 3) + 8 * (r >> 2); if (kv > qrel) p0[r] = -INFINITY; if (kv + 32 > qrel) p1[r] = -INFINITY; }
    }
    ATT_SB(); asm volatile("s_nop 7\n\ts_nop 7"); ATT_SB();
    float rm = max3f(p0[0], p0[1], p1[0]), rb = max3f(p0[2], p0[3], p1[1]);
    rm = max3f(rm, p1[2], p1[3]);
#pragma unroll
    for (int r = 4; r < 16; r += 4) { rm = max3f(rm, p0[r], p0[r + 1]); rb = max3f(rb, p0[r + 2], p0[r + 3]); rm = max3f(rm, p1[r], p1[r + 1]); rb = max3f(rb, p1[r + 2], p1[r + 3]); }
    rm = max3f(rm, rb, rb);
    { auto rr = __builtin_amdgcn_permlane32_swap(__float_as_uint(rm), __float_as_uint(rm), false, false); rm = fmaxf(__uint_as_float(rr[0]), __uint_as_float(rr[1])); }
    if (__any(rm > ATT_THR)) {
        const float dl = fmaxf(rm, 0.f), f = __builtin_amdgcn_exp2f(-dl);
        cinit -= dl;
#pragma unroll
        for (int r = 0; r < 16; ++r) { p0[r] -= dl; p1[r] -= dl; }
        lsum *= f;
#pragma unroll
        for (int d = 0; d < 4; ++d)
#pragma unroll
            for (int r = 0; r < 16; ++r) o[d][r] *= f;
    }
    }
    cinit += shift;
}
struct AW { float b1, b2, b3, a8, c1, c2, c3; };
template <int MODE> __device__ __forceinline__ u32x4 exp_pack(const f32x16& p, int s, float& lsum, float cks, const AW& aw) {
    float e[8];
#pragma unroll
    for (int j = 0; j < 8; ++j) e[j] = (MODE & 2) ? p[8 * s + j] : __builtin_amdgcn_exp2f(p[8 * s + j]);
    const float g0 = __builtin_fmaf(aw.b3, e[3], __builtin_fmaf(aw.b2, e[2], __builtin_fmaf(aw.b1, e[1], e[0])));
    const float g1 = __builtin_fmaf(aw.b3, e[7], __builtin_fmaf(aw.b2, e[6], __builtin_fmaf(aw.b1, e[5], e[4])));
    lsum = __builtin_fmaf(cks, __builtin_fmaf(aw.a8, g1, g0), lsum);
    u32x4 w; w.x = pg8::cvt_pk_bf16(e[0], e[1]); w.y = pg8::cvt_pk_bf16(e[2], e[3]); w.z = pg8::cvt_pk_bf16(e[4], e[5]); w.w = pg8::cvt_pk_bf16(e[6], e[7]);
    return w;
}
__device__ __forceinline__ void qk_half(const bf16x8 (&kf)[8], const bf16x8 (&qr)[4], f32x16& p0, f32x16& p1, int half) {
    if (half == 0) {
        p0 = __builtin_amdgcn_mfma_f32_32x32x16_bf16(kf[0], qr[0], f32x16{}, 0, 0, 0); p1 = __builtin_amdgcn_mfma_f32_32x32x16_bf16(kf[1], qr[0], f32x16{}, 0, 0, 0);
        p0 = __builtin_amdgcn_mfma_f32_32x32x16_bf16(kf[2], qr[1], p0, 0, 0, 0); p1 = __builtin_amdgcn_mfma_f32_32x32x16_bf16(kf[3], qr[1], p1, 0, 0, 0);
    } else {
        p0 = __builtin_amdgcn_mfma_f32_32x32x16_bf16(kf[4], qr[2], p0, 0, 0, 0); p1 = __builtin_amdgcn_mfma_f32_32x32x16_bf16(kf[5], qr[2], p1, 0, 0, 0);
        p0 = __builtin_amdgcn_mfma_f32_32x32x16_bf16(kf[6], qr[3], p0, 0, 0, 0); p1 = __builtin_amdgcn_mfma_f32_32x32x16_bf16(kf[7], qr[3], p1, 0, 0, 0);
    }
}
__device__ __forceinline__ void softmax_head2(f32x16 (&o)[4], float& lsum, f32x16& p0, f32x16& p1, float& c, bool band, int kb, int qrel) {
    if (band) {
#pragma unroll
        for (int r = 0; r < 16; ++r) { const int kv = kb + (r & 3) + 8 * (r >> 2); if (kv > qrel) p0[r] = -INFINITY; if (kv + 32 > qrel) p1[r] = -INFINITY; }
    }
    ATT_SB();
    float rm = max3f(p0[0], p0[1], p1[0]), rb = max3f(p0[2], p0[3], p1[1]);
    rm = max3f(rm, p1[2], p1[3]);
#pragma unroll
    for (int r = 4; r < 16; r += 4) { rm = max3f(rm, p0[r], p0[r + 1]); rb = max3f(rb, p0[r + 2], p0[r + 3]); rm = max3f(rm, p1[r], p1[r + 1]); rb = max3f(rb, p1[r + 2], p1[r + 3]); }
    rm = max3f(rm, rb, rb) + c;
    { auto rr = __builtin_amdgcn_permlane32_swap(__float_as_uint(rm), __float_as_uint(rm), false, false); rm = fmaxf(__uint_as_float(rr[0]), __uint_as_float(rr[1])); }
    if (__any(rm > ATT_THR)) {
        const float dl = fmaxf(rm, 0.f), f = __builtin_amdgcn_exp2f(-dl);
        c -= dl; lsum *= f;
#pragma unroll
        for (int d = 0; d < 4; ++d)
#pragma unroll
            for (int r = 0; r < 16; ++r) o[d][r] *= f;
    }
}
__device__ __forceinline__ u32x4 exp_pack2(const f32x16& p, int s, float c, float& lsum, float cks, const AW& aw) {
    float e[8];
#pragma unroll
    for (int j = 0; j < 8; ++j) e[j] = __builtin_amdgcn_exp2f(p[8 * s + j] + c);
    const float g0 = __builtin_fmaf(aw.b3, e[3], __builtin_fmaf(aw.b2, e[2], __builtin_fmaf(aw.b1, e[1], e[0])));
    const float g1 = __builtin_fmaf(aw.b3, e[7], __builtin_fmaf(aw.b2, e[6], __builtin_fmaf(aw.b1, e[5], e[4])));
    lsum = __builtin_fmaf(cks, __builtin_fmaf(aw.a8, g1, g0), lsum);
    u32x4 w; w.x = pg8::cvt_pk_bf16(e[0], e[1]); w.y = pg8::cvt_pk_bf16(e[2], e[3]); w.z = pg8::cvt_pk_bf16(e[4], e[5]); w.w = pg8::cvt_pk_bf16(e[6], e[7]);
    return w;
}
struct ESl { float g0, g1; };
__device__ __forceinline__ void exp_slice(ESl& x, u32x4& w, const f32x16& p, int s, int d, float c, const AW& aw) {
    const float a = __builtin_amdgcn_exp2f(p[8 * s + 2 * d] + c), b = __builtin_amdgcn_exp2f(p[8 * s + 2 * d + 1] + c);
    const unsigned pk = pg8::cvt_pk_bf16(a, b);
    if (d == 0) { w.x = pk; x.g0 = __builtin_fmaf(aw.b1, b, a); } else if (d == 1) { w.y = pk; x.g0 = __builtin_fmaf(aw.b3, b, __builtin_fmaf(aw.b2, a, x.g0)); }
    else if (d == 2) { w.z = pk; x.g1 = __builtin_fmaf(aw.b1, b, a); } else { w.w = pk; x.g1 = __builtin_fmaf(aw.b3, b, __builtin_fmaf(aw.b2, a, x.g1)); }
}
#define ATT_PIN1(v) asm volatile("" : "+v"(v))
__device__ __forceinline__ void pv_exp_step(f32x16 (&o)[4], const u32x4& pwk, bf16x8 (&buf)[8], int half, lptr vp, int vks, u32x4& wn, const f32x16& pnx, int s, float c, float& lsum, float cks, const AW& aw) {
    const bf16x8 pb = __builtin_bit_cast(bf16x8, pwk); ESl x;
#pragma unroll
    for (int d = 0; d < 4; ++d) {
        o[d] = __builtin_amdgcn_mfma_f32_32x32x16_bf16(buf[4 * half + d], pb, o[d], 0, 0, 0);
        exp_slice(x, wn, pnx, s, d, c, aw);
        if (vks >= 0) buf[4 * half + d] = vfrag(vp, vks, d);
        if (d == 3) lsum = __builtin_fmaf(cks, __builtin_fmaf(aw.a8, x.g1, x.g0), lsum);
        if (d == 0) ATT_PIN1(wn.x); else if (d == 1) ATT_PIN1(wn.y); else if (d == 2) ATT_PIN1(wn.z); else { ATT_PIN1(wn.w); ATT_PIN1(lsum); }
        ATT_SB();
    }
}
__device__ __forceinline__ void qk_exp_half(const bf16x8 (&kf)[8], const bf16x8 (&qr)[4], f32x16& p0, f32x16& p1, bool nxt, u32x4& wn, const f32x16& pcur, float c, float& lsum, const AW& aw) {
    ESl x;
#pragma unroll
    for (int d = 0; d < 4; ++d) {
        if (nxt) { if (d == 0) p0 = __builtin_amdgcn_mfma_f32_32x32x16_bf16(kf[4], qr[2], p0, 0, 0, 0); else if (d == 1) p1 = __builtin_amdgcn_mfma_f32_32x32x16_bf16(kf[5], qr[2], p1, 0, 0, 0);
                   else if (d == 2) p0 = __builtin_amdgcn_mfma_f32_32x32x16_bf16(kf[6], qr[3], p0, 0, 0, 0); else p1 = __builtin_amdgcn_mfma_f32_32x32x16_bf16(kf[7], qr[3], p1, 0, 0, 0); }
        exp_slice(x, wn, pcur, 0, d, c, aw);
        if (d == 3) lsum = __builtin_fmaf(1.f, __builtin_fmaf(aw.a8, x.g1, x.g0), lsum);
        if (d == 0) ATT_PIN1(wn.x); else if (d == 1) ATT_PIN1(wn.y); else if (d == 2) ATT_PIN1(wn.z); else { ATT_PIN1(wn.w); ATT_PIN1(lsum); }
        ATT_SB();
    }
}
template <int MODE> __device__ __forceinline__ void attn_unit(LAS unsigned char* lds, const bf16* PROJ, const bf16* KVP, bf16* AB, const float* gsub, float lam, int bh, int qb, float dq2, int tid) {
    const int lane = tid & 63, r32 = lane & 31, hi = lane >> 5, g = (lane >> 4) & 1, qq = (lane & 15) >> 2, pp = lane & 3;
    const int wid = __builtin_amdgcn_readfirstlane(tid >> 6), map = wid >> 2, qblk = wid & 3;
    const int b = bh >> 2, h = bh & 3, q0 = qb * 128;
    const size_t rowbase = (size_t)b * SEQ;
    const float sl2 = alibi_sl2(h);
    const unsigned lds0 = (unsigned)(uintptr_t)lds;
    const char* kvw = (const char*)(KVP + (size_t)bh * 128 * 16384) + wid * 1024;
    const unsigned lane16 = (unsigned)lane * 16u;
#define ATT_DMA_K(t, kslot) do { const char* _g = kvw + (size_t)(t) * 32768; const unsigned _k = lds0 + (kslot) * KSLOT + wid * 1024; \
        glds16s(_g, lane16, (unsigned)__builtin_amdgcn_readfirstlane(_k)); glds16s(_g + 8192, lane16, (unsigned)__builtin_amdgcn_readfirstlane(_k + L_K2)); } while (0)
#define ATT_DMA_V(t, vslot) do { const char* _g = kvw + (size_t)(t) * 32768 + 16384; const unsigned _v = lds0 + L_V + (vslot) * VSLOT + wid * 1024; \
        glds16s(_g, lane16, (unsigned)__builtin_amdgcn_readfirstlane(_v)); glds16s(_g + 8192, lane16, (unsigned)__builtin_amdgcn_readfirstlane(_v + 8192)); } while (0)
    const int NT = 2 * (qb + 1);
    int t0 = 0;
#if ATT_SKIP
    { const float dneed = (152.f + dq2) / sl2;
      const int tq = (int)__builtin_floorf(((float)q0 - dneed - 63.f) * (1.f / 64.f)) + 1;
      t0 = __builtin_amdgcn_readfirstlane(tq > 0 ? tq : 0); }
#endif
    ATT_DMA_K(t0, 0); ATT_DMA_V(t0, 0); ATT_DMA_K(t0 + 1, 1); ATT_DMA_V(t0 + 1, 1);
    if (t0 + 2 < NT) { ATT_DMA_K(t0 + 2, 2); ATT_DMA_V(t0 + 2, 2); }
    const bf16* Qw = PROJ + (rowbase + q0 + 32 * qblk + r32) * PP + (map ? C_Q2 : C_Q1) + h * HD;
    bf16x8 qr[4];
#pragma unroll
    for (int d0 = 0; d0 < 4; ++d0) qr[d0] = *(const bf16x8*)(Qw + d0 * 16 + hi * 8);
    auto uni = [](float x) { return __builtin_bit_cast(float, __builtin_amdgcn_readfirstlane(__builtin_bit_cast(int, x))); };
    const AW aw = {uni(__builtin_amdgcn_exp2f(sl2)), uni(__builtin_amdgcn_exp2f(2.f * sl2)), uni(__builtin_amdgcn_exp2f(3.f * sl2)), uni(__builtin_amdgcn_exp2f(8.f * sl2)),
                   uni(__builtin_amdgcn_exp2f(16.f * sl2)), uni(__builtin_amdgcn_exp2f(32.f * sl2)), uni(__builtin_amdgcn_exp2f(48.f * sl2))};
    const float whi = __builtin_amdgcn_exp2f(sl2 * (float)(4 * hi - 63));
    float lsum = 0.f;
    f32x16 o[4];
#pragma unroll
    for (int d = 0; d < 4; ++d) o[d] = f32x16{};
    float cinit = sl2 * 63.f;
    const float shift = 64.f * sl2;
    const int qrel = 32 * qblk + r32;
    const lptr ldsc = (lptr)lds;
    const lptr vp0 = ldsc + L_V + (4 * hi + qq) * 64 + (16 * g + 4 * pp) * 2;
    const lptr kp0 = ldsc + (map ? L_K2 : 0) + hi * 1024 + r32 * 16;
    u32x4 pw[4];
#pragma unroll
    for (int i = 0; i < 4; ++i) pw[i] = (u32x4){0u, 0u, 0u, 0u};
    bf16x8 hold[8], tmp[8];
    int sl_cur = 0;
    asm volatile("" : "+v"(qr[0]), "+v"(qr[1]), "+v"(qr[2]), "+v"(qr[3]));
    ATT_WAIT_BAR();
    f32x16 pA0, pA1, pB0, pB1;
    kload8(hold, kp0);
    qk_half(hold, qr, pA0, pA1, 0); qk_half(hold, qr, pA0, pA1, 1);
    auto step = [&](int t, f32x16& pc0, f32x16& pc1, f32x16& pn0, f32x16& pn1) __attribute__((always_inline)) {
        if (t > t0) { if (t + 2 < NT) ATT_WAIT_BAR4(); else ATT_WAIT_BAR(); }
        const bool nxt = (t + 1 < NT), band = (t >= NT - 2); const int kb = 64 * (t - (NT - 2)) + 4 * hi;
        const lptr vp = vp0 + sl_cur * VSLOT;
        if (nxt) kload4(hold, kp0 + ((sl_cur + 1) & 3) * KSLOT, 0);
        vload4(tmp, 0, vp, 0); vload4(tmp, 1, vp, 1);
        ATT_SB();
        if (nxt) qk_half(hold, qr, pn0, pn1, 0);
        if (nxt) kload4(hold, kp0 + ((sl_cur + 1) & 3) * KSLOT, 1);
        ATT_SB();
        softmax_head2(o, lsum, pc0, pc1, cinit, band, kb, qrel);
        ATT_SB();
        if (t + 3 < NT) { ATT_DMA_K(t + 3, (sl_cur + 3) & 3); ATT_DMA_V(t + 3, (sl_cur + 3) & 3); }
        ATT_SB();
        { u32x4 wa, wb;
        qk_exp_half(hold, qr, pn0, pn1, nxt, wa, pc0, cinit, lsum, aw);
        pv_exp_step(o, wa, tmp, 0, vp, 2, wb, pc0, 1, cinit, lsum, aw.c1, aw);
        pv_exp_step(o, wb, tmp, 1, vp, 3, wa, pc1, 0, cinit, lsum, aw.c2, aw);
        pv_exp_step(o, wa, tmp, 0, vp, -1, wb, pc1, 1, cinit, lsum, aw.c3, aw);
        pv_step(o, wb, tmp, 1); ATT_SB(); }
        cinit += shift;
        sl_cur = (sl_cur + 1) & 3;
    };
    for (int t = t0; t < NT; t += 2) { step(t, pA0, pA1, pB0, pB1); if (t + 1 < NT) step(t + 1, pB0, pB1, pA0, pA1); }
    float rl;
    { const float lw = lsum * whi; auto rr = __builtin_amdgcn_permlane32_swap(__float_as_uint(lw), __float_as_uint(lw), false, false); rl = __builtin_amdgcn_rcpf(__uint_as_float(rr[0]) + __uint_as_float(rr[1])); }
    ATT_WAIT_BAR();
    LAS float* xch = (LAS float*)(lds + qblk * 16384) + lane;
    if (map == 1) {
#pragma unroll
        for (int d = 0; d < 4; ++d)
#pragma unroll
            for (int r = 0; r < 16; ++r) xch[(d * 16 + r) * 64] = o[d][r] * rl;
    }
    ATT_WAIT_BAR();
    if (map == 0) {
        float ss = 0.f;
#pragma unroll
        for (int d = 0; d < 4; ++d)
#pragma unroll
            for (int r = 0; r < 16; ++r) { const float a = o[d][r] * rl - lam * xch[(d * 16 + r) * 64]; o[d][r] = a; ss += a * a; }
        ss += __shfl_xor(ss, 32);
        const float rstd = rsqrtf(ss * (1.f / DV) + SUBLN_EPS) * (1.f - LAM_INIT);
        bf16* dst = AB + (rowbase + q0 + 32 * qblk + r32) * 512 + h * DV + 8 * hi;
#pragma unroll
        for (int d = 0; d < 4; ++d)
#pragma unroll
            for (int pq = 0; pq < 2; ++pq) { u32x2 w[2];
#pragma unroll
                for (int e = 0; e < 2; ++e) { const int gq = 2 * pq + e; const f32x4 gg = *(const f32x4*)(gsub + 32 * d + 8 * gq + 4 * hi);
                    w[e].x = pg8::cvt_pk_bf16(o[d][4 * gq] * rstd * gg[0], o[d][4 * gq + 1] * rstd * gg[1]); w[e].y = pg8::cvt_pk_bf16(o[d][4 * gq + 2] * rstd * gg[2], o[d][4 * gq + 3] * rstd * gg[3]); }
                auto rx = __builtin_amdgcn_permlane32_swap(w[0].x, w[1].x, false, false); auto ry = __builtin_amdgcn_permlane32_swap(w[0].y, w[1].y, false, false);
                *(u32x4*)(dst + 32 * d + 16 * pq) = (u32x4){rx[0], ry[0], rx[1], ry[1]}; }
    }
    ATT_WAIT_BAR();
#undef ATT_DMA_K
#undef ATT_DMA_V
}
template <int MODE> __device__ __forceinline__ void attn_phase(LAS unsigned char* lds, const bf16* PROJ, const bf16* KVP, const unsigned* KN, bf16* AB, const float* gsub, const float* lq1, const float* lk1, const float* lq2, const float* lk2, int vcu, int G, int tid, unsigned* aq = nullptr) {
    const int lane = tid & 63;
    const float lam = __expf(wave_sum(lq1[lane] * lk1[lane])) - __expf(wave_sum(lq2[lane] * lk2[lane])) + LAM_INIT;
    auto bound = [&](int bh) { float dq2 = 0.f;
#pragma unroll
        for (int mp = 0; mp < 2; ++mp) { const float kn = __uint_as_float(__hip_atomic_load(KN + bh * 2 + mp, __ATOMIC_RELAXED, __HIP_MEMORY_SCOPE_AGENT)), qn = __uint_as_float(__hip_atomic_load(KN + 64 + bh * 2 + mp, __ATOMIC_RELAXED, __HIP_MEMORY_SCOPE_AGENT));
            dq2 = fmaxf(dq2, 2.f * __builtin_sqrtf(2.f * qn) * __builtin_sqrtf(2.f * kn) * 1.0001f); }
        return dq2; };
    LAS int* slot = (LAS int*)(lds + 131072 + 768);
    for (int v = vcu; v < 256; v += G) {
        const int b = v >> 5, w = v & 31;
        for (int it = 0;; ++it) {
            int h, qb;
            if (aq) {
                if (tid == 0) *slot = (int)__hip_atomic_fetch_add(aq, 1u, __ATOMIC_RELAXED, __HIP_MEMORY_SCOPE_AGENT);
                __syncthreads();
                const int u = __builtin_amdgcn_readfirstlane(*slot);
                if (u >= 256) break;
                h = 3 - (u >> 6); qb = 63 - (u & 63);
            } else { if (it >= 8) break; h = (it & 1) ? 3 - (it >> 1) : (it >> 1); qb = (it & 4) ? 63 - w : w; }
            const int bh = b * 4 + h;
            attn_unit<MODE>(lds, PROJ, KVP, AB, gsub, lam, bh, qb, bound(bh), tid);
        }
    }
}
}

constexpr int NWAVES = 8;
constexpr int RING_OFF = 0, RING_BYTES = 131072;
constexpr int LDSCTL_OFF = RING_BYTES, MISC_OFF = LDSCTL_OFF + 320;
constexpr int LDS_BYTES = 159744;
constexpr size_t CTL_ZERO_BYTES = 1 * MiB;
constexpr int CW_BAR = 4096;
constexpr int CW_AQ = 2048;
constexpr int CW_MIS = 1024;
constexpr int CW_KN = 32768;
constexpr int N_PHASES = 10;
constexpr int HALO_OFF = RING_BYTES + 1024;
constexpr int MAX_LAUNCH = 4;
static_assert((CW_BAR + MAX_LAUNCH * XCD_BAR_WORDS) * 4 <= (int)CTL_ZERO_BYTES, "barrier words inside the memset region");
static_assert(HALO_OFF + 2048 + 2 * 4096 + 16384 <= LDS_BYTES, "halo + conv weight tables + rstd partials inside the LDS allocation");

struct Frame {
    LAS unsigned char* lds; volatile LAS unsigned* MISC; gu32* ctl;
    int tid, lane, wave, vcu, G;
};

__device__ __forceinline__ void p0_transpose_item(const float* W, int K, int N, bf16* WT, const float* rs, int mode, LAS float* scr, int item, int lane) {
    const int nblk = N / 32, kb = item / nblk, nb = item % nblk, k0 = 64 * kb, n0 = 32 * nb, s0 = wt_src_col(n0, mode);
#pragma unroll 8
    for (int i = 0; i < 32; ++i) { const int kk = 2 * i + (lane >> 5); const float s = rs ? rs[k0 + kk] : 1.f; scr[kk * 33 + (lane & 31)] = W[(size_t)(k0 + kk) * N + s0 + (lane & 31)] * s; }
    LDS_WAIT(); asm volatile("" ::: "memory");
    const int c = lane & 7;
#pragma unroll
    for (int j = 0; j < 4; ++j) { const int n = (lane >> 3) + 8 * j; const LAS float* s = scr + (8 * c) * 33 + n;
        u32x4 o; o.x = pk2(s[0 * 33], s[1 * 33]); o.y = pk2(s[2 * 33], s[3 * 33]); o.z = pk2(s[4 * 33], s[5 * 33]); o.w = pk2(s[6 * 33], s[7 * 33]);
        *(u32x4*)(WT + (size_t)(n0 + n) * K + k0 + 8 * c) = o; }
    LDS_WAIT(); asm volatile("" ::: "memory");
}
__device__ __forceinline__ void rms_row_to_bf16(const float* xrow, const float* g, bf16* orow, int lane) {
    const f32x4* xr = (const f32x4*)xrow + lane; f32x4 v[4]; float s = 0.f;
#pragma unroll
    for (int j = 0; j < 4; ++j) { v[j] = xr[64 * j]; s += (v[j].x * v[j].x + v[j].y * v[j].y) + (v[j].z * v[j].z + v[j].w * v[j].w); }
    const float rstd = rsqrtf(wave_sum(s) * (1.f / DM) + NORM_EPS);
    u32x2* o = (u32x2*)orow + lane;
#pragma unroll
    for (int j = 0; j < 4; ++j) { const f32x4 gg = ((const f32x4*)g)[lane + 64 * j];
        u32x2 w; w.x = pk2(v[j].x * rstd * gg.x, v[j].y * rstd * gg.y); w.y = pk2(v[j].z * rstd * gg.z, v[j].w * rstd * gg.w); o[64 * j] = w; }
}

struct Args { const float* in[17]; float* out; unsigned char* ws; int ph_lo, ph_hi, li, opt; };

__global__ void __launch_bounds__(NWAVES * 64, 2) mk_fwd(Args args) {
    extern __shared__ __attribute__((aligned(16))) unsigned char lds[];
    Frame F;
    F.lds = (LAS unsigned char*)lds; F.MISC = (volatile LAS unsigned*)(F.lds + MISC_OFF);
    F.tid = threadIdx.x; F.lane = F.tid & 63; F.wave = __builtin_amdgcn_readfirstlane(F.tid >> 6);
    F.G = gridDim.x; { const int bx = blockIdx.x; F.vcu = (F.G % 8 == 0) ? (bx % 8) * (F.G / 8) + bx / 8 : bx; }
    unsigned char* ws = args.ws;
    F.ctl = (gu32*)(ws + WS_CTL);
    const float* x = args.in[0]; const float* g_mix = args.in[1]; const float* w_in = args.in[2];
    const float* w_dp = args.in[8]; const float* w_rp = args.in[9]; const float* w_out = args.in[10];
    const float* g_ffn = args.in[11]; const float* w_up = args.in[12]; const float* conv_w = args.in[13]; const float* conv_b = args.in[14];
    const float* w_down = args.in[15]; const float* g_final = args.in[16];
    float* out = args.out;
    bf16* WIN = (bf16*)(ws + WS_WIN); bf16* WD = (bf16*)(ws + WS_WD); bf16* WR = (bf16*)(ws + WS_WR); bf16* WO = (bf16*)(ws + WS_WO); bf16* WUP = (bf16*)(ws + WS_WUP); bf16* WDN = (bf16*)(ws + WS_WDN);
    bf16* XN = (bf16*)(ws + WS_XN); bf16* PROJ = (bf16*)(ws + WS_PROJ); bf16* AB = (bf16*)(ws + WS_A); bf16* RB = (bf16*)(ws + WS_R);
    bf16* X1B = (bf16*)(ws + WS_X1B); bf16* GB = (bf16*)(ws + WS_G); bf16* UB = (bf16*)(ws + WS_U); float* SSQ1 = (float*)(ws + WS_SSQ1);
    bf16* KVP = (bf16*)(ws + WS_KVP); bf16* MG = XN; bf16* X2B = XN; float* SSQ2 = (float*)(ws + WS_SSQ2); float* GST = (float*)(ws + WS_GST); float* HB = (float*)(ws + WS_HB);
    for (int u = F.tid; u < (LDS_BYTES - LDSCTL_OFF) / 4; u += NWAVES * 64) ((LAS unsigned*)(F.lds + LDSCTL_OFF))[u] = 0u;
    __syncthreads();
    XcdBarrier bar = xcd_barrier_post((unsigned*)(F.ctl + CW_BAR) + args.li * XCD_BAR_WORDS, F.MISC + 8, F.wave);
    const int lo = args.ph_lo, hi = args.ph_hi;
    if (F.tid == 0 && (bar.x != (blockIdx.x & 7u) || F.G != 256)) atomicOr((unsigned*)(F.ctl + CW_MIS + 64 * args.li), 1u);
    bool local_ok = false;
#define IN(k) (lo <= (k) && (k) < hi)
#define SEAM(k) do { if (IN(k) && IN((k) + 1)) { if (local_ok && (k) != 0 && (k) != 4) xcd_barrier_local(bar); else xcd_barrier(bar); } } while (0)

    if (IN(0)) {
        LAS float* scr = (LAS float*)(F.lds + RING_OFF + F.wave * 16384);
        const int gw = F.vcu * NWAVES + F.wave, NGW = F.G * NWAVES;
        constexpr int I_IN = (DM / 64) * (DIN / 32), I_D = (512 / 64) * (DM / 32), I_O = (DM / 64) * (DM / 32), I_UP = (DM / 64) * (FF2 / 32), I_DN = (FF / 64) * (DM / 32);
        constexpr int NITEMS = I_IN + 2 * I_D + I_O + I_UP + I_DN;
        for (int it = gw; it < NITEMS; it += NGW) {
            int r = it;
            if (r < I_IN) { p0_transpose_item(w_in, DM, DIN, WIN, nullptr, 0, scr, r, F.lane); continue; } r -= I_IN;
            if (r < I_D) { p0_transpose_item(w_dp, 512, DM, WD, nullptr, 0, scr, r, F.lane); continue; } r -= I_D;
            if (r < I_D) { p0_transpose_item(w_rp, 512, DM, WR, nullptr, 0, scr, r, F.lane); continue; } r -= I_D;
            if (r < I_O) { p0_transpose_item(w_out, DM, DM, WO, nullptr, 0, scr, r, F.lane); continue; } r -= I_O;
            if (r < I_UP) { p0_transpose_item(w_up, DM, FF2, WUP, g_ffn, 1, scr, r, F.lane); continue; } r -= I_UP;
            p0_transpose_item(w_down, FF, DM, WDN, nullptr, 0, scr, r, F.lane);
        }
        { float* cs = (float*)(ws + WS_CONV);
          for (int i = (int)blockIdx.x * (NWAVES * 64) + F.tid; i < 4 * FF2; i += F.G * (NWAVES * 64)) { const int row = i / FF2, c = i % FF2;
              cs[i] = ((row < 3) ? conv_w[i] : conv_b[c]) * ((c < FF) ? -LOG2E : -1.f / LOG2E); } }
        for (int m = gw; m < M; m += 2 * NGW) {
            const f32x4* xa = (const f32x4*)(x + (size_t)m * DM) + F.lane; const int m2 = (m + NGW < M) ? m + NGW : m; const f32x4* xb = (const f32x4*)(x + (size_t)m2 * DM) + F.lane;
            f32x4 va[4], vb[4]; float sa = 0.f, sb = 0.f;
#pragma unroll
            for (int j = 0; j < 4; ++j) { va[j] = xa[64 * j]; vb[j] = xb[64 * j]; }
#pragma unroll
            for (int j = 0; j < 4; ++j) { sa += (va[j].x * va[j].x + va[j].y * va[j].y) + (va[j].z * va[j].z + va[j].w * va[j].w); sb += (vb[j].x * vb[j].x + vb[j].y * vb[j].y) + (vb[j].z * vb[j].z + vb[j].w * vb[j].w); }
            const float ra = rsqrtf(wave_sum(sa) * (1.f / DM) + NORM_EPS), rb = rsqrtf(wave_sum(sb) * (1.f / DM) + NORM_EPS);
            u32x2* oa = (u32x2*)(XN + (size_t)m * DM) + F.lane; u32x2* ob = (u32x2*)(XN + (size_t)m2 * DM) + F.lane;
#pragma unroll
            for (int j = 0; j < 4; ++j) { const f32x4 gg = ((const f32x4*)g_mix)[F.lane + 64 * j];
                u32x2 w; w.x = pk2(va[j].x * ra * gg.x, va[j].y * ra * gg.y); w.y = pk2(va[j].z * ra * gg.z, va[j].w * ra * gg.w); oa[64 * j] = w;
                w.x = pk2(vb[j].x * rb * gg.x, vb[j].y * rb * gg.y); w.y = pk2(vb[j].z * rb * gg.z, vb[j].w * rb * gg.w); ob[64 * j] = w; }
        }
    }
    SEAM(0);
    if (lo == 0 && hi > 1) local_ok = __builtin_amdgcn_readfirstlane((int)xb_ld((unsigned*)(F.ctl + CW_MIS + 64 * args.li))) == 0;
    if (IN(1)) {
        pg8::Gemm g{XN, WIN, M, DIN, DM}; pg8::StaticOrder S; S.init(M, DIN, F.G, (int)blockIdx.x);
        pg8::EpiProj E{PROJ, KVP, (unsigned*)(F.ctl + CW_KN)};
        pg8::gemm_phase<pg8::EpiProj, pg8::StaticOrder, true, true>(F.lds + RING_OFF, g, S, E, F.wave);
    }
    SEAM(1);
    if (IN(2)) { if (!(args.opt & 1)) for (int ui = F.vcu; ui < 256; ui += F.G) ret::ret_group_state(F.lds + RING_OFF, PROJ, GST, ui, F.tid); }
    SEAM(2);
    if (IN(3)) { const int tidL = F.wave * 64 + lane_now();
        if (!(args.opt & 1)) for (int ui = F.vcu; ui < 256; ui += F.G) ret::ret_outputs(F.lds + RING_OFF, PROJ, GST, RB, ui ^ 7, tidL);
        if (!(args.opt & 2)) attn::attn_phase<0>(F.lds + RING_OFF, PROJ, KVP, (const unsigned*)(F.ctl + CW_KN), AB, args.in[7], args.in[3], args.in[4], args.in[5], args.in[6], F.vcu, F.G, tidL, (F.G == 256) ? (unsigned*)(F.ctl + CW_AQ + 64 * (8 * args.li + (int)(blockIdx.x & 7))) : nullptr);
#ifdef PROBE_MODE
        if (args.opt & 4) attn::attn_phase<PROBE_MODE>(F.lds + RING_OFF, PROJ, KVP, (const unsigned*)(F.ctl + CW_KN), XN, args.in[7], args.in[3], args.in[4], args.in[5], args.in[6], F.vcu, F.G, tidL);
#endif
    }
    SEAM(3);
    if (IN(4)) {
        pg8::Gemm g{AB, WD, M, DM, 512, RB, WR}; pg8::DualOrder S; S.init(M, DM, F.G, (int)blockIdx.x);
        pg8::EpiMerge2 E{PROJ, MG};
        pg8::gemm_phase<pg8::EpiMerge2, pg8::DualOrder, true, true>(F.lds + RING_OFF, g, S, E, F.wave);
    }
    SEAM(4);
    if (IN(5)) {
        pg8::Gemm g{MG, WO, M, DM, DM}; pg8::StaticOrder S; S.init(M, DM, F.G, (int)blockIdx.x);
        pg8::EpiOutProj E{x, X1B, SSQ1};
        pg8::gemm_phase<pg8::EpiOutProj, pg8::StaticOrder, true, true>(F.lds + RING_OFF, g, S, E, F.wave);
    }
    SEAM(5);
    if (IN(6)) {
        pg8::Gemm g{X1B, WUP, M, FF2, DM}; pg8::StaticOrder S; S.init(M, FF2, F.G, (int)blockIdx.x);
        pg8::EpiUpConv E{SSQ1, GB, HB, (const float*)(ws + WS_CONV), (const float*)(ws + WS_CONV) + 3 * FF2, (LAS float*)(F.lds + HALO_OFF)};
        pg8::gemm_phase<pg8::EpiUpConv, pg8::StaticOrder, true, true>(F.lds + RING_OFF, g, S, E, F.wave);
    }
    SEAM(6);
    if (IN(7)) {
        const bool gp = (F.G == 256);
        const int nw = gp ? 32 : F.G, w = gp ? (int)(blockIdx.x >> 3) : (int)blockIdx.x, pm0 = gp ? (int)(blockIdx.x & 7) * 32 : 0, npm = gp ? 32 : M / 256;
        const int nit = npm * (FF / 4);
        const int tidL = F.wave * 64 + lane_now();
        for (int it = w * (NWAVES * 64) + tidL; it < nit; it += nw * (NWAVES * 64)) {
            const int pm = pm0 + it / (FF / 4), gc = (it % (FF / 4)) * 4;
            if ((pm & 31) == 0) continue;
            const int uc = (gc >> 7) * 256 + (gc & 127);
            const float* h0 = HB + (size_t)(pm - 1) * 4 * FF2, * h1 = HB + (size_t)pm * 4 * FF2;
            const f32x4 gm2 = *(const f32x4*)(h0 + 2 * FF2 + uc), gm1 = *(const f32x4*)(h0 + 3 * FF2 + uc), g0 = *(const f32x4*)(h1 + uc), g1 = *(const f32x4*)(h1 + FF2 + uc);
            const f32x4 um2 = *(const f32x4*)(h0 + 2 * FF2 + uc + 128), um1 = *(const f32x4*)(h0 + 3 * FF2 + uc + 128), u0 = *(const f32x4*)(h1 + uc + 128), u1 = *(const f32x4*)(h1 + FF2 + uc + 128);
            f32x4 wg[3], wu[3];
            const float* cs = (const float*)(ws + WS_CONV);
#pragma unroll
            for (int k = 0; k < 3; ++k) { wg[k] = *(const f32x4*)(cs + k * FF2 + gc); wu[k] = *(const f32x4*)(cs + k * FF2 + FF + gc); }
            const f32x4 bg = *(const f32x4*)(cs + 3 * FF2 + gc), bu = *(const f32x4*)(cs + 3 * FF2 + FF + gc);
            const f32x4 zg0 = bg + wg[2] * g0 + wg[1] * gm1 + wg[0] * gm2, zu0 = bu + wu[2] * u0 + wu[1] * um1 + wu[0] * um2;
            const f32x4 zg1 = bg + wg[2] * g1 + wg[1] * g0 + wg[0] * gm1, zu1 = bu + wu[2] * u1 + wu[1] * u0 + wu[0] * um1;
            f32x4 r0, r1;
#pragma unroll
            for (int i = 0; i < 4; ++i) { r0[i] = (zg0[i] * zu0[i]) * __builtin_amdgcn_rcpf(1.f + __builtin_amdgcn_exp2f(zg0[i])); r1[i] = (zg1[i] * zu1[i]) * __builtin_amdgcn_rcpf(1.f + __builtin_amdgcn_exp2f(zg1[i])); }
            u32x2 w0, w1; w0.x = pg8::cvt_pk_bf16(r0[0], r0[1]); w0.y = pg8::cvt_pk_bf16(r0[2], r0[3]); w1.x = pg8::cvt_pk_bf16(r1[0], r1[1]); w1.y = pg8::cvt_pk_bf16(r1[2], r1[3]);
            *(u32x2*)(GB + (size_t)pm * 256 * FF + gc) = w0; *(u32x2*)(GB + ((size_t)pm * 256 + 1) * FF + gc) = w1;
        }
    }
    SEAM(7);
    if (IN(8)) {
        pg8::Gemm g{GB, WDN, M, DM, FF}; pg8::StaticOrder S; S.init(M, DM, F.G, (int)blockIdx.x);
        pg8::EpiDown E{X1B, X2B, SSQ2};
        pg8::gemm_phase<pg8::EpiDown, pg8::StaticOrder, true, true>(F.lds + RING_OFF, g, S, E, F.wave);
    }
    SEAM(8);
    if (IN(9)) {
        const int laneL = lane_now();
        const bool gp = (F.G == 256);
        const int gw = (gp ? (int)(blockIdx.x >> 3) : F.vcu) * NWAVES + F.wave, NGW = (gp ? 32 : F.G) * NWAVES, m0 = gp ? (int)(blockIdx.x & 7) * 8192 : 0, nm = gp ? 8192 : M;
        for (int mm = gw; mm < nm; mm += 4 * NGW) {
            u32x4 xv[4][2]; float sq[4];
#pragma unroll
            for (int r = 0; r < 4; ++r) { const int m = m0 + ((mm + r * NGW < nm) ? mm + r * NGW : mm); const u32x4* xr = (const u32x4*)(X2B + (size_t)m * DM) + laneL;
                xv[r][0] = xr[0]; xv[r][1] = xr[64]; sq[r] = (laneL < 16) ? SSQ2[(size_t)m * 16 + laneL] : 0.f; }
#pragma unroll
            for (int r = 0; r < 4; ++r) { const int m = m0 + ((mm + r * NGW < nm) ? mm + r * NGW : mm); float q = sq[r];
                q += __shfl_xor(q, 1); q += __shfl_xor(q, 2); q += __shfl_xor(q, 4); q += __shfl_xor(q, 8);
                const float rstd = rsqrtf(__shfl(q, 0) * (1.f / DM) + NORM_EPS);
                f32x4* orow = (f32x4*)(out + (size_t)m * DM) + 2 * laneL;
#pragma unroll
                for (int j = 0; j < 2; ++j) { f32x4 a, b; pg8::unpack8(xv[r][j], a, b);
                    const f32x4 g0 = ((const f32x4*)g_final)[2 * laneL + 128 * j], g1 = ((const f32x4*)g_final)[2 * laneL + 128 * j + 1];
                    orow[128 * j] = a * rstd * g0; orow[128 * j + 1] = b * rstd * g1; } }
        }
    }
#undef IN
#undef SEAM
}

static void launch_mk(Args a, int lo, int hi, int li, int grid, hipStream_t stream, int opt = 0) {
    a.ph_lo = lo; a.ph_hi = hi; a.li = li; a.opt = opt;
    hipLaunchKernelGGL(mk_fwd, dim3(grid), dim3(NWAVES * 64), LDS_BYTES, stream, a);
}
extern "C" void kernel_launch(void* const* d_in, const int* in_sizes, int n_in, void* d_out, int out_size, void* d_ws, size_t ws_size, hipStream_t stream) {
    static int grid = 0;
    if (grid == 0) {
        if (n_in != 17 || out_size != M * DM || ws_size < WS_END) { fprintf(stderr, "kernel_launch: unexpected shapes (n_in %d out %d ws %zu)\n", n_in, out_size, ws_size); grid = -1; return; }
        int dev = 0, cus = 0, per_cu = 0;
        if (hipGetDevice(&dev) != hipSuccess || hipDeviceGetAttribute(&cus, hipDeviceAttributeMultiprocessorCount, dev) != hipSuccess) { grid = -1; return; }
        if (hipFuncSetAttribute((const void*)mk_fwd, hipFuncAttributeMaxDynamicSharedMemorySize, LDS_BYTES) != hipSuccess) { fprintf(stderr, "kernel_launch: hipFuncSetAttribute failed\n"); grid = -1; return; }
        if (hipOccupancyMaxActiveBlocksPerMultiprocessor(&per_cu, (const void*)mk_fwd, NWAVES * 64, LDS_BYTES) != hipSuccess || per_cu < 1) { fprintf(stderr, "kernel_launch: occupancy query says %d\n", per_cu); }
        (void)hipGetLastError();
        grid = cus;
    }
    if (grid < 0) return;
    if (hipMemsetAsync((char*)d_ws + WS_CTL, 0, CTL_ZERO_BYTES, stream) != hipSuccess) return;
    unsigned char* ws = (unsigned char*)d_ws;
    Args a{};
    for (int i = 0; i < 17; ++i) a.in[i] = (const float*)d_in[i];
    a.out = (float*)d_out; a.ws = ws;
    launch_mk(a, 0, N_PHASES, 0, grid, stream);
}
```

```cpp
#include <hip/hip_runtime.h>
#include <cstdio>
#include <cstdint>
#include <cmath>

typedef unsigned short bf16;
typedef short bf16x8 __attribute__((ext_vector_type(8)));
typedef float f32x4 __attribute__((ext_vector_type(4)));
typedef float f32x16 __attribute__((ext_vector_type(16)));
typedef unsigned u32x4 __attribute__((ext_vector_type(4)));
typedef unsigned u32x2 __attribute__((ext_vector_type(2)));

constexpr int BATCH = 8, SEQ = 8192, DM = 1024, M = BATCH * SEQ;
constexpr int NH = 4, HD = 64, DV = 128;
constexpr int DIN = 5120, PP = 4096;
constexpr int FF = 2816, FF2 = 5632;
constexpr int C_Q1 = 0, C_Q2 = 256, C_QR = 512, C_KR = 768, C_VR = 1024, C_GR = 1536, C_GA = 2048, C_GB = 3072;
constexpr float LOG2E = 1.4426950408889634f;
constexpr float C2 = 0.125f * LOG2E;
constexpr float NORM_EPS = 1e-6f, SUBLN_EPS = 1e-5f;
constexpr float LAM_INIT = 0.2f;

constexpr size_t MiB = 1u << 20;
constexpr size_t WS_CTL = 0;
constexpr size_t WS_CONV = 512 * 1024;
constexpr size_t WS_SSQ1 = 2 * MiB;
constexpr size_t WS_SSQ2 = 6 * MiB;
constexpr size_t WS_GST = 10 * MiB;
constexpr size_t WS_WIN = 20 * MiB, WS_WD = 30 * MiB, WS_WR = 31 * MiB, WS_WO = 32 * MiB, WS_WUP = 34 * MiB, WS_WDN = 45 * MiB;
constexpr size_t WS_XN = 64 * MiB;
constexpr size_t WS_PROJ = 192 * MiB;
constexpr size_t WS_KVP = 704 * MiB;
constexpr size_t WS_A = 864 * MiB, WS_R = 928 * MiB;
constexpr size_t WS_X1B = 192 * MiB;
constexpr size_t WS_G = 320 * MiB;
constexpr size_t WS_U = 672 * MiB;
constexpr size_t WS_HB = 672 * MiB;
constexpr size_t WS_END = 1024 * MiB;

__device__ __forceinline__ unsigned f2bf(float f) { unsigned u = __builtin_bit_cast(unsigned, f); return (u + 0x7fffu + ((u >> 16) & 1u)) >> 16; }
__device__ __forceinline__ unsigned pk2(float lo, float hi) { return f2bf(lo) | (f2bf(hi) << 16); }
__device__ __forceinline__ float bf2f(unsigned short b) { return __builtin_bit_cast(float, (unsigned)b << 16); }
__device__ __forceinline__ float bflo(unsigned w) { return __builtin_bit_cast(float, w << 16); }
__device__ __forceinline__ float bfhi(unsigned w) { return __builtin_bit_cast(float, w & 0xffff0000u); }
__device__ __forceinline__ float wave_sum(float v) {
#pragma unroll
    for (int o = 1; o < 64; o <<= 1) v += __shfl_xor(v, o);
    return v;
}
__device__ __forceinline__ float wave_max(float v) {
#pragma unroll
    for (int o = 1; o < 64; o <<= 1) v = fmaxf(v, __shfl_xor(v, o));
    return v;
}
__device__ __forceinline__ float sigmoidf_(float x) { return 1.f / (1.f + __expf(-x)); }
__device__ __forceinline__ float siluf_(float x) { return x / (1.f + __expf(-x)); }
__device__ __forceinline__ float alibi_sl2(int h) { return h == 0 ? 0.36067376022224085f : h == 1 ? 0.09016844005556021f : h == 2 ? 0.022542110013890053f : 0.005635527503472513f; }
__device__ __forceinline__ float ret_lg2(int h) { return h == 0 ? -0.04580368961312479f : h == 1 ? -0.02272007650008353f : h == 2 ? -0.011315313227834146f : -0.005646563141142063f; }

__device__ __forceinline__ int wt_src_col(int n, int mode) {
    if (mode == 0) return n;
    const int t = n >> 8, w = n & 255;
    return (w < 128) ? (t * 128 + w) : (FF + t * 128 + (w - 128));
}
__device__ __forceinline__ int lane_now() { int l; asm volatile("v_mbcnt_lo_u32_b32 %0, -1, 0\n\tv_mbcnt_hi_u32_b32 %0, -1, %0" : "=v"(l)); return l; }
namespace pg8 {
#define PG8_LAS __attribute__((address_space(3)))
typedef unsigned short bf16_t;
typedef short bf16x8 __attribute__((ext_vector_type(8)));
typedef float f32x4 __attribute__((ext_vector_type(4)));
typedef unsigned u32x4 __attribute__((ext_vector_type(4)));
constexpr int BM = 256, BK = 64, HALF = 128, HTB = HALF * BK * 2  , STAGE_BYTES = 8 * HTB, NXCD = 8, WGM = 8;

__host__ __device__ __forceinline__ int lds_byte(int r, int c) { const int st = (r >> 4) * 2 + (c >> 5), rr = r & 15, cc = c & 31, ob = rr * 64 + cc * 2; return st * 1024 + (ob ^ (((ob >> 9) & 1) << 5)); }
__host__ __device__ __forceinline__ void stage_rc(int b, int& R, int& C) { const int st = b / 1024, sb = b % 1024, swz = sb ^ (((sb >> 9) & 1) << 5); R = (st >> 1) * 16 + swz / 64; C = (st & 1) * 32 + (swz % 64) / 2; }
__host__ __device__ __forceinline__ int perm32(int rho) { const int n = rho >> 4, i = rho & 15; return 8 * (i >> 2) + 4 * n + (i & 3); }

struct Unit { int pm, pn, seg; };
struct Gemm { const bf16_t* A; const bf16_t* Bt; int M, N, K; const bf16_t* A2; const bf16_t* Bt2; };

struct StaticOrder {
    int nM, nN, nwg, G, c;
    __host__ __device__ void init(int M, int N, int G_, int c_) { nM = M / BM; nN = N / BM; nwg = nM * nN; G = G_; c = c_; }
    __host__ __device__ bool next(int i, Unit& u) const {
        const long L = (long)i * G + c; if (L >= nwg) return false;
        int wgid = (int)L; { const int q = nwg / NXCD, r = nwg % NXCD, xcd = wgid % NXCD, off = wgid / NXCD; wgid = (xcd < r ? xcd * (q + 1) : r * (q + 1) + (xcd - r) * q) + off; }
        const int nig = WGM * nN, gid = wgid / nig, fm = gid * WGM, gsz = (nM - fm) < WGM ? (nM - fm) : WGM;
        u.pm = fm + ((wgid % nig) % gsz); u.pn = (wgid % nig) / gsz; u.seg = 0; return true;
    }
    __device__ __forceinline__ void a_ready(const Unit&) const {}
    __device__ __forceinline__ void done(const Unit&) const {}
};

struct DualOrder {
    StaticOrder S;
    __host__ __device__ void init(int M, int N, int G_, int c_) { S.init(M, N, G_, c_); }
    __host__ __device__ bool next(int i, Unit& u) const { if (!S.next(i >> 1, u)) return false; u.seg = i & 1; return true; }
    __device__ __forceinline__ void a_ready(const Unit&) const {}
    __device__ __forceinline__ void done(const Unit&) const {}
};

typedef float f32x2 __attribute__((ext_vector_type(2))); typedef __bf16 bf16x2_t __attribute__((ext_vector_type(2)));
__device__ __forceinline__ unsigned cvt_pk_bf16(float lo, float hi) { f32x2 v = {lo, hi}; bf16x2_t b = __builtin_convertvector(v, bf16x2_t); return __builtin_bit_cast(unsigned, b); }
__device__ __forceinline__ float fast_sigmoid(float x) { return __builtin_amdgcn_rcpf(1.f + __builtin_amdgcn_exp2f(-1.4426950408889634f * x)); }
__device__ __forceinline__ u32x4 pack8(const f32x4 a, const f32x4 b) { u32x4 w; w.x = cvt_pk_bf16(a[0], a[1]); w.y = cvt_pk_bf16(a[2], a[3]); w.z = cvt_pk_bf16(b[0], b[1]); w.w = cvt_pk_bf16(b[2], b[3]); return w; }
__device__ __forceinline__ void unpack8(const u32x4 w, f32x4& a, f32x4& b) {
    a[0] = __builtin_bit_cast(float, w.x << 16); a[1] = __builtin_bit_cast(float, w.x & 0xffff0000u); a[2] = __builtin_bit_cast(float, w.y << 16); a[3] = __builtin_bit_cast(float, w.y & 0xffff0000u);
    b[0] = __builtin_bit_cast(float, w.z << 16); b[1] = __builtin_bit_cast(float, w.z & 0xffff0000u); b[2] = __builtin_bit_cast(float, w.w << 16); b[3] = __builtin_bit_cast(float, w.w & 0xffff0000u); }

__device__ __forceinline__ unsigned sig4_u8(const f32x4 v) { unsigned w = 0u;
#pragma unroll
    for (int i = 0; i < 4; ++i) { const float e = __builtin_amdgcn_exp2f(-1.4426950408889634f * v[i]); const unsigned q = (unsigned)(__builtin_amdgcn_rcpf(__builtin_fmaf(e, 1.f / 255.f, 1.f / 255.f)) + 0.5f); w |= q << (8 * i); }
    return w; }
__device__ __forceinline__ f32x4 u8x4_f32(const unsigned w) { return (f32x4){(float)(w & 255u), (float)((w >> 8) & 255u), (float)((w >> 16) & 255u), (float)(w >> 24)} * (1.f / 255.f); }
struct EpiProj {
    static constexpr bool PERM = true, AFTER_DRAIN = false, PERMA = false, PREFETCH = false, DUAL = false;
    bf16_t* P; bf16_t* KV; unsigned* KN;
    __device__ __forceinline__ void operator()(const f32x4 (&acc)[2][2][4][2], const Unit& u, int wr, int wc, int fr, int fq) const {
        const int pn = u.pn, pm = u.pm;
        if (pn >= 2 && pn < 6) {
            const size_t tile0 = ((size_t)(pm >> 5) * 4 * 128 + (size_t)((pm & 31) * 4 + wr)) * 16384;
            if (pn < 4) {
#pragma unroll
                for (int bj = 0; bj < 2; ++bj) { bf16_t* hb = KV + tile0 + (size_t)(2 * bj + (wc >> 1)) * 128 * 16384 + (pn == 3 ? 4096 : 0) + ((wc & 1) * 4 + fq) * 512 + fr * 8;
#pragma unroll
                    for (int ai = 0; ai < 2; ++ai)
#pragma unroll
                        for (int m = 0; m < 4; ++m) *(u32x4*)(hb + (size_t)ai * 2 * 16384 + m * 128) = pack8(acc[ai][bj][m][0], acc[ai][bj][m][1]); }
#pragma unroll
                for (int bj = 0; bj < 2; ++bj) { float hm = 0.f;
#pragma unroll
                    for (int ai = 0; ai < 2; ++ai)
#pragma unroll
                        for (int m = 0; m < 4; ++m) { const f32x4 a = acc[ai][bj][m][0], b = acc[ai][bj][m][1];
                            float q = (a[0] * a[0] + a[1] * a[1]) + (a[2] * a[2] + a[3] * a[3]) + (b[0] * b[0] + b[1] * b[1]) + (b[2] * b[2] + b[3] * b[3]);
                            q += __shfl_xor(q, 16); q += __shfl_xor(q, 32); hm = fmaxf(hm, q); }
                    hm = fmaxf(hm, __shfl_xor(hm, 1)); hm = fmaxf(hm, __shfl_xor(hm, 2)); hm = fmaxf(hm, __shfl_xor(hm, 4)); hm = fmaxf(hm, __shfl_xor(hm, 8));
                    if (fr == 0 && fq == 0) atomicMax(KN + ((pm >> 5) * 4 + 2 * bj + (wc >> 1)) * 2 + (pn - 2), __float_as_uint(hm * 1.01f)); }
            } else {
#pragma unroll
                for (int bj = 0; bj < 2; ++bj) { const int head = (pn - 4) * 2 + bj; const float sl = alibi_sl2(head);
                    bf16_t* hb = KV + tile0 + (size_t)head * 128 * 16384 + 8192 + wc * 2048 + fr * 32 + fq * 8;
#pragma unroll
                    for (int m = 0; m < 4; ++m) { const float sc = __builtin_amdgcn_exp2f(sl * (float)((fr + 16 * m) - 63));
#pragma unroll
                        for (int ai = 0; ai < 2; ++ai) *(u32x4*)(hb + (size_t)ai * 2 * 16384 + m * 512) = pack8(acc[ai][bj][m][0] * sc, acc[ai][bj][m][1] * sc); } }
            }
        } else {
            const int cpn = (pn < 2) ? pn : pn - 4;
            bf16_t* base = P + (size_t)(pm * BM + wr * 64 + fr) * PP + cpn * BM + wc * 32 + 8 * fq;
            if (pn >= 12) {
                unsigned char* gq = (unsigned char*)(P + (size_t)(pm * BM + wr * 64 + fr) * PP + C_GA) + (pn - 12) * 256 + wc * 64 + fq * 16;
#pragma unroll
                for (int ai = 0; ai < 2; ++ai)
#pragma unroll
                    for (int m = 0; m < 4; ++m) { u32x4 w; w.x = sig4_u8(acc[ai][0][m][0]); w.y = sig4_u8(acc[ai][0][m][1]); w.z = sig4_u8(acc[ai][1][m][0]); w.w = sig4_u8(acc[ai][1][m][1]);
                        *(u32x4*)(gq + (size_t)(ai * HALF + m * 16) * (PP * 2)) = w; }
            } else if (pn >= 10) {
#pragma unroll
                for (int ai = 0; ai < 2; ++ai)
#pragma unroll
                    for (int m = 0; m < 4; ++m)
#pragma unroll
                        for (int bj = 0; bj < 2; ++bj) { f32x4 a = acc[ai][bj][m][0], b = acc[ai][bj][m][1];
#pragma unroll
                            for (int i = 0; i < 4; ++i) { a[i] *= fast_sigmoid(a[i]); b[i] *= fast_sigmoid(b[i]); }
                            *(u32x4*)(base + (size_t)(ai * HALF + m * 16) * PP + bj * HALF) = pack8(a, b); }
            } else {
            const float sc = (pn < 2) ? C2 : (pn == 7) ? 0.125f : 1.f;
#pragma unroll
            for (int ai = 0; ai < 2; ++ai)
#pragma unroll
                for (int m = 0; m < 4; ++m)
#pragma unroll
                    for (int bj = 0; bj < 2; ++bj) *(u32x4*)(base + (size_t)(ai * HALF + m * 16) * PP + bj * HALF) = pack8(acc[ai][bj][m][0] * sc, acc[ai][bj][m][1] * sc);
            if (pn < 2) {
#pragma unroll
                for (int bj = 0; bj < 2; ++bj) { float hm = 0.f;
#pragma unroll
                    for (int ai = 0; ai < 2; ++ai)
#pragma unroll
                        for (int m = 0; m < 4; ++m) { const f32x4 a = acc[ai][bj][m][0], b = acc[ai][bj][m][1];
                            float q = (a[0] * a[0] + a[1] * a[1]) + (a[2] * a[2] + a[3] * a[3]) + (b[0] * b[0] + b[1] * b[1]) + (b[2] * b[2] + b[3] * b[3]);
                            q += __shfl_xor(q, 16); q += __shfl_xor(q, 32); hm = fmaxf(hm, q); }
                    hm = fmaxf(hm, __shfl_xor(hm, 1)); hm = fmaxf(hm, __shfl_xor(hm, 2)); hm = fmaxf(hm, __shfl_xor(hm, 4)); hm = fmaxf(hm, __shfl_xor(hm, 8));
                    if (fr == 0 && fq == 0) atomicMax(KN + 64 + ((pm >> 5) * 4 + 2 * bj + (wc >> 1)) * 2 + pn, __float_as_uint(hm * (C2 * C2) * 1.01f)); }
            }
            }
        }
    }
};
struct EpiMerge2 {
    static constexpr bool PERM = true, AFTER_DRAIN = false, PERMA = false, PREFETCH = false, DUAL = true;
    const bf16_t* P; bf16_t* MG;
    static __device__ __forceinline__ f32x4 u8f(const unsigned w) { return (f32x4){(float)(w & 255u), (float)((w >> 8) & 255u), (float)((w >> 16) & 255u), (float)(w >> 24)}; }
    static __device__ __forceinline__ f32x4 max1(const f32x4 v) { return (f32x4){fmaxf(v[0], 1.f), fmaxf(v[1], 1.f), fmaxf(v[2], 1.f), fmaxf(v[3], 1.f)}; }
    __device__ __forceinline__ void mid(f32x4 (&acc)[2][2][4][2], const Unit& u, int wr, int wc, int fr, int fq) const {
        const unsigned char* gq = (const unsigned char*)(P + (size_t)(u.pm * BM + wr * 64 + fr) * PP + C_GA) + u.pn * 256 + wc * 64 + fq * 16;
#pragma unroll
        for (int ai = 0; ai < 2; ++ai)
#pragma unroll
            for (int m = 0; m < 4; ++m) { const u32x4 wa = *(const u32x4*)(gq + (size_t)(ai * HALF + m * 16) * (PP * 2)), wq = *(const u32x4*)(gq + 1024 + (size_t)(ai * HALF + m * 16) * (PP * 2));
#pragma unroll
                for (int bj = 0; bj < 2; ++bj)
#pragma unroll
                    for (int n = 0; n < 2; ++n) { const unsigned da = bj ? (n ? wa.w : wa.z) : (n ? wa.y : wa.x), dr = bj ? (n ? wq.w : wq.z) : (n ? wq.y : wq.x);
                        const f32x4 qa = u8f(da), qr = max1(u8f(dr));
#pragma unroll
                        for (int i = 0; i < 4; ++i) acc[ai][bj][m][n][i] *= qa[i] * __builtin_amdgcn_rcpf(qr[i]); } }
    }
    __device__ __forceinline__ void operator()(const f32x4 (&acc)[2][2][4][2], const Unit& u, int wr, int wc, int fr, int fq) const {
        const int row0 = u.pm * BM + wr * 64 + fr, col0 = u.pn * BM + wc * 32 + 8 * fq;
        const unsigned char* gq = (const unsigned char*)(P + (size_t)row0 * PP + C_GA) + 1024 + u.pn * 256 + wc * 64 + fq * 16;
#pragma unroll
        for (int ai = 0; ai < 2; ++ai)
#pragma unroll
            for (int m = 0; m < 4; ++m) { const int row = row0 + ai * HALF + m * 16;
                const u32x4 wq = *(const u32x4*)(gq + (size_t)(ai * HALF + m * 16) * (PP * 2));
#pragma unroll
                for (int bj = 0; bj < 2; ++bj) { const f32x4 s0 = max1(u8f(bj ? wq.z : wq.x)) * (1.f / 255.f), s1 = max1(u8f(bj ? wq.w : wq.y)) * (1.f / 255.f);
                    *(u32x4*)(MG + (size_t)row * DM + col0 + bj * HALF) = pack8(acc[ai][bj][m][0] * s0, acc[ai][bj][m][1] * s1); } }
    }
};
__device__ __forceinline__ void store_ssq(float* SSQ, float a, float b, int row0, int slot, int fq) {
    const int ra = row0 + (fq >> 1) * HALF + (fq & 1) * 32;
    SSQ[(size_t)ra * 16 + slot] = a; SSQ[(size_t)(ra + 16) * 16 + slot] = b;
}
struct EpiOutProj {
    static constexpr bool PERM = true, AFTER_DRAIN = false, PERMA = false, PREFETCH = false, DUAL = false;
    const float* X; bf16_t* X1B; float* SSQ;
    __device__ __forceinline__ void operator()(const f32x4 (&acc)[2][2][4][2], const Unit& u, int wr, int wc, int fr, int fq) const {
        const int row0 = u.pm * BM + wr * 64 + fr, col0 = u.pn * BM + wc * 32 + 8 * fq;
        float sa = 0.f, sb = 0.f;
#pragma unroll
        for (int ai = 0; ai < 2; ++ai)
#pragma unroll
            for (int m = 0; m < 4; ++m) { const int row = row0 + ai * HALF + m * 16; float s = 0.f;
#pragma unroll
                for (int bj = 0; bj < 2; ++bj) { const size_t off = (size_t)row * DM + col0 + bj * HALF;
                    const f32x4 v0 = *(const f32x4*)(X + off) + acc[ai][bj][m][0], v1 = *(const f32x4*)(X + off + 4) + acc[ai][bj][m][1];
                    *(u32x4*)(X1B + off) = pack8(v0, v1);
                    s += (v0[0] * v0[0] + v0[1] * v0[1]) + (v0[2] * v0[2] + v0[3] * v0[3]) + (v1[0] * v1[0] + v1[1] * v1[1]) + (v1[2] * v1[2] + v1[3] * v1[3]); }
                s += __shfl_xor(s, 16); s += __shfl_xor(s, 32); if (((ai * 4 + m) >> 1) == fq) { if (m & 1) sb = s; else sa = s; } }
        store_ssq(SSQ, sa, sb, row0, u.pn * 4 + wc, fq);
    }
};
__device__ __forceinline__ float dpp_shr1(float x) { return __builtin_bit_cast(float, __builtin_amdgcn_update_dpp(0, __builtin_bit_cast(int, x), 0x111, 0xf, 0xf, true)); }
__device__ __forceinline__ f32x4 row_shr1(const f32x4 v) {
    const float a = v[0], b = v[1], c = v[2], d = v[3];
    return (f32x4){dpp_shr1(a), dpp_shr1(b), dpp_shr1(c), dpp_shr1(d)};
}
struct EpiUpConv {
    static constexpr bool PERM = true, AFTER_DRAIN = false, PERMA = true, PREFETCH = true, DUAL = false;
    const float* SSQ; bf16_t* G; float* HB; const float* cw; const float* cb; PG8_LAS float* halo;
    __device__ __forceinline__ void prefetch(const Unit& u, int ui, int wid, int lane) const {
        const int fr = lane & 15, fq = lane >> 4;
#pragma unroll
        for (int i = 0; i < 2; ++i) { const int k = 2 * wid + i;
            __builtin_amdgcn_global_load_lds((const unsigned*)(SSQ + (size_t)(u.pm * BM + (k >> 3) * 128 + fr * 8 + (k & 7)) * 16 + 4 * fq), (PG8_LAS unsigned*)(halo + 2560 + k * 256), 16, 0, 0); }
        const int w = wid & 3, row = 2 * w + (lane >> 5), c = (lane & 31) * 4, gcb = u.pn * HALF;
        const float* src = (row < 6) ? cw + (row >> 1) * FF2 + (row & 1) * FF + gcb + c : cb + (row & 1) * FF + gcb + c;
        __builtin_amdgcn_global_load_lds((const unsigned*)src, (PG8_LAS unsigned*)(halo + 512 + (ui & 1) * 1024 + w * 256), 16, 0, 0);
    }
    __device__ __forceinline__ void operator()(f32x4 (&acc)[2][2][4][2], const Unit& u, int wr, int wc, int fr, int fq, int ui) const {
        const int pn = u.pn, pm = u.pm, tok0 = pm * BM + wr * 128 + fr * 8, cl = wc * 32 + 8 * fq;
        const bool seq_start = (pm & 31) == 0;
        PG8_LAS float* wt = halo + 512 + (ui & 1) * 1024;
#pragma unroll
        for (int ai = 0; ai < 2; ++ai)
#pragma unroll
            for (int m = 0; m < 4; ++m) { const f32x4 a = *(const PG8_LAS f32x4*)(halo + 2560 + ((wr * 8 + 4 * ai + m) * 64 + fq * 16 + fr) * 4);
                float sq = (a[0] + a[1]) + (a[2] + a[3]); sq += __shfl_xor(sq, 16); sq += __shfl_xor(sq, 32);
                const float r = rsqrtf(sq * (1.f / DM) + NORM_EPS);
#pragma unroll
                for (int bj = 0; bj < 2; ++bj)
#pragma unroll
                    for (int n = 0; n < 2; ++n) acc[ai][bj][m][n] = acc[ai][bj][m][n] * r; }
        if (fr == 15) {
#pragma unroll
            for (int bj = 0; bj < 2; ++bj)
#pragma unroll
                for (int n = 0; n < 2; ++n)
#pragma unroll
                    for (int q = 0; q < 2; ++q) { const f32x4 v = acc[1][bj][2 + q][n];
                        if (wr == 0) *(PG8_LAS f32x4*)(halo + q * 256 + bj * HALF + cl + 4 * n) = v;
                        else *(f32x4*)(HB + ((size_t)pm * 4 + 2 + q) * FF2 + pn * BM + bj * HALF + cl + 4 * n) = v; }
        }
        if (fr == 0 && wr == 0) {
#pragma unroll
            for (int bj = 0; bj < 2; ++bj)
#pragma unroll
                for (int n = 0; n < 2; ++n)
#pragma unroll
                    for (int q = 0; q < 2; ++q) *(f32x4*)(HB + ((size_t)pm * 4 + q) * FF2 + pn * BM + bj * HALF + cl + 4 * n) = acc[0][bj][q][n];
        }
        asm volatile("s_waitcnt lgkmcnt(0)\n\ts_barrier" ::: "memory");
        const int gc = pn * HALF + cl;
        const float hk = (wr == 1 && fr == 0) ? 1.f : 0.f;
#pragma unroll
        for (int jh = 0; jh < 2; ++jh) {
            u32x2 gpk[4];
#pragma unroll
            for (int n = 0; n < 2; ++n) {
                f32x4 g6 = {}, g7 = {}, u6 = {}, u7 = {};
                if (jh == 0) {
                    g6 = row_shr1(acc[1][0][2][n]); g7 = row_shr1(acc[1][0][3][n]); u6 = row_shr1(acc[1][1][2][n]); u7 = row_shr1(acc[1][1][3][n]);
                    g6 = g6 + *(const PG8_LAS f32x4*)(halo + cl + 4 * n) * hk; g7 = g7 + *(const PG8_LAS f32x4*)(halo + 256 + cl + 4 * n) * hk;
                    u6 = u6 + *(const PG8_LAS f32x4*)(halo + HALF + cl + 4 * n) * hk; u7 = u7 + *(const PG8_LAS f32x4*)(halo + 256 + HALF + cl + 4 * n) * hk;
                }
                const f32x4 wg0 = *(const PG8_LAS f32x4*)(wt + 0 * 128 + cl + 4 * n), wg1 = *(const PG8_LAS f32x4*)(wt + 2 * 128 + cl + 4 * n), wg2 = *(const PG8_LAS f32x4*)(wt + 4 * 128 + cl + 4 * n), bg = *(const PG8_LAS f32x4*)(wt + 6 * 128 + cl + 4 * n);
                const f32x4 wu0 = *(const PG8_LAS f32x4*)(wt + 1 * 128 + cl + 4 * n), wu1 = *(const PG8_LAS f32x4*)(wt + 3 * 128 + cl + 4 * n), wu2 = *(const PG8_LAS f32x4*)(wt + 5 * 128 + cl + 4 * n), bu = *(const PG8_LAS f32x4*)(wt + 7 * 128 + cl + 4 * n);
#pragma unroll
                for (int jj = 0; jj < 4; ++jj) { const int j = 4 * jh + jj;
                    const f32x4 vg = acc[j >> 2][0][j & 3][n], vu = acc[j >> 2][1][j & 3][n];
                    const int j1 = (j >= 1) ? j - 1 : 0, j2 = (j >= 2) ? j - 2 : 0;
                    const f32x4 pg1 = (j >= 1) ? acc[j1 >> 2][0][j1 & 3][n] : g7, pg2 = (j >= 2) ? acc[j2 >> 2][0][j2 & 3][n] : (j == 1 ? g7 : g6);
                    const f32x4 pu1 = (j >= 1) ? acc[j1 >> 2][1][j1 & 3][n] : u7, pu2 = (j >= 2) ? acc[j2 >> 2][1][j2 & 3][n] : (j == 1 ? u7 : u6);
                    f32x4 zg = bg + wg2 * vg + wg1 * pg1 + wg0 * pg2; asm volatile("" : "+v"(zg));
                    f32x4 zu = bu + wu2 * vu + wu1 * pu1 + wu0 * pu2; asm volatile("" : "+v"(zu));
                    f32x4 r;
#pragma unroll
                    for (int i = 0; i < 4; ++i) r[i] = (zg[i] * zu[i]) * __builtin_amdgcn_rcpf(1.f + __builtin_amdgcn_exp2f(zg[i]));
                    u32x2 w; w.x = cvt_pk_bf16(r[0], r[1]); w.y = cvt_pk_bf16(r[2], r[3]);
                    const bool skip = (wr == 0) && (fr == 0) && (j < 2) && !seq_start;
                    if (n == 0) { gpk[jj] = w; asm volatile("" : "+v"(gpk[jj].x), "+v"(gpk[jj].y)); }
                    else if (!skip) *(u32x4*)(G + (size_t)(tok0 + j) * FF + gc) = (u32x4){gpk[jj].x, gpk[jj].y, w.x, w.y};
                }
                __builtin_amdgcn_sched_barrier(0);
            }
        }
    }
};
struct EpiDown {
    static constexpr bool PERM = true, AFTER_DRAIN = false, PERMA = false, PREFETCH = false, DUAL = false;
    const bf16_t* X1B; bf16_t* X2B; float* SSQ;
    __device__ __forceinline__ void operator()(const f32x4 (&acc)[2][2][4][2], const Unit& u, int wr, int wc, int fr, int fq) const {
        const int row0 = u.pm * BM + wr * 64 + fr, col0 = u.pn * BM + wc * 32 + 8 * fq;
        float sa = 0.f, sb = 0.f;
#pragma unroll
        for (int ai = 0; ai < 2; ++ai)
#pragma unroll
            for (int m = 0; m < 4; ++m) { const int row = row0 + ai * HALF + m * 16; float s = 0.f;
#pragma unroll
                for (int bj = 0; bj < 2; ++bj) { const size_t off = (size_t)row * DM + col0 + bj * HALF;
                    f32x4 v0, v1; unpack8(*(const u32x4*)(X1B + off), v0, v1); v0 = v0 + acc[ai][bj][m][0]; v1 = v1 + acc[ai][bj][m][1];
                    *(u32x4*)(X2B + off) = pack8(v0, v1);
                    s += (v0[0] * v0[0] + v0[1] * v0[1]) + (v0[2] * v0[2] + v0[3] * v0[3]) + (v1[0] * v1[0] + v1[1] * v1[1]) + (v1[2] * v1[2] + v1[3] * v1[3]); }
                s += __shfl_xor(s, 16); s += __shfl_xor(s, 32); if (((ai * 4 + m) >> 1) == fq) { if (m & 1) sb = s; else sa = s; } }
        store_ssq(SSQ, sa, sb, row0, u.pn * 4 + wc, fq);
    }
};
template <class Epi, class Sched, bool ALIGN_EPI = false, bool SP2 = false>
__device__ __forceinline__ void gemm_phase(PG8_LAS unsigned char* lds, const Gemm g, const Sched& S, const Epi& E, const int wid) {
    const int lane = lane_now(), tid = wid * 64 + lane, wr = wid >> 2, wc = wid & 3, fr = lane & 15, fq = lane >> 4;
    const int K = g.K, nt = K / BK;
    unsigned voffA[2], voffB[2];
#pragma unroll
    for (int i = 0; i < 2; ++i) { int R, C; stage_rc(tid * 16 + i * 8192, R, C); const int Rb = Epi::PERM ? ((R & ~31) + perm32(R & 31)) : R;
        const int Ra = Epi::PERMA ? (128 * ((R >> 6) & 1) + 8 * (R & 15) + ((R >> 4) & 3)) : R;
        voffA[i] = (unsigned)(Ra * K + C) * 2u; voffB[i] = (unsigned)(Rb * K + C) * 2u; }
    const size_t kstep = (size_t)(BK * 2);
    const size_t hstep = (size_t)HALF * K * 2;
    const size_t tstep = 2 * hstep;
    const size_t hstepA = Epi::PERMA ? (size_t)4 * K * 2 : hstep;
    const unsigned ldsw = (unsigned)wid * 1024u;
    const int aoff = lds_byte(wr * 64 + fr, fq * 8), boff = lds_byte(wc * 32 + fr, fq * 8);
#define PG8_SA(b, h) (((b) * 2 + (h)) * HTB)
#define PG8_SB(b, h) ((4 + (b) * 2 + (h)) * HTB)
#define PG8_STAGE(bufoff, gbase, voff) do { _Pragma("unroll") for (int _i = 0; _i < 2; ++_i) \
        __builtin_amdgcn_global_load_lds((const unsigned*)((const char*)(gbase) + (voff)[_i]), (PG8_LAS unsigned*)(lds + (bufoff) + ldsw + _i * 8192), 16, 0, 0); } while (0)
#define PG8_LDA(dst, b, h) do { _Pragma("unroll") for (int m = 0; m < 4; ++m) _Pragma("unroll") for (int k = 0; k < 2; ++k) dst[m][k] = *(const PG8_LAS bf16x8*)(lds + PG8_SA(b, h) + aoff + m * 2048 + k * 1024); } while (0)
#define PG8_LDB(dst, b, h) do { _Pragma("unroll") for (int n = 0; n < 2; ++n) _Pragma("unroll") for (int k = 0; k < 2; ++k) dst[n][k] = *(const PG8_LAS bf16x8*)(lds + PG8_SB(b, h) + boff + n * 2048 + k * 1024); } while (0)
#define PG8_MMA(ai, bj, At, Bt) do { __builtin_amdgcn_s_setprio(1); _Pragma("unroll") for (int m = 0; m < 4; ++m) _Pragma("unroll") for (int n = 0; n < 2; ++n) _Pragma("unroll") for (int k = 0; k < 2; ++k) \
        acc[ai][bj][m][n] = __builtin_amdgcn_mfma_f32_16x16x32_bf16(Bt[n][k], At[m][k], acc[ai][bj][m][n], 0, 0, 0); __builtin_amdgcn_s_setprio(0); } while (0)
#define PG8_WAIT_V(n) asm volatile("s_waitcnt vmcnt(" #n ")" ::: "memory")
#define PG8_WAIT_L(n) asm volatile("s_waitcnt lgkmcnt(" #n ")" ::: "memory")
#define PG8_BAR __builtin_amdgcn_s_barrier()
#define PG8_SCHED __builtin_amdgcn_sched_barrier(0)
    Unit cur, nxt; int ui = 0;
    if (!S.next(0, cur)) return;
    f32x4 acc[2][2][4][2];
#pragma unroll
    for (int a = 0; a < 2; ++a)
#pragma unroll
        for (int b = 0; b < 2; ++b)
#pragma unroll
            for (int m = 0; m < 4; ++m)
#pragma unroll
                for (int n = 0; n < 2; ++n) acc[a][b][m][n] = (f32x4){0.f, 0.f, 0.f, 0.f};
    bf16x8 At[4][2], B0[2][2], B1[2][2];
    const char* cA = (const char*)((Epi::DUAL && cur.seg) ? g.A2 : g.A) + (size_t)cur.pm * tstep; const char* cB = (const char*)((Epi::DUAL && cur.seg) ? g.Bt2 : g.Bt) + (size_t)cur.pn * tstep;
    S.a_ready(cur);
    if constexpr (Epi::PREFETCH) E.prefetch(cur, 0, wid, lane);
    if constexpr (SP2) {
        PG8_STAGE(PG8_SB(0, 0), cB, voffB); PG8_STAGE(PG8_SB(0, 1), cB + hstep, voffB); PG8_STAGE(PG8_SA(0, 0), cA, voffA); PG8_STAGE(PG8_SA(0, 1), cA + hstepA, voffA);
        if (wr == 1) PG8_BAR;
        PG8_WAIT_V(2); PG8_BAR;
        PG8_STAGE(PG8_SB(1, 0), cB + kstep, voffB); PG8_STAGE(PG8_SA(1, 0), cA + kstep, voffA); PG8_STAGE(PG8_SB(1, 1), cB + hstep + kstep, voffB);
        PG8_WAIT_V(6); PG8_BAR;
    } else {
        PG8_STAGE(PG8_SB(0, 0), cB, voffB); PG8_STAGE(PG8_SA(0, 0), cA, voffA); PG8_STAGE(PG8_SB(0, 1), cB + hstep, voffB); PG8_STAGE(PG8_SA(0, 1), cA + hstepA, voffA);
        if (wr == 1) PG8_BAR;
        PG8_WAIT_V(4); PG8_BAR;
        PG8_STAGE(PG8_SB(1, 0), cB + kstep, voffB); PG8_STAGE(PG8_SA(1, 0), cA + kstep, voffA); PG8_STAGE(PG8_SB(1, 1), cB + hstep + kstep, voffB);
        PG8_WAIT_V(6); PG8_BAR;
    }
    for (;;) {
        const bool has_next = S.next(ui + 1, nxt);
        const char* nA = has_next ? (const char*)((Epi::DUAL && nxt.seg) ? g.A2 : g.A) + (size_t)nxt.pm * tstep : cA; const char* nB = has_next ? (const char*)((Epi::DUAL && nxt.seg) ? g.Bt2 : g.Bt) + (size_t)nxt.pn * tstep : cB;
        for (int t = 0; t < nt; t += 2) {
            const bool last = (t == nt - 2);
            const char* a1 = cA + (size_t)(t + 1) * kstep;
            const char* a2 = last ? nA : cA + (size_t)(t + 2) * kstep; const char* b2 = last ? nB : cB + (size_t)(t + 2) * kstep;
            const char* a3 = a2 + kstep; const char* b3 = b2 + kstep;
            if (last && has_next) S.a_ready(nxt);
            if constexpr (SP2) {
            PG8_LDB(B0, 0, 0); PG8_LDB(B1, 0, 1); PG8_SCHED; PG8_LDA(At, 0, 0); PG8_STAGE(PG8_SA(1, 1), a1 + hstepA, voffA);
            PG8_WAIT_V(8); PG8_WAIT_L(0); PG8_BAR; PG8_MMA(0, 0, At, B0); PG8_MMA(0, 1, At, B1); PG8_BAR; PG8_SCHED;
            PG8_LDA(At, 0, 1); PG8_STAGE(PG8_SB(0, 0), b2, voffB); PG8_STAGE(PG8_SB(0, 1), b2 + hstep, voffB); PG8_STAGE(PG8_SA(0, 0), a2, voffA);
            PG8_WAIT_V(8); PG8_WAIT_L(0); PG8_BAR; PG8_MMA(1, 0, At, B0); PG8_MMA(1, 1, At, B1); PG8_BAR; PG8_SCHED;
            PG8_LDB(B0, 1, 0); PG8_LDB(B1, 1, 1); PG8_SCHED; PG8_LDA(At, 1, 0); PG8_STAGE(PG8_SA(0, 1), a2 + hstepA, voffA);
            PG8_WAIT_V(8); PG8_WAIT_L(0); PG8_BAR; PG8_MMA(0, 0, At, B0); PG8_MMA(0, 1, At, B1); PG8_BAR; PG8_SCHED;
            PG8_LDA(At, 1, 1); PG8_STAGE(PG8_SB(1, 0), b3, voffB); PG8_STAGE(PG8_SB(1, 1), b3 + hstep, voffB); PG8_STAGE(PG8_SA(1, 0), a3, voffA);
            PG8_WAIT_V(8); PG8_WAIT_L(0); PG8_BAR; PG8_MMA(1, 0, At, B0); PG8_MMA(1, 1, At, B1); PG8_BAR; PG8_SCHED;
            } else {
            PG8_LDB(B0, 0, 0); PG8_SCHED; PG8_LDA(At, 0, 0); PG8_STAGE(PG8_SA(1, 1), a1 + hstepA, voffA);
            PG8_WAIT_L(8); PG8_BAR; PG8_WAIT_L(0); PG8_MMA(0, 0, At, B0); PG8_BAR; PG8_SCHED;
            PG8_LDB(B1, 0, 1); PG8_STAGE(PG8_SB(0, 0), b2, voffB);
            PG8_BAR; PG8_WAIT_L(0); PG8_MMA(0, 1, At, B1); PG8_BAR;
            PG8_LDA(At, 0, 1); PG8_STAGE(PG8_SA(0, 0), a2, voffA);
            PG8_BAR; PG8_WAIT_L(0); PG8_MMA(1, 0, At, B0); PG8_BAR; PG8_SCHED;
            PG8_STAGE(PG8_SB(0, 1), b2 + hstep, voffB);
            PG8_WAIT_V(6); PG8_BAR; PG8_MMA(1, 1, At, B1); PG8_BAR;
            PG8_LDB(B0, 1, 0); PG8_SCHED; PG8_LDA(At, 1, 0); PG8_STAGE(PG8_SA(0, 1), a2 + hstepA, voffA);
            PG8_WAIT_L(8); PG8_BAR; PG8_WAIT_L(0); PG8_MMA(0, 0, At, B0); PG8_BAR; PG8_SCHED;
            PG8_LDB(B1, 1, 1); PG8_STAGE(PG8_SB(1, 0), b3, voffB);
            PG8_BAR; PG8_WAIT_L(0); PG8_MMA(0, 1, At, B1); PG8_BAR;
            PG8_LDA(At, 1, 1); PG8_STAGE(PG8_SA(1, 0), a3, voffA);
            PG8_BAR; PG8_WAIT_L(0); PG8_MMA(1, 0, At, B0); PG8_BAR; PG8_SCHED;
            PG8_STAGE(PG8_SB(1, 1), b3 + hstep, voffB);
            PG8_WAIT_V(6); PG8_BAR; PG8_MMA(1, 1, At, B1); PG8_BAR;
            }
        }
        if constexpr (ALIGN_EPI) { if (wr == 0) PG8_BAR; }
        if constexpr (!Epi::AFTER_DRAIN) { if constexpr (Epi::PREFETCH) E(acc, cur, wr, wc, fr, fq, ui); else if constexpr (Epi::DUAL) { if (cur.seg == 0) E.mid(acc, cur, wr, wc, fr, fq); else E(acc, cur, wr, wc, fr, fq); } else E(acc, cur, wr, wc, fr, fq); S.done(cur); }
        if (!has_next) break;
        if (!(Epi::DUAL && cur.seg == 0))
#pragma unroll
        for (int a = 0; a < 2; ++a)
#pragma unroll
            for (int b = 0; b < 2; ++b)
#pragma unroll
                for (int m = 0; m < 4; ++m)
#pragma unroll
                    for (int n = 0; n < 2; ++n) acc[a][b][m][n] = (f32x4){0.f, 0.f, 0.f, 0.f};
        cur = nxt; cA = nA; cB = nB; ++ui;
        if constexpr (Epi::PREFETCH) E.prefetch(cur, ui, wid, lane);
        if constexpr (ALIGN_EPI) { if (wr == 1) PG8_BAR; }
    }
    PG8_WAIT_V(0);
    if constexpr (!ALIGN_EPI) { if (wr == 0) PG8_BAR; }
    PG8_BAR;
    if constexpr (Epi::AFTER_DRAIN) { E.fused(acc, cur, wr, wc, fr, fq, lds, wid, lane); S.done(cur); }
#undef PG8_SA
#undef PG8_SB
#undef PG8_STAGE
#undef PG8_LDA
#undef PG8_LDB
#undef PG8_MMA
#undef PG8_WAIT_V
#undef PG8_WAIT_L
#undef PG8_BAR
#undef PG8_SCHED
}
}

#define GAS __attribute__((address_space(1)))
#define LAS __attribute__((address_space(3)))
typedef GAS unsigned gu32;
typedef GAS unsigned long long gu64;
#define RLX_AGENT __ATOMIC_RELAXED, __HIP_MEMORY_SCOPE_AGENT
#define LDS_WAIT() asm volatile("s_waitcnt lgkmcnt(0)" ::: "memory")
#define VM_WAIT() asm volatile("s_waitcnt vmcnt(0)" ::: "memory")
#define XB_TMO      128
#define XB_XCNT(j)  (256  + 64 * (j))
#define XB_XSUB(j)  (1280 + 64 * (j))
#define XB_XGEN(j)  (2304 + 64 * (j))
#define XB_TOP      3328
#define XB_TOPGEN   3392
#define XB_LSUB(j)  (3456 + 64 * (j))
#define XB_LGEN(j)  (4480 + 64 * (j))
#define XCD_BAR_WORDS 5504
#define XB_SPIN_CAP (1u << 18)

__device__ __forceinline__ unsigned xb_ld(unsigned* p)              { return __hip_atomic_load(p, __ATOMIC_RELAXED, __HIP_MEMORY_SCOPE_AGENT); }
__device__ __forceinline__ unsigned xb_add(unsigned* p, unsigned v) { return __hip_atomic_fetch_add(p, v, __ATOMIC_RELAXED, __HIP_MEMORY_SCOPE_AGENT); }
__device__ __forceinline__ unsigned xb_xcc_id() { return (unsigned)__builtin_amdgcn_s_getreg((3 << 11) | 20) & 0xFu; }
#define XB_SPIN(cond, bar) do { unsigned _sp = 0; while (cond) { __builtin_amdgcn_s_sleep(1); \
    if ((++_sp & 255u) == 0u) { if (xb_ld(&(bar)[XB_TMO])) break; if (_sp > XB_SPIN_CAP) { atomicAdd(&(bar)[XB_TMO], 1u); break; } } } } while (0)

struct XcdBarrier {
    unsigned* bar; unsigned x; int wv;
    volatile LAS unsigned* st;
};

__device__ __forceinline__ XcdBarrier xcd_barrier_post(unsigned* bar, volatile LAS unsigned* st, int wv) {
    XcdBarrier b; b.bar = bar; b.x = xb_xcc_id(); b.st = st; b.wv = wv;
    if (wv == 0 && lane_now() == 0) (void)xb_add(&bar[XB_XCNT(b.x)], 1u);
    return b;
}
__device__ __forceinline__ void xcd_barrier_complete(unsigned* bar, unsigned x, unsigned& nloc, unsigned& nx) {
    const unsigned G = gridDim.x * gridDim.y * gridDim.z;
    unsigned sum, cnt, mine, sp = 0u;
    for (;;) {
        sum = 0u; cnt = 0u; mine = 0u;
#pragma unroll
        for (unsigned j = 0; j < 16; ++j) { const unsigned c = xb_ld(&bar[XB_XCNT(j)]); sum += c; cnt += (c > 0u) ? 1u : 0u; mine = (j == x) ? c : mine; }
        if (sum == G) break;
        __builtin_amdgcn_s_sleep(1);
        if ((++sp & 255u) == 0u) { if (xb_ld(&bar[XB_TMO])) break; if (sp > XB_SPIN_CAP) { atomicAdd(&bar[XB_TMO], 1u); break; } }
    }
    nloc = mine > 0u ? mine : 1u; nx = cnt > 0u ? cnt : 1u;
}

__device__ __forceinline__ void xcd_barrier(const XcdBarrier& b) {
    asm volatile("s_waitcnt vmcnt(0)" ::: "memory");
    __syncthreads();
    if (b.wv == 0 && lane_now() == 0) {
        unsigned* bar = b.bar;
        __builtin_amdgcn_s_waitcnt(0);
        unsigned nloc = b.st[0], nx = b.st[1];
        if (nloc == 0u) { xcd_barrier_complete(bar, b.x, nloc, nx); b.st[0] = nloc; b.st[1] = nx; }
        const unsigned old = xb_add(&bar[XB_XSUB(b.x)], 1u);
        const unsigned gen = old / nloc;
        if (old + 1u == (gen + 1u) * nloc) {
            __builtin_amdgcn_fence(__ATOMIC_RELEASE, "agent");
            asm volatile("s_waitcnt vmcnt(0)" ::: "memory");
            const unsigned og = xb_add(&bar[XB_TOP], 1u);
            const unsigned tg = og / nx;
            if (og + 1u == (tg + 1u) * nx) xb_add(&bar[XB_TOPGEN], 1u);
            else XB_SPIN(xb_ld(&bar[XB_TOPGEN]) == tg, bar);
            __builtin_amdgcn_fence(__ATOMIC_ACQUIRE, "agent");
            xb_add(&bar[XB_XGEN(b.x)], 1u);
            asm volatile("s_waitcnt vmcnt(0)" ::: "memory");
        } else {
            XB_SPIN(xb_ld(&bar[XB_XGEN(b.x)]) == gen, bar);
            __builtin_amdgcn_fence(__ATOMIC_ACQUIRE, "agent");
            asm volatile("s_waitcnt vmcnt(0)" ::: "memory");
        }
    }
    __syncthreads();
}
__device__ __forceinline__ void xcd_barrier_local(const XcdBarrier& b) {
    asm volatile("s_waitcnt vmcnt(0)" ::: "memory");
    __syncthreads();
    if (b.wv == 0 && lane_now() == 0) {
        unsigned* bar = b.bar;
        __builtin_amdgcn_s_waitcnt(0);
        const unsigned nloc = b.st[0];
        const unsigned old = xb_add(&bar[XB_LSUB(b.x)], 1u);
        const unsigned gen = old / nloc;
        if (old + 1u == (gen + 1u) * nloc) xb_add(&bar[XB_LGEN(b.x)], 1u);
        else XB_SPIN(xb_ld(&bar[XB_LGEN(b.x)]) == gen, bar);
        __builtin_amdgcn_fence(__ATOMIC_ACQUIRE, "agent");
        asm volatile("s_waitcnt vmcnt(0)" ::: "memory");
    }
    __syncthreads();
}

namespace ret {
typedef short s16x4 __attribute__((ext_vector_type(4)));
typedef short v4i16_t __attribute__((ext_vector_type(4)));
typedef LAS const unsigned char* lptr;
constexpr int QS_STRIDE = 144, KD_STRIDE = 192, VS_STRIDE = 320, OUT_STRIDE = 528;
constexpr int OFF_QS = 0, OFF_ST = 18432, OFF_KS = 36864, OFF_KD = 55296, OFF_VS = 79872, OFF_END = 120832, OFF_OUT = OFF_KS, OFF_SSQ = OFF_END;
static_assert(OFF_OUT + 128 * OUT_STRIDE <= OFF_END && OFF_SSQ + 1024 <= 131072, "retention LDS map");
__device__ __forceinline__ s16x4 vtr(lptr p) { return __builtin_bit_cast(s16x4, __builtin_amdgcn_ds_read_tr16_b64_v4i16((LAS v4i16_t*)p)); }
__device__ __forceinline__ bf16x8 cat8(const s16x4 lo, const s16x4 hi) { return (bf16x8){lo[0], lo[1], lo[2], lo[3], hi[0], hi[1], hi[2], hi[3]}; }

__device__ __forceinline__ void stage_chunk(LAS unsigned char* lds, const bf16* rowbase, int h, float lg, int tid, bool with_qk) {
#pragma unroll
    for (int i = 0; i < 2; ++i) { const int it = tid + 512 * i, row = it >> 3, ch = it & 7;
        const u32x4 k = *(const u32x4*)(rowbase + (size_t)row * PP + C_KR + h * HD + ch * 8);
        f32x4 a, b; pg8::unpack8(k, a, b); const float d = __builtin_amdgcn_exp2f(lg * (float)(127 - row));
        *(LAS u32x4*)(lds + OFF_KD + row * KD_STRIDE + ch * 16) = pg8::pack8(a * d, b * d);
        if (with_qk) { *(LAS u32x4*)(lds + OFF_KS + row * QS_STRIDE + ch * 16) = k;
            *(LAS u32x4*)(lds + OFF_QS + row * QS_STRIDE + ch * 16) = *(const u32x4*)(rowbase + (size_t)row * PP + C_QR + h * HD + ch * 8); } }
#pragma unroll
    for (int i = 0; i < 4; ++i) { const int it = tid + 512 * i, row = it >> 4, ch = it & 15;
        *(LAS u32x4*)(lds + OFF_VS + row * VS_STRIDE + ch * 16) = *(const u32x4*)(rowbase + (size_t)row * PP + C_VR + h * DV + ch * 8); }
}
__device__ __forceinline__ void state_update(f32x16& st, lptr lds, int dkb, int dvb, float gC, int lane) {
    const int hi = lane >> 5, g = (lane >> 4) & 1, qq = (lane & 15) >> 2, pp = lane & 3;
    lptr ka = lds + OFF_KD + (8 * hi + qq) * KD_STRIDE + (32 * dkb + 16 * g + 4 * pp) * 2;
    lptr va = lds + OFF_VS + (8 * hi + qq) * VS_STRIDE + (32 * dvb + 16 * g + 4 * pp) * 2;
#pragma unroll
    for (int r = 0; r < 16; ++r) st[r] *= gC;
#pragma unroll
    for (int ks = 0; ks < 8; ++ks) {
        const bf16x8 a = cat8(vtr(ka + ks * 16 * KD_STRIDE), vtr(ka + (ks * 16 + 4) * KD_STRIDE));
        const bf16x8 b = cat8(vtr(va + ks * 16 * VS_STRIDE), vtr(va + (ks * 16 + 4) * VS_STRIDE));
        st = __builtin_amdgcn_mfma_f32_32x32x16_bf16(a, b, st, 0, 0, 0);
    }
}

__device__ __forceinline__ void ret_group_state(LAS unsigned char* lds, const bf16* PROJ, float* GST, int ui, int tid) {
    const int lane = tid & 63, wave = __builtin_amdgcn_readfirstlane(tid >> 6), hi = lane >> 5;
    const int bh = ui >> 3, s = ui & 7, h = bh & 3, b = bh >> 2, dkb = wave & 1, dvb = wave >> 1;
    const float lg = ret_lg2(h), gC = __builtin_amdgcn_exp2f(lg * 128.f);
    f32x16 st = {};
    const bf16* rb0 = PROJ + ((size_t)b * SEQ + (size_t)(8 * s) * 128) * PP;
    const size_t koff0 = (size_t)(tid >> 3) * PP + C_KR + h * HD + (tid & 7) * 8, voff0 = (size_t)(tid >> 4) * PP + C_VR + h * DV + (tid & 15) * 8;
    u32x4 kk[3][2], vv[3][4];
#pragma unroll
    for (int c = 0; c < 3; ++c) { const bf16* rb = rb0 + (size_t)c * 128 * PP;
#pragma unroll
        for (int i = 0; i < 2; ++i) kk[c][i] = *(const u32x4*)(rb + koff0 + (size_t)(64 * i) * PP);
#pragma unroll
        for (int i = 0; i < 4; ++i) vv[c][i] = *(const u32x4*)(rb + voff0 + (size_t)(32 * i) * PP); }
#pragma unroll
    for (int c = 0; c < 8; ++c) { const int q = c % 3;
        __syncthreads();
#pragma unroll
        for (int i = 0; i < 2; ++i) { const int row = (tid >> 3) + 64 * i, ch = tid & 7;
            f32x4 a, bq; pg8::unpack8(kk[q][i], a, bq); const float d = __builtin_amdgcn_exp2f(lg * (float)(127 - row));
            *(LAS u32x4*)(lds + OFF_KD + row * KD_STRIDE + ch * 16) = pg8::pack8(a * d, bq * d); }
#pragma unroll
        for (int i = 0; i < 4; ++i) { const int row = (tid >> 4) + 32 * i, ch = tid & 15; *(LAS u32x4*)(lds + OFF_VS + row * VS_STRIDE + ch * 16) = vv[q][i]; }
        if (c + 3 < 8) { const bf16* rb = rb0 + (size_t)(c + 3) * 128 * PP;
#pragma unroll
            for (int i = 0; i < 2; ++i) kk[q][i] = *(const u32x4*)(rb + koff0 + (size_t)(64 * i) * PP);
#pragma unroll
            for (int i = 0; i < 4; ++i) vv[q][i] = *(const u32x4*)(rb + voff0 + (size_t)(32 * i) * PP); }
        __syncthreads();
        state_update(st, (lptr)lds, dkb, dvb, gC, lane);
    }
    float* gp = GST + (size_t)ui * (HD * DV) + (size_t)(32 * dkb) * DV + 32 * dvb + (lane & 31);
#pragma unroll
    for (int r = 0; r < 16; ++r) gp[(size_t)((r & 3) + 8 * (r >> 2) + 4 * hi) * DV] = st[r];
    __syncthreads();
}

__device__ __forceinline__ void ret_outputs(LAS unsigned char* lds, const bf16* PROJ, const float* GST, bf16* RB, int ui, int tid) {
    const int lane = tid & 63, wave = __builtin_amdgcn_readfirstlane(tid >> 6), hi = lane >> 5, l31 = lane & 31;
    const int g = (lane >> 4) & 1, qq = (lane & 15) >> 2, pp = lane & 3;
    const int bh = ui >> 3, s = ui & 7, h = bh & 3, b = bh >> 2, dkb = wave & 1, dvb = wave >> 1;
    const int qblk = wave & 3, dvh = wave >> 2;
    const float lg = ret_lg2(h), gC = __builtin_amdgcn_exp2f(lg * 128.f);
    f32x16 st = {};
    for (int sp = 0; sp < s; ++sp) {
        const float w = __builtin_amdgcn_exp2f(lg * 1024.f * (float)(s - 1 - sp));
        const float* gp = GST + (size_t)(bh * 8 + sp) * (HD * DV) + (size_t)(32 * dkb) * DV + 32 * dvb + l31;
#pragma unroll
        for (int r = 0; r < 16; ++r) st[r] += w * gp[(size_t)((r & 3) + 8 * (r >> 2) + 4 * hi) * DV];
    }
    const float qdec = __builtin_amdgcn_exp2f(lg * (float)(32 * qblk + l31 + 1));
    const bf16* rb0 = PROJ + ((size_t)b * SEQ + (size_t)(8 * s) * 128) * PP;
    const size_t qoff0 = (size_t)(tid >> 3) * PP + h * HD + (tid & 7) * 8, voff0 = (size_t)(tid >> 4) * PP + C_VR + h * DV + (tid & 15) * 8;
    u32x4 kk[2], qv[2], vv[4];
#pragma unroll
    for (int i = 0; i < 2; ++i) { kk[i] = *(const u32x4*)(rb0 + qoff0 + C_KR + (size_t)(64 * i) * PP); qv[i] = *(const u32x4*)(rb0 + qoff0 + C_QR + (size_t)(64 * i) * PP); }
#pragma unroll
    for (int i = 0; i < 4; ++i) vv[i] = *(const u32x4*)(rb0 + voff0 + (size_t)(32 * i) * PP);
    for (int c = 0; c < 8; ++c) {
        const size_t row0 = (size_t)b * SEQ + (size_t)(8 * s + c) * 128;
        __syncthreads();
#pragma unroll
        for (int gq = 0; gq < 4; ++gq) { u32x2 w; w.x = pg8::cvt_pk_bf16(st[4 * gq], st[4 * gq + 1]); w.y = pg8::cvt_pk_bf16(st[4 * gq + 2], st[4 * gq + 3]);
            *(LAS u32x2*)(lds + OFF_ST + (32 * dvb + l31) * QS_STRIDE + (32 * dkb + 8 * gq + 4 * hi) * 2) = w; }
#pragma unroll
        for (int i = 0; i < 2; ++i) { const int row = (tid >> 3) + 64 * i, ch = tid & 7;
            f32x4 a, bq; pg8::unpack8(kk[i], a, bq); const float d = __builtin_amdgcn_exp2f(lg * (float)(127 - row));
            *(LAS u32x4*)(lds + OFF_KD + row * KD_STRIDE + ch * 16) = pg8::pack8(a * d, bq * d);
            *(LAS u32x4*)(lds + OFF_KS + row * QS_STRIDE + ch * 16) = kk[i]; *(LAS u32x4*)(lds + OFF_QS + row * QS_STRIDE + ch * 16) = qv[i]; }
#pragma unroll
        for (int i = 0; i < 4; ++i) { const int row = (tid >> 4) + 32 * i, ch = tid & 15; *(LAS u32x4*)(lds + OFF_VS + row * VS_STRIDE + ch * 16) = vv[i]; }
        if (c + 1 < 8) { const bf16* rb = rb0 + (size_t)(c + 1) * 128 * PP;
#pragma unroll
            for (int i = 0; i < 2; ++i) { kk[i] = *(const u32x4*)(rb + qoff0 + C_KR + (size_t)(64 * i) * PP); qv[i] = *(const u32x4*)(rb + qoff0 + C_QR + (size_t)(64 * i) * PP); }
#pragma unroll
            for (int i = 0; i < 4; ++i) vv[i] = *(const u32x4*)(rb + voff0 + (size_t)(32 * i) * PP); }
        __syncthreads();
        bf16x8 qf[4];
#pragma unroll
        for (int d0 = 0; d0 < 4; ++d0) qf[d0] = *(const LAS bf16x8*)(lds + OFF_QS + (32 * qblk + l31) * QS_STRIDE + (16 * d0 + 8 * hi) * 2);
        f32x16 o[2];
#pragma unroll
        for (int d = 0; d < 2; ++d) { o[d] = f32x16{};
#pragma unroll
            for (int d0 = 0; d0 < 4; ++d0) { const bf16x8 a = *(const LAS bf16x8*)(lds + OFF_ST + (32 * (2 * dvh + d) + l31) * QS_STRIDE + (16 * d0 + 8 * hi) * 2);
                o[d] = __builtin_amdgcn_mfma_f32_32x32x16_bf16(a, qf[d0], o[d], 0, 0, 0); }
#pragma unroll
            for (int r = 0; r < 16; ++r) o[d][r] *= qdec; }
        for (int kb = 0; kb <= qblk; ++kb) {
            f32x16 sT = {};
#pragma unroll
            for (int d0 = 0; d0 < 4; ++d0) { const bf16x8 a = *(const LAS bf16x8*)(lds + OFF_KS + (32 * kb + l31) * QS_STRIDE + (16 * d0 + 8 * hi) * 2);
                sT = __builtin_amdgcn_mfma_f32_32x32x16_bf16(a, qf[d0], sT, 0, 0, 0); }
            const int dq = 32 * (qblk - kb) + l31;
#pragma unroll
            for (int r = 0; r < 16; ++r) { const int dist = dq - ((r & 3) + 8 * (r >> 2) + 4 * hi); sT[r] = (dist >= 0) ? sT[r] * __builtin_amdgcn_exp2f(lg * (float)dist) : 0.f; }
            u32x4 pw[2];
#pragma unroll
            for (int sx = 0; sx < 2; ++sx) { pw[sx].x = pg8::cvt_pk_bf16(sT[8 * sx], sT[8 * sx + 1]); pw[sx].y = pg8::cvt_pk_bf16(sT[8 * sx + 2], sT[8 * sx + 3]);
                pw[sx].z = pg8::cvt_pk_bf16(sT[8 * sx + 4], sT[8 * sx + 5]); pw[sx].w = pg8::cvt_pk_bf16(sT[8 * sx + 6], sT[8 * sx + 7]); }
#pragma unroll
            for (int d = 0; d < 2; ++d)
#pragma unroll
                for (int sx = 0; sx < 2; ++sx) { lptr vp = (lptr)lds + OFF_VS + (32 * kb + 16 * sx + 4 * hi + qq) * VS_STRIDE + (32 * (2 * dvh + d) + 16 * g + 4 * pp) * 2;
                    const bf16x8 a = cat8(vtr(vp), vtr(vp + 8 * VS_STRIDE));
                    o[d] = __builtin_amdgcn_mfma_f32_32x32x16_bf16(a, __builtin_bit_cast(bf16x8, pw[sx]), o[d], 0, 0, 0); }
        }
        state_update(st, (lptr)lds, dkb, dvb, gC, lane);
        float ss = 0.f;
#pragma unroll
        for (int d = 0; d < 2; ++d)
#pragma unroll
            for (int r = 0; r < 16; ++r) ss += o[d][r] * o[d][r];
        ss += __shfl_xor(ss, 32);
        __syncthreads();
#pragma unroll
        for (int d = 0; d < 2; ++d)
#pragma unroll
            for (int gq = 0; gq < 4; ++gq) *(LAS f32x4*)(lds + OFF_OUT + (32 * qblk + l31) * OUT_STRIDE + (32 * (2 * dvh + d) + 8 * gq + 4 * hi) * 4) = (f32x4){o[d][4 * gq], o[d][4 * gq + 1], o[d][4 * gq + 2], o[d][4 * gq + 3]};
        if (hi == 0) *(LAS float*)(lds + OFF_SSQ + (dvh * 128 + 32 * qblk + l31) * 4) = ss;
        __syncthreads();
        { const int row = tid >> 2, seg = tid & 3;
          const float rstd = rsqrtf((*(const LAS float*)(lds + OFF_SSQ + row * 4) + *(const LAS float*)(lds + OFF_SSQ + (128 + row) * 4)) * (1.f / DV) + SUBLN_EPS);
          const bf16* gsrc = PROJ + (row0 + row) * PP + C_GR + h * DV + seg * 32; bf16* dst = RB + (row0 + row) * 512 + h * DV + seg * 32;
#pragma unroll
          for (int cc = 0; cc < 4; ++cc) { const f32x4 v0 = *(const LAS f32x4*)(lds + OFF_OUT + row * OUT_STRIDE + (seg * 32 + cc * 8) * 4), v1 = *(const LAS f32x4*)(lds + OFF_OUT + row * OUT_STRIDE + (seg * 32 + cc * 8 + 4) * 4);
              f32x4 g0, g1; pg8::unpack8(*(const u32x4*)(gsrc + cc * 8), g0, g1); f32x4 r0, r1;
#pragma unroll
              for (int i = 0; i < 4; ++i) { r0[i] = v0[i] * rstd * g0[i]; r1[i] = v1[i] * rstd * g1[i]; }
              *(u32x4*)(dst + cc * 8) = pg8::pack8(r0, r1); } }
    }
    __syncthreads();
}
}

namespace attn {
typedef short s16x4 __attribute__((ext_vector_type(4)));
typedef short v4i16_t __attribute__((ext_vector_type(4)));
typedef LAS const unsigned char* lptr;
constexpr int KSLOT = 16384, L_K2 = 8192, L_V = 65536, VSLOT = 16384;
#ifndef ATT_SKIP
#define ATT_SKIP 1
#endif
#ifndef ATT_THR
#define ATT_THR 60.0f
#endif
__device__ __forceinline__ void glds16s(const void* sbase, unsigned voff, unsigned lds_dst) { unsigned keep;
    asm volatile("s_mov_b32 %0, m0\n\ts_mov_b32 m0, %3\n\ts_nop 0\n\tglobal_load_lds_dwordx4 %1, %2\n\ts_mov_b32 m0, %0" : "=&s"(keep) : "v"(voff), "s"(sbase), "s"(lds_dst) : "memory"); }
__device__ __forceinline__ void glds16(const void* gsrc, unsigned lds_dst) { unsigned keep;
    asm volatile("s_mov_b32 %0, m0\n\ts_mov_b32 m0, %2\n\ts_nop 0\n\tglobal_load_lds_dwordx4 %1, off\n\ts_mov_b32 m0, %0" : "=&s"(keep) : "v"(gsrc), "s"(lds_dst) : "memory"); }
__device__ __forceinline__ s16x4 vtr(lptr p) { return __builtin_bit_cast(s16x4, __builtin_amdgcn_ds_read_tr16_b64_v4i16((LAS v4i16_t*)p)); }
__device__ __forceinline__ bf16x8 cat8(const s16x4 lo, const s16x4 hi) { return (bf16x8){lo[0], lo[1], lo[2], lo[3], hi[0], hi[1], hi[2], hi[3]}; }
#define ATT_WAIT_BAR() asm volatile("s_waitcnt vmcnt(0) lgkmcnt(0)\n\ts_barrier" ::: "memory")
#define ATT_WAIT_BAR4() asm volatile("s_waitcnt vmcnt(4) lgkmcnt(0)\n\ts_barrier" ::: "memory")

#define ATT_SB() __builtin_amdgcn_sched_barrier(0)
__device__ __forceinline__ float max3f(float a, float b, float c) { float r; asm("v_max3_f32 %0, %1, %2, %3" : "=v"(r) : "v"(a), "v"(b), "v"(c)); return r; }
__device__ __forceinline__ bf16x8 vfrag(lptr vp, int ks, int d) { const lptr va = vp + d * 4096 + (32 * (ks >> 1) + 16 * (ks & 1)) * 64; return cat8(vtr(va), vtr(va + 8 * 64)); }
__device__ __forceinline__ void vload4(bf16x8 (&buf)[8], int half, lptr vp, int ks) {
#pragma unroll
    for (int d = 0; d < 4; ++d) buf[4 * half + d] = vfrag(vp, ks, d);
}
__device__ __forceinline__ void pv_step(f32x16 (&o)[4], const u32x4& pwk, const bf16x8 (&buf)[8], int half) {
    const bf16x8 pb = __builtin_bit_cast(bf16x8, pwk);
#pragma unroll
    for (int d = 0; d < 4; ++d) o[d] = __builtin_amdgcn_mfma_f32_32x32x16_bf16(buf[4 * half + d], pb, o[d], 0, 0, 0);
}
__device__ __forceinline__ void kload8(bf16x8 (&kf)[8], lptr kp) {
#pragma unroll
    for (int d0 = 0; d0 < 4; ++d0) { kf[2 * d0] = *(const LAS bf16x8*)(kp + d0 * 2048); kf[2 * d0 + 1] = *(const LAS bf16x8*)(kp + d0 * 2048 + 512); }
}
__device__ __forceinline__ void kload4(bf16x8 (&kf)[8], lptr kp, int half) {
#pragma unroll
    for (int d0 = 2 * half; d0 < 2 * half + 2; ++d0) { kf[2 * d0] = *(const LAS bf16x8*)(kp + d0 * 2048); kf[2 * d0 + 1] = *(const LAS bf16x8*)(kp + d0 * 2048 + 512); }
}
template <int MODE> __device__ __forceinline__ void qk_scores(const bf16x8 (&kf)[8], const bf16x8 (&qr)[4], f32x16 (&o)[4], f32x16& p0, f32x16& p1, float& cinit, float shift, bool band, int kb, int qrel, lptr vp, bf16x8 (&tmp)[8]) {
#pragma unroll
    for (int r = 0; r < 16; ++r) { p0[r] = cinit; p1[r] = cinit; }
#pragma unroll
    for (int d0 = 0; d0 < 4; ++d0) {
        p0 = __builtin_amdgcn_mfma_f32_32x32x16_bf16(kf[2 * d0], qr[d0], p0, 0, 0, 0);
        p1 = __builtin_amdgcn_mfma_f32_32x32x16_bf16(kf[2 * d0 + 1], qr[d0], p1, 0, 0, 0);
    }
    ATT_SB();
    vload4(tmp, 0, vp, 0); vload4(tmp, 1, vp, 1);
    ATT_SB();
}
template <int MODE> __device__ __forceinline__ void softmax_head(f32x16 (&o)[4], float& lsum, f32x16& p0, f32x16& p1, float& cinit, float shift, bool band, int kb, int qrel) {
    if (!(MODE & 2)) {
    if (band) {
#pragma unroll
        for (int r = 0; r < 16; ++r) { const int kv = kb + (r & 3) + 8 * (r >> 2); if (kv > qrel) p0[r] = -INFINITY; if (kv + 32 > qrel) p1[r] = -INFINITY; }
    }
    ATT_SB(); asm volatile("s_nop 7\n\ts_nop 7"); ATT_SB();
    float rm = max3f(p0[0], p0[1], p1[0]), rb = max3f(p0[2], p0[3], p1[1]);
    rm = max3f(rm, p1[2], p1[3]);
#pragma unroll
    for (int r = 4; r < 16; r += 4) { rm = max3f(rm, p0[r], p0[r + 1]); rb = max3f(rb, p0[r + 2], p0[r + 3]); rm = max3f(rm, p1[r], p1[r + 1]); rb = max3f(rb, p1[r + 2], p1[r + 3]); }
    rm = max3f(rm, rb, rb);
    { auto rr = __builtin_amdgcn_permlane32_swap(__float_as_uint(rm), __float_as_uint(rm), false, false); rm = fmaxf(__uint_as_float(rr[0]), __uint_as_float(rr[1])); }
    if (__any(rm > ATT_THR)) {
        const float dl = fmaxf(rm, 0.f), f = __builtin_amdgcn_exp2f(-dl);
        cinit -= dl;
#pragma unroll
        for (int r = 0; r < 16; ++r) { p0[r] -= dl; p1[r] -= dl; }
        lsum *= f;
#pragma unroll
        for (int d = 0; d < 4; ++d)
#pragma unroll
            for (int r = 0; r < 16; ++r) o[d][r] *= f;
    }
    }
    cinit += shift;
}
struct AW { float b1, b2, b3, a8, c1, c2, c3; };
template <int MODE> __device__ __forceinline__ u32x4 exp_pack(const f32x16& p, int s, float& lsum, float cks, const AW& aw) {
    float e[8];
#pragma unroll
    for (int j = 0; j < 8; ++j) e[j] = (MODE & 2) ? p[8 * s + j] : __builtin_amdgcn_exp2f(p[8 * s + j]);
    const float g0 = __builtin_fmaf(aw.b3, e[3], __builtin_fmaf(aw.b2, e[2], __builtin_fmaf(aw.b1, e[1], e[0])));
    const float g1 = __builtin_fmaf(aw.b3, e[7], __builtin_fmaf(aw.b2, e[6], __builtin_fmaf(aw.b1, e[5], e[4])));
    lsum = __builtin_fmaf(cks, __builtin_fmaf(aw.a8, g1, g0), lsum);
    u32x4 w; w.x = pg8::cvt_pk_bf16(e[0], e[1]); w.y = pg8::cvt_pk_bf16(e[2], e[3]); w.z = pg8::cvt_pk_bf16(e[4], e[5]); w.w = pg8::cvt_pk_bf16(e[6], e[7]);
    return w;
}
__device__ __forceinline__ void qk_half(const bf16x8 (&kf)[8], const bf16x8 (&qr)[4], f32x16& p0, f32x16& p1, int half) {
    if (half == 0) {
        p0 = __builtin_amdgcn_mfma_f32_32x32x16_bf16(kf[0], qr[0], f32x16{}, 0, 0, 0); p1 = __builtin_amdgcn_mfma_f32_32x32x16_bf16(kf[1], qr[0], f32x16{}, 0, 0, 0);
        p0 = __builtin_amdgcn_mfma_f32_32x32x16_bf16(kf[2], qr[1], p0, 0, 0, 0); p1 = __builtin_amdgcn_mfma_f32_32x32x16_bf16(kf[3], qr[1], p1, 0, 0, 0);
    } else {
        p0 = __builtin_amdgcn_mfma_f32_32x32x16_bf16(kf[4], qr[2], p0, 0, 0, 0); p1 = __builtin_amdgcn_mfma_f32_32x32x16_bf16(kf[5], qr[2], p1, 0, 0, 0);
        p0 = __builtin_amdgcn_mfma_f32_32x32x16_bf16(kf[6], qr[3], p0, 0, 0, 0); p1 = __builtin_amdgcn_mfma_f32_32x32x16_bf16(kf[7], qr[3], p1, 0, 0, 0);
    }
}
__device__ __forceinline__ void softmax_head2(f32x16 (&o)[4], float& lsum, f32x16& p0, f32x16& p1, float& c, bool band, int kb, int qrel) {
    if (band) {
#pragma unroll
        for (int r = 0; r < 16; ++r) { const int kv = kb + (r & 3) + 8 * (r >> 2); if (kv > qrel) p0[r] = -INFINITY; if (kv + 32 > qrel) p1[r] = -INFINITY; }
    }
    ATT_SB();
    float rm = max3f(p0[0], p0[1], p1[0]), rb = max3f(p0[2], p0[3], p1[1]);
    rm = max3f(rm, p1[2], p1[3]);
#pragma unroll
    for (int r = 4; r < 16; r += 4) { rm = max3f(rm, p0[r], p0[r + 1]); rb = max3f(rb, p0[r + 2], p0[r + 3]); rm = max3f(rm, p1[r], p1[r + 1]); rb = max3f(rb, p1[r + 2], p1[r + 3]); }
    rm = max3f(rm, rb, rb) + c;
    { auto rr = __builtin_amdgcn_permlane32_swap(__float_as_uint(rm), __float_as_uint(rm), false, false); rm = fmaxf(__uint_as_float(rr[0]), __uint_as_float(rr[1])); }
    if (__any(rm > ATT_THR)) {
        const float dl = fmaxf(rm, 0.f), f = __builtin_amdgcn_exp2f(-dl);
        c -= dl; lsum *= f;
#pragma unroll
        for (int d = 0; d < 4; ++d)
#pragma unroll
            for (int r = 0; r < 16; ++r) o[d][r] *= f;
    }
}
__device__ __forceinline__ u32x4 exp_pack2(const f32x16& p, int s, float c, float& lsum, float cks, const AW& aw) {
    float e[8];
#pragma unroll
    for (int j = 0; j < 8; ++j) e[j] = __builtin_amdgcn_exp2f(p[8 * s + j] + c);
    const float g0 = __builtin_fmaf(aw.b3, e[3], __builtin_fmaf(aw.b2, e[2], __builtin_fmaf(aw.b1, e[1], e[0])));
    const float g1 = __builtin_fmaf(aw.b3, e[7], __builtin_fmaf(aw.b2, e[6], __builtin_fmaf(aw.b1, e[5], e[4])));
    lsum = __builtin_fmaf(cks, __builtin_fmaf(aw.a8, g1, g0), lsum);
    u32x4 w; w.x = pg8::cvt_pk_bf16(e[0], e[1]); w.y = pg8::cvt_pk_bf16(e[2], e[3]); w.z = pg8::cvt_pk_bf16(e[4], e[5]); w.w = pg8::cvt_pk_bf16(e[6], e[7]);
    return w;
}
struct ESl { float g0, g1; };
__device__ __forceinline__ void exp_slice(ESl& x, u32x4& w, const f32x16& p, int s, int d, float c, const AW& aw) {
    const float a = __builtin_amdgcn_exp2f(p[8 * s + 2 * d] + c), b = __builtin_amdgcn_exp2f(p[8 * s + 2 * d + 1] + c);
    const unsigned pk = pg8::cvt_pk_bf16(a, b);
    if (d == 0) { w.x = pk; x.g0 = __builtin_fmaf(aw.b1, b, a); } else if (d == 1) { w.y = pk; x.g0 = __builtin_fmaf(aw.b3, b, __builtin_fmaf(aw.b2, a, x.g0)); }
    else if (d == 2) { w.z = pk; x.g1 = __builtin_fmaf(aw.b1, b, a); } else { w.w = pk; x.g1 = __builtin_fmaf(aw.b3, b, __builtin_fmaf(aw.b2, a, x.g1)); }
}
#define ATT_PIN1(v) asm volatile("" : "+v"(v))
__device__ __forceinline__ void pv_exp_step(f32x16 (&o)[4], const u32x4& pwk, bf16x8 (&buf)[8], int half, lptr vp, int vks, u32x4& wn, const f32x16& pnx, int s, float c, float& lsum, float cks, const AW& aw) {
    const bf16x8 pb = __builtin_bit_cast(bf16x8, pwk); ESl x;
#pragma unroll
    for (int d = 0; d < 4; ++d) {
        o[d] = __builtin_amdgcn_mfma_f32_32x32x16_bf16(buf[4 * half + d], pb, o[d], 0, 0, 0);
        exp_slice(x, wn, pnx, s, d, c, aw);
        if (vks >= 0) buf[4 * half + d] = vfrag(vp, vks, d);
        if (d == 3) lsum = __builtin_fmaf(cks, __builtin_fmaf(aw.a8, x.g1, x.g0), lsum);
        if (d == 0) ATT_PIN1(wn.x); else if (d == 1) ATT_PIN1(wn.y); else if (d == 2) ATT_PIN1(wn.z); else { ATT_PIN1(wn.w); ATT_PIN1(lsum); }
        ATT_SB();
    }
}
__device__ __forceinline__ void qk_exp_half(const bf16x8 (&kf)[8], const bf16x8 (&qr)[4], f32x16& p0, f32x16& p1, bool nxt, u32x4& wn, const f32x16& pcur, float c, float& lsum, const AW& aw) {
    ESl x;
#pragma unroll
    for (int d = 0; d < 4; ++d) {
        if (nxt) { if (d == 0) p0 = __builtin_amdgcn_mfma_f32_32x32x16_bf16(kf[4], qr[2], p0, 0, 0, 0); else if (d == 1) p1 = __builtin_amdgcn_mfma_f32_32x32x16_bf16(kf[5], qr[2], p1, 0, 0, 0);
                   else if (d == 2) p0 = __builtin_amdgcn_mfma_f32_32x32x16_bf16(kf[6], qr[3], p0, 0, 0, 0); else p1 = __builtin_amdgcn_mfma_f32_32x32x16_bf16(kf[7], qr[3], p1, 0, 0, 0); }
        exp_slice(x, wn, pcur, 0, d, c, aw);
        if (d == 3) lsum = __builtin_fmaf(1.f, __builtin_fmaf(aw.a8, x.g1, x.g0), lsum);
        if (d == 0) ATT_PIN1(wn.x); else if (d == 1) ATT_PIN1(wn.y); else if (d == 2) ATT_PIN1(wn.z); else { ATT_PIN1(wn.w); ATT_PIN1(lsum); }
        ATT_SB();
    }
}
template <int MODE> __device__ __forceinline__ void attn_unit(LAS unsigned char* lds, const bf16* PROJ, const bf16* KVP, bf16* AB, const float* gsub, float lam, int bh, int qb, float dq2, int tid) {
    const int lane = tid & 63, r32 = lane & 31, hi = lane >> 5, g = (lane >> 4) & 1, qq = (lane & 15) >> 2, pp = lane & 3;
    const int wid = __builtin_amdgcn_readfirstlane(tid >> 6), map = wid >> 2, qblk = wid & 3;
    const int b = bh >> 2, h = bh & 3, q0 = qb * 128;
    const size_t rowbase = (size_t)b * SEQ;
    const float sl2 = alibi_sl2(h);
    const unsigned lds0 = (unsigned)(uintptr_t)lds;
    const char* kvw = (const char*)(KVP + (size_t)bh * 128 * 16384) + wid * 1024;
    const unsigned lane16 = (unsigned)lane * 16u;
#define ATT_DMA_K(t, kslot) do { const char* _g = kvw + (size_t)(t) * 32768; const unsigned _k = lds0 + (kslot) * KSLOT + wid * 1024; \
        glds16s(_g, lane16, (unsigned)__builtin_amdgcn_readfirstlane(_k)); glds16s(_g + 8192, lane16, (unsigned)__builtin_amdgcn_readfirstlane(_k + L_K2)); } while (0)
#define ATT_DMA_V(t, vslot) do { const char* _g = kvw + (size_t)(t) * 32768 + 16384; const unsigned _v = lds0 + L_V + (vslot) * VSLOT + wid * 1024; \
        glds16s(_g, lane16, (unsigned)__builtin_amdgcn_readfirstlane(_v)); glds16s(_g + 8192, lane16, (unsigned)__builtin_amdgcn_readfirstlane(_v + 8192)); } while (0)
    const int NT = 2 * (qb + 1);
    int t0 = 0;
#if ATT_SKIP
    { const float dneed = (152.f + dq2) / sl2;
      const int tq = (int)__builtin_floorf(((float)q0 - dneed - 63.f) * (1.f / 64.f)) + 1;
      t0 = __builtin_amdgcn_readfirstlane(tq > 0 ? tq : 0); }
#endif
    ATT_DMA_K(t0, 0); ATT_DMA_V(t0, 0); ATT_DMA_K(t0 + 1, 1); ATT_DMA_V(t0 + 1, 1);
    if (t0 + 2 < NT) { ATT_DMA_K(t0 + 2, 2); ATT_DMA_V(t0 + 2, 2); }
    const bf16* Qw = PROJ + (rowbase + q0 + 32 * qblk + r32) * PP + (map ? C_Q2 : C_Q1) + h * HD;
    bf16x8 qr[4];
#pragma unroll
    for (int d0 = 0; d0 < 4; ++d0) qr[d0] = *(const bf16x8*)(Qw + d0 * 16 + hi * 8);
    auto uni = [](float x) { return __builtin_bit_cast(float, __builtin_amdgcn_readfirstlane(__builtin_bit_cast(int, x))); };
    const AW aw = {uni(__builtin_amdgcn_exp2f(sl2)), uni(__builtin_amdgcn_exp2f(2.f * sl2)), uni(__builtin_amdgcn_exp2f(3.f * sl2)), uni(__builtin_amdgcn_exp2f(8.f * sl2)),
                   uni(__builtin_amdgcn_exp2f(16.f * sl2)), uni(__builtin_amdgcn_exp2f(32.f * sl2)), uni(__builtin_amdgcn_exp2f(48.f * sl2))};
    const float whi = __builtin_amdgcn_exp2f(sl2 * (float)(4 * hi - 63));
    float lsum = 0.f;
    f32x16 o[4];
#pragma unroll
    for (int d = 0; d < 4; ++d) o[d] = f32x16{};
    float cinit = sl2 * 63.f;
    const float shift = 64.f * sl2;
    const int qrel = 32 * qblk + r32;
    const lptr ldsc = (lptr)lds;
    const lptr vp0 = ldsc + L_V + (4 * hi + qq) * 64 + (16 * g + 4 * pp) * 2;
    const lptr kp0 = ldsc + (map ? L_K2 : 0) + hi * 1024 + r32 * 16;
    u32x4 pw[4];
#pragma unroll
    for (int i = 0; i < 4; ++i) pw[i] = (u32x4){0u, 0u, 0u, 0u};
    bf16x8 hold[8], tmp[8];
    int sl_cur = 0;
    asm volatile("" : "+v"(qr[0]), "+v"(qr[1]), "+v"(qr[2]), "+v"(qr[3]));
    ATT_WAIT_BAR();
    f32x16 pA0, pA1, pB0, pB1;
    kload8(hold, kp0);
    qk_half(hold, qr, pA0, pA1, 0); qk_half(hold, qr, pA0, pA1, 1);
    auto step = [&](int t, f32x16& pc0, f32x16& pc1, f32x16& pn0, f32x16& pn1) __attribute__((always_inline)) {
        if (t > t0) { if (t + 2 < NT) ATT_WAIT_BAR4(); else ATT_WAIT_BAR(); }
        const bool nxt = (t + 1 < NT), band = (t >= NT - 2); const int kb = 64 * (t - (NT - 2)) + 4 * hi;
        const lptr vp = vp0 + sl_cur * VSLOT;
        if (nxt) kload4(hold, kp0 + ((sl_cur + 1) & 3) * KSLOT, 0);
        vload4(tmp, 0, vp, 0); vload4(tmp, 1, vp, 1);
        ATT_SB();
        if (nxt) qk_half(hold, qr, pn0, pn1, 0);
        if (nxt) kload4(hold, kp0 + ((sl_cur + 1) & 3) * KSLOT, 1);
        ATT_SB();
        softmax_head2(o, lsum, pc0, pc1, cinit, band, kb, qrel);
        ATT_SB();
        if (t + 3 < NT) { ATT_DMA_K(t + 3, (sl_cur + 3) & 3); ATT_DMA_V(t + 3, (sl_cur + 3) & 3); }
        ATT_SB();
        { u32x4 wa, wb;
        qk_exp_half(hold, qr, pn0, pn1, nxt, wa, pc0, cinit, lsum, aw);
        pv_exp_step(o, wa, tmp, 0, vp, 2, wb, pc0, 1, cinit, lsum, aw.c1, aw);
        pv_exp_step(o, wb, tmp, 1, vp, 3, wa, pc1, 0, cinit, lsum, aw.c2, aw);
        pv_exp_step(o, wa, tmp, 0, vp, -1, wb, pc1, 1, cinit, lsum, aw.c3, aw);
        pv_step(o, wb, tmp, 1); ATT_SB(); }
        cinit += shift;
        sl_cur = (sl_cur + 1) & 3;
    };
    for (int t = t0; t < NT; t += 2) { step(t, pA0, pA1, pB0, pB1); if (t + 1 < NT) step(t + 1, pB0, pB1, pA0, pA1); }
    float rl;
    { const float lw = lsum * whi; auto rr = __builtin_amdgcn_permlane32_swap(__float_as_uint(lw), __float_as_uint(lw), false, false); rl = __builtin_amdgcn_rcpf(__uint_as_float(rr[0]) + __uint_as_float(rr[1])); }
    ATT_WAIT_BAR();
    LAS float* xch = (LAS float*)(lds + qblk * 16384) + lane;
    if (map == 1) {
#pragma unroll
        for (int d = 0; d < 4; ++d)
#pragma unroll
            for (int r = 0; r < 16; ++r) xch[(d * 16 + r) * 64] = o[d][r] * rl;
    }
    ATT_WAIT_BAR();
    if (map == 0) {
        float ss = 0.f;
#pragma unroll
        for (int d = 0; d < 4; ++d)
#pragma unroll
            for (int r = 0; r < 16; ++r) { const float a = o[d][r] * rl - lam * xch[(d * 16 + r) * 64]; o[d][r] = a; ss += a * a; }
        ss += __shfl_xor(ss, 32);
        const float rstd = rsqrtf(ss * (1.f / DV) + SUBLN_EPS) * (1.f - LAM_INIT);
        bf16* dst = AB + (rowbase + q0 + 32 * qblk + r32) * 512 + h * DV + 8 * hi;
#pragma unroll
        for (int d = 0; d < 4; ++d)
#pragma unroll
            for (int pq = 0; pq < 2; ++pq) { u32x2 w[2];
#pragma unroll
                for (int e = 0; e < 2; ++e) { const int gq = 2 * pq + e; const f32x4 gg = *(const f32x4*)(gsub + 32 * d + 8 * gq + 4 * hi);
                    w[e].x = pg8::cvt_pk_bf16(o[d][4 * gq] * rstd * gg[0], o[d][4 * gq + 1] * rstd * gg[1]); w[e].y = pg8::cvt_pk_bf16(o[d][4 * gq + 2] * rstd * gg[2], o[d][4 * gq + 3] * rstd * gg[3]); }
                auto rx = __builtin_amdgcn_permlane32_swap(w[0].x, w[1].x, false, false); auto ry = __builtin_amdgcn_permlane32_swap(w[0].y, w[1].y, false, false);
                *(u32x4*)(dst + 32 * d + 16 * pq) = (u32x4){rx[0], ry[0], rx[1], ry[1]}; }
    }
    ATT_WAIT_BAR();
#undef ATT_DMA_K
#undef ATT_DMA_V
}
template <int MODE> __device__ __forceinline__ void attn_phase(LAS unsigned char* lds, const bf16* PROJ, const bf16* KVP, const unsigned* KN, bf16* AB, const float* gsub, const float* lq1, const float* lk1, const float* lq2, const float* lk2, int vcu, int G, int tid, unsigned* aq = nullptr) {
    const int lane = tid & 63;
    const float lam = __expf(wave_sum(lq1[lane] * lk1[lane])) - __expf(wave_sum(lq2[lane] * lk2[lane])) + LAM_INIT;
    auto bound = [&](int bh) { float dq2 = 0.f;
#pragma unroll
        for (int mp = 0; mp < 2; ++mp) { const float kn = __uint_as_float(__hip_atomic_load(KN + bh * 2 + mp, __ATOMIC_RELAXED, __HIP_MEMORY_SCOPE_AGENT)), qn = __uint_as_float(__hip_atomic_load(KN + 64 + bh * 2 + mp, __ATOMIC_RELAXED, __HIP_MEMORY_SCOPE_AGENT));
            dq2 = fmaxf(dq2, 2.f * __builtin_sqrtf(2.f * qn) * __builtin_sqrtf(2.f * kn) * 1.0001f); }
        return dq2; };
    LAS int* slot = (LAS int*)(lds + 131072 + 768);
    for (int v = vcu; v < 256; v += G) {
        const int b = v >> 5, w = v & 31;
        for (int it = 0;; ++it) {
            int h, qb;
            if (aq) {
                if (tid == 0) *slot = (int)__hip_atomic_fetch_add(aq, 1u, __ATOMIC_RELAXED, __HIP_MEMORY_SCOPE_AGENT);
                __syncthreads();
                const int u = __builtin_amdgcn_readfirstlane(*slot);
                if (u >= 256) break;
                h = 3 - (u >> 6); qb = 63 - (u & 63);
            } else { if (it >= 8) break; h = (it & 1) ? 3 - (it >> 1) : (it >> 1); qb = (it & 4) ? 63 - w : w; }
            const int bh = b * 4 + h;
            attn_unit<MODE>(lds, PROJ, KVP, AB, gsub, lam, bh, qb, bound(bh), tid);
        }
    }
}
}

constexpr int NWAVES = 8;
constexpr int RING_OFF = 0, RING_BYTES = 131072;
constexpr int LDSCTL_OFF = RING_BYTES, MISC_OFF = LDSCTL_OFF + 320;
constexpr int LDS_BYTES = 159744;
constexpr size_t CTL_ZERO_BYTES = 1 * MiB;
constexpr int CW_BAR = 4096;
constexpr int CW_AQ = 2048;
constexpr int CW_MIS = 1024;
constexpr int CW_KN = 32768;
constexpr int N_PHASES = 10;
constexpr int HALO_OFF = RING_BYTES + 1024;
constexpr int MAX_LAUNCH = 4;
static_assert((CW_BAR + MAX_LAUNCH * XCD_BAR_WORDS) * 4 <= (int)CTL_ZERO_BYTES, "barrier words inside the memset region");
static_assert(HALO_OFF + 2048 + 2 * 4096 + 16384 <= LDS_BYTES, "halo + conv weight tables + rstd partials inside the LDS allocation");

struct Frame {
    LAS unsigned char* lds; volatile LAS unsigned* MISC; gu32* ctl;
    int tid, lane, wave, vcu, G;
};

__device__ __forceinline__ void p0_transpose_item(const float* W, int K, int N, bf16* WT, const float* rs, int mode, LAS float* scr, int item, int lane) {
    const int nblk = N / 32, kb = item / nblk, nb = item % nblk, k0 = 64 * kb, n0 = 32 * nb, s0 = wt_src_col(n0, mode);
#pragma unroll 8
    for (int i = 0; i < 32; ++i) { const int kk = 2 * i + (lane >> 5); const float s = rs ? rs[k0 + kk] : 1.f; scr[kk * 33 + (lane & 31)] = W[(size_t)(k0 + kk) * N + s0 + (lane & 31)] * s; }
    LDS_WAIT(); asm volatile("" ::: "memory");
    const int c = lane & 7;
#pragma unroll
    for (int j = 0; j < 4; ++j) { const int n = (lane >> 3) + 8 * j; const LAS float* s = scr + (8 * c) * 33 + n;
        u32x4 o; o.x = pk2(s[0 * 33], s[1 * 33]); o.y = pk2(s[2 * 33], s[3 * 33]); o.z = pk2(s[4 * 33], s[5 * 33]); o.w = pk2(s[6 * 33], s[7 * 33]);
        *(u32x4*)(WT + (size_t)(n0 + n) * K + k0 + 8 * c) = o; }
    LDS_WAIT(); asm volatile("" ::: "memory");
}
__device__ __forceinline__ void rms_row_to_bf16(const float* xrow, const float* g, bf16* orow, int lane) {
    const f32x4* xr = (const f32x4*)xrow + lane; f32x4 v[4]; float s = 0.f;
#pragma unroll
    for (int j = 0; j < 4; ++j) { v[j] = xr[64 * j]; s += (v[j].x * v[j].x + v[j].y * v[j].y) + (v[j].z * v[j].z + v[j].w * v[j].w); }
    const float rstd = rsqrtf(wave_sum(s) * (1.f / DM) + NORM_EPS);
    u32x2* o = (u32x2*)orow + lane;
#pragma unroll
    for (int j = 0; j < 4; ++j) { const f32x4 gg = ((const f32x4*)g)[lane + 64 * j];
        u32x2 w; w.x = pk2(v[j].x * rstd * gg.x, v[j].y * rstd * gg.y); w.y = pk2(v[j].z * rstd * gg.z, v[j].w * rstd * gg.w); o[64 * j] = w; }
}

struct Args { const float* in[17]; float* out; unsigned char* ws; int ph_lo, ph_hi, li, opt; };

__global__ void __launch_bounds__(NWAVES * 64, 2) mk_fwd(Args args) {
    extern __shared__ __attribute__((aligned(16))) unsigned char lds[];
    Frame F;
    F.lds = (LAS unsigned char*)lds; F.MISC = (volatile LAS unsigned*)(F.lds + MISC_OFF);
    F.tid = threadIdx.x; F.lane = F.tid & 63; F.wave = __builtin_amdgcn_readfirstlane(F.tid >> 6);
    F.G = gridDim.x; { const int bx = blockIdx.x; F.vcu = (F.G % 8 == 0) ? (bx % 8) * (F.G / 8) + bx / 8 : bx; }
    unsigned char* ws = args.ws;
    F.ctl = (gu32*)(ws + WS_CTL);
    const float* x = args.in[0]; const float* g_mix = args.in[1]; const float* w_in = args.in[2];
    const float* w_dp = args.in[8]; const float* w_rp = args.in[9]; const float* w_out = args.in[10];
    const float* g_ffn = args.in[11]; const float* w_up = args.in[12]; const float* conv_w = args.in[13]; const float* conv_b = args.in[14];
    const float* w_down = args.in[15]; const float* g_final = args.in[16];
    float* out = args.out;
    bf16* WIN = (bf16*)(ws + WS_WIN); bf16* WD = (bf16*)(ws + WS_WD); bf16* WR = (bf16*)(ws + WS_WR); bf16* WO = (bf16*)(ws + WS_WO); bf16* WUP = (bf16*)(ws + WS_WUP); bf16* WDN = (bf16*)(ws + WS_WDN);
    bf16* XN = (bf16*)(ws + WS_XN); bf16* PROJ = (bf16*)(ws + WS_PROJ); bf16* AB = (bf16*)(ws + WS_A); bf16* RB = (bf16*)(ws + WS_R);
    bf16* X1B = (bf16*)(ws + WS_X1B); bf16* GB = (bf16*)(ws + WS_G); bf16* UB = (bf16*)(ws + WS_U); float* SSQ1 = (float*)(ws + WS_SSQ1);
    bf16* KVP = (bf16*)(ws + WS_KVP); bf16* MG = XN; bf16* X2B = XN; float* SSQ2 = (float*)(ws + WS_SSQ2); float* GST = (float*)(ws + WS_GST); float* HB = (float*)(ws + WS_HB);
    for (int u = F.tid; u < (LDS_BYTES - LDSCTL_OFF) / 4; u += NWAVES * 64) ((LAS unsigned*)(F.lds + LDSCTL_OFF))[u] = 0u;
    __syncthreads();
    XcdBarrier bar = xcd_barrier_post((unsigned*)(F.ctl + CW_BAR) + args.li * XCD_BAR_WORDS, F.MISC + 8, F.wave);
    const int lo = args.ph_lo, hi = args.ph_hi;
    if (F.tid == 0 && (bar.x != (blockIdx.x & 7u) || F.G != 256)) atomicOr((unsigned*)(F.ctl + CW_MIS + 64 * args.li), 1u);
    bool local_ok = false;
#define IN(k) (lo <= (k) && (k) < hi)
#define SEAM(k) do { if (IN(k) && IN((k) + 1)) { if (local_ok && (k) != 0 && (k) != 4) xcd_barrier_local(bar); else xcd_barrier(bar); } } while (0)

    if (IN(0)) {
        LAS float* scr = (LAS float*)(F.lds + RING_OFF + F.wave * 16384);
        const int gw = F.vcu * NWAVES + F.wave, NGW = F.G * NWAVES;
        constexpr int I_IN = (DM / 64) * (DIN / 32), I_D = (512 / 64) * (DM / 32), I_O = (DM / 64) * (DM / 32), I_UP = (DM / 64) * (FF2 / 32), I_DN = (FF / 64) * (DM / 32);
        constexpr int NITEMS = I_IN + 2 * I_D + I_O + I_UP + I_DN;
        for (int it = gw; it < NITEMS; it += NGW) {
            int r = it;
            if (r < I_IN) { p0_transpose_item(w_in, DM, DIN, WIN, nullptr, 0, scr, r, F.lane); continue; } r -= I_IN;
            if (r < I_D) { p0_transpose_item(w_dp, 512, DM, WD, nullptr, 0, scr, r, F.lane); continue; } r -= I_D;
            if (r < I_D) { p0_transpose_item(w_rp, 512, DM, WR, nullptr, 0, scr, r, F.lane); continue; } r -= I_D;
            if (r < I_O) { p0_transpose_item(w_out, DM, DM, WO, nullptr, 0, scr, r, F.lane); continue; } r -= I_O;
            if (r < I_UP) { p0_transpose_item(w_up, DM, FF2, WUP, g_ffn, 1, scr, r, F.lane); continue; } r -= I_UP;
            p0_transpose_item(w_down, FF, DM, WDN, nullptr, 0, scr, r, F.lane);
        }
        { float* cs = (float*)(ws + WS_CONV);
          for (int i = (int)blockIdx.x * (NWAVES * 64) + F.tid; i < 4 * FF2; i += F.G * (NWAVES * 64)) { const int row = i / FF2, c = i % FF2;
              cs[i] = ((row < 3) ? conv_w[i] : conv_b[c]) * ((c < FF) ? -LOG2E : -1.f / LOG2E); } }
        for (int m = gw; m < M; m += 2 * NGW) {
            const f32x4* xa = (const f32x4*)(x + (size_t)m * DM) + 2 * F.lane; const int m2 = (m + NGW < M) ? m + NGW : m; const f32x4* xb = (const f32x4*)(x + (size_t)m2 * DM) + 2 * F.lane;
            f32x4 va[4], vb[4]; float sa = 0.f, sb = 0.f;
#pragma unroll
            for (int j = 0; j < 2; ++j) { va[2 * j] = xa[128 * j]; va[2 * j + 1] = xa[128 * j + 1]; vb[2 * j] = xb[128 * j]; vb[2 * j + 1] = xb[128 * j + 1]; }
#pragma unroll
            for (int j = 0; j < 4; ++j) { sa += (va[j].x * va[j].x + va[j].y * va[j].y) + (va[j].z * va[j].z + va[j].w * va[j].w); sb += (vb[j].x * vb[j].x + vb[j].y * vb[j].y) + (vb[j].z * vb[j].z + vb[j].w * vb[j].w); }
            const float ra = rsqrtf(wave_sum(sa) * (1.f / DM) + NORM_EPS), rb = rsqrtf(wave_sum(sb) * (1.f / DM) + NORM_EPS);
            u32x4* oa = (u32x4*)(XN + (size_t)m * DM) + F.lane; u32x4* ob = (u32x4*)(XN + (size_t)m2 * DM) + F.lane;
#pragma unroll
            for (int j = 0; j < 2; ++j) { const f32x4 g0 = ((const f32x4*)g_mix)[2 * F.lane + 128 * j], g1 = ((const f32x4*)g_mix)[2 * F.lane + 128 * j + 1];
                u32x4 w; w.x = pk2(va[2 * j].x * ra * g0.x, va[2 * j].y * ra * g0.y); w.y = pk2(va[2 * j].z * ra * g0.z, va[2 * j].w * ra * g0.w);
                w.z = pk2(va[2 * j + 1].x * ra * g1.x, va[2 * j + 1].y * ra * g1.y); w.w = pk2(va[2 * j + 1].z * ra * g1.z, va[2 * j + 1].w * ra * g1.w); oa[64 * j] = w;
                w.x = pk2(vb[2 * j].x * rb * g0.x, vb[2 * j].y * rb * g0.y); w.y = pk2(vb[2 * j].z * rb * g0.z, vb[2 * j].w * rb * g0.w);
                w.z = pk2(vb[2 * j + 1].x * rb * g1.x, vb[2 * j + 1].y * rb * g1.y); w.w = pk2(vb[2 * j + 1].z * rb * g1.z, vb[2 * j + 1].w * rb * g1.w); ob[64 * j] = w; }
        }
    }
    SEAM(0);
    if (lo == 0 && hi > 1) local_ok = __builtin_amdgcn_readfirstlane((int)xb_ld((unsigned*)(F.ctl + CW_MIS + 64 * args.li))) == 0;
    if (IN(1)) {
        pg8::Gemm g{XN, WIN, M, DIN, DM}; pg8::StaticOrder S; S.init(M, DIN, F.G, (int)blockIdx.x);
        pg8::EpiProj E{PROJ, KVP, (unsigned*)(F.ctl + CW_KN)};
        pg8::gemm_phase<pg8::EpiProj, pg8::StaticOrder, true, true>(F.lds + RING_OFF, g, S, E, F.wave);
    }
    SEAM(1);
    if (IN(2)) { if (!(args.opt & 1)) for (int ui = F.vcu; ui < 256; ui += F.G) ret::ret_group_state(F.lds + RING_OFF, PROJ, GST, ui, F.tid); }
    SEAM(2);
    if (IN(3)) { const int tidL = F.wave * 64 + lane_now();
        if (!(args.opt & 1)) for (int ui = F.vcu; ui < 256; ui += F.G) ret::ret_outputs(F.lds + RING_OFF, PROJ, GST, RB, ui ^ 7, tidL);
        if (!(args.opt & 2)) attn::attn_phase<0>(F.lds + RING_OFF, PROJ, KVP, (const unsigned*)(F.ctl + CW_KN), AB, args.in[7], args.in[3], args.in[4], args.in[5], args.in[6], F.vcu, F.G, tidL, (F.G == 256) ? (unsigned*)(F.ctl + CW_AQ + 64 * (8 * args.li + (int)(blockIdx.x & 7))) : nullptr);
#ifdef PROBE_MODE
        if (args.opt & 4) attn::attn_phase<PROBE_MODE>(F.lds + RING_OFF, PROJ, KVP, (const unsigned*)(F.ctl + CW_KN), XN, args.in[7], args.in[3], args.in[4], args.in[5], args.in[6], F.vcu, F.G, tidL);
#endif
    }
    SEAM(3);
    if (IN(4)) {
        pg8::Gemm g{AB, WD, M, DM, 512, RB, WR}; pg8::DualOrder S; S.init(M, DM, F.G, (int)blockIdx.x);
        pg8::EpiMerge2 E{PROJ, MG};
        pg8::gemm_phase<pg8::EpiMerge2, pg8::DualOrder, true, true>(F.lds + RING_OFF, g, S, E, F.wave);
    }
    SEAM(4);
    if (IN(5)) {
        pg8::Gemm g{MG, WO, M, DM, DM}; pg8::StaticOrder S; S.init(M, DM, F.G, (int)blockIdx.x);
        pg8::EpiOutProj E{x, X1B, SSQ1};
        pg8::gemm_phase<pg8::EpiOutProj, pg8::StaticOrder, true, true>(F.lds + RING_OFF, g, S, E, F.wave);
    }
    SEAM(5);
    if (IN(6)) {
        pg8::Gemm g{X1B, WUP, M, FF2, DM}; pg8::StaticOrder S; S.init(M, FF2, F.G, (int)blockIdx.x);
        pg8::EpiUpConv E{SSQ1, GB, HB, (const float*)(ws + WS_CONV), (const float*)(ws + WS_CONV) + 3 * FF2, (LAS float*)(F.lds + HALO_OFF)};
        pg8::gemm_phase<pg8::EpiUpConv, pg8::StaticOrder, true, true>(F.lds + RING_OFF, g, S, E, F.wave);
    }
    SEAM(6);
    if (IN(7)) {
        const bool gp = (F.G == 256);
        const int nw = gp ? 32 : F.G, w = gp ? (int)(blockIdx.x >> 3) : (int)blockIdx.x, pm0 = gp ? (int)(blockIdx.x & 7) * 32 : 0, npm = gp ? 32 : M / 256;
        const int nit = npm * (FF / 4);
        const int tidL = F.wave * 64 + lane_now();
        for (int it = w * (NWAVES * 64) + tidL; it < nit; it += nw * (NWAVES * 64)) {
            const int pm = pm0 + it / (FF / 4), gc = (it % (FF / 4)) * 4;
            if ((pm & 31) == 0) continue;
            const int uc = (gc >> 7) * 256 + (gc & 127);
            const float* h0 = HB + (size_t)(pm - 1) * 4 * FF2, * h1 = HB + (size_t)pm * 4 * FF2;
            const f32x4 gm2 = *(const f32x4*)(h0 + 2 * FF2 + uc), gm1 = *(const f32x4*)(h0 + 3 * FF2 + uc), g0 = *(const f32x4*)(h1 + uc), g1 = *(const f32x4*)(h1 + FF2 + uc);
            const f32x4 um2 = *(const f32x4*)(h0 + 2 * FF2 + uc + 128), um1 = *(const f32x4*)(h0 + 3 * FF2 + uc + 128), u0 = *(const f32x4*)(h1 + uc + 128), u1 = *(const f32x4*)(h1 + FF2 + uc + 128);
            f32x4 wg[3], wu[3];
            const float* cs = (const float*)(ws + WS_CONV);
#pragma unroll
            for (int k = 0; k < 3; ++k) { wg[k] = *(const f32x4*)(cs + k * FF2 + gc); wu[k] = *(const f32x4*)(cs + k * FF2 + FF + gc); }
            const f32x4 bg = *(const f32x4*)(cs + 3 * FF2 + gc), bu = *(const f32x4*)(cs + 3 * FF2 + FF + gc);
            const f32x4 zg0 = bg + wg[2] * g0 + wg[1] * gm1 + wg[0] * gm2, zu0 = bu + wu[2] * u0 + wu[1] * um1 + wu[0] * um2;
            const f32x4 zg1 = bg + wg[2] * g1 + wg[1] * g0 + wg[0] * gm1, zu1 = bu + wu[2] * u1 + wu[1] * u0 + wu[0] * um1;
            f32x4 r0, r1;
#pragma unroll
            for (int i = 0; i < 4; ++i) { r0[i] = (zg0[i] * zu0[i]) * __builtin_amdgcn_rcpf(1.f + __builtin_amdgcn_exp2f(zg0[i])); r1[i] = (zg1[i] * zu1[i]) * __builtin_amdgcn_rcpf(1.f + __builtin_amdgcn_exp2f(zg1[i])); }
            u32x2 w0, w1; w0.x = pg8::cvt_pk_bf16(r0[0], r0[1]); w0.y = pg8::cvt_pk_bf16(r0[2], r0[3]); w1.x = pg8::cvt_pk_bf16(r1[0], r1[1]); w1.y = pg8::cvt_pk_bf16(r1[2], r1[3]);
            *(u32x2*)(GB + (size_t)pm * 256 * FF + gc) = w0; *(u32x2*)(GB + ((size_t)pm * 256 + 1) * FF + gc) = w1;
        }
    }
    SEAM(7);
    if (IN(8)) {
        pg8::Gemm g{GB, WDN, M, DM, FF}; pg8::StaticOrder S; S.init(M, DM, F.G, (int)blockIdx.x);
        pg8::EpiDown E{X1B, X2B, SSQ2};
        pg8::gemm_phase<pg8::EpiDown, pg8::StaticOrder, true, true>(F.lds + RING_OFF, g, S, E, F.wave);
    }
    SEAM(8);
    if (IN(9)) {
        const int laneL = lane_now();
        const bool gp = (F.G == 256);
        const int gw = (gp ? (int)(blockIdx.x >> 3) : F.vcu) * NWAVES + F.wave, NGW = (gp ? 32 : F.G) * NWAVES, m0 = gp ? (int)(blockIdx.x & 7) * 8192 : 0, nm = gp ? 8192 : M;
        for (int mm = gw; mm < nm; mm += 4 * NGW) {
            u32x4 xv[4][2]; float sq[4];
#pragma unroll
            for (int r = 0; r < 4; ++r) { const int m = m0 + ((mm + r * NGW < nm) ? mm + r * NGW : mm); const u32x4* xr = (const u32x4*)(X2B + (size_t)m * DM) + laneL;
                xv[r][0] = xr[0]; xv[r][1] = xr[64]; sq[r] = (laneL < 16) ? SSQ2[(size_t)m * 16 + laneL] : 0.f; }
#pragma unroll
            for (int r = 0; r < 4; ++r) { const int m = m0 + ((mm + r * NGW < nm) ? mm + r * NGW : mm); float q = sq[r];
                q += __shfl_xor(q, 1); q += __shfl_xor(q, 2); q += __shfl_xor(q, 4); q += __shfl_xor(q, 8);
                const float rstd = rsqrtf(__shfl(q, 0) * (1.f / DM) + NORM_EPS);
                f32x4* orow = (f32x4*)(out + (size_t)m * DM) + 2 * laneL;
#pragma unroll
                for (int j = 0; j < 2; ++j) { f32x4 a, b; pg8::unpack8(xv[r][j], a, b);
                    const f32x4 g0 = ((const f32x4*)g_final)[2 * laneL + 128 * j], g1 = ((const f32x4*)g_final)[2 * laneL + 128 * j + 1];
                    orow[128 * j] = a * rstd * g0; orow[128 * j + 1] = b * rstd * g1; } }
        }
    }
#undef IN
#undef SEAM
}

static void launch_mk(Args a, int lo, int hi, int li, int grid, hipStream_t stream, int opt = 0) {
    a.ph_lo = lo; a.ph_hi = hi; a.li = li; a.opt = opt;
    hipLaunchKernelGGL(mk_fwd, dim3(grid), dim3(NWAVES * 64), LDS_BYTES, stream, a);
}
extern "C" void kernel_launch(void* const* d_in, const int* in_sizes, int n_in, void* d_out, int out_size, void* d_ws, size_t ws_size, hipStream_t stream) {
    static int grid = 0;
    if (grid == 0) {
        if (n_in != 17 || out_size != M * DM || ws_size < WS_END) { fprintf(stderr, "kernel_launch: unexpected shapes (n_in %d out %d ws %zu)\n", n_in, out_size, ws_size); grid = -1; return; }
        int dev = 0, cus = 0, per_cu = 0;
        if (hipGetDevice(&dev) != hipSuccess || hipDeviceGetAttribute(&cus, hipDeviceAttributeMultiprocessorCount, dev) != hipSuccess) { grid = -1; return; }
        if (hipFuncSetAttribute((const void*)mk_fwd, hipFuncAttributeMaxDynamicSharedMemorySize, LDS_BYTES) != hipSuccess) { fprintf(stderr, "kernel_launch: hipFuncSetAttribute failed\n"); grid = -1; return; }
        if (hipOccupancyMaxActiveBlocksPerMultiprocessor(&per_cu, (const void*)mk_fwd, NWAVES * 64, LDS_BYTES) != hipSuccess || per_cu < 1) { fprintf(stderr, "kernel_launch: occupancy query says %d\n", per_cu); }
        (void)hipGetLastError();
        grid = cus;
    }
    if (grid < 0) return;
    if (hipMemsetAsync((char*)d_ws + WS_CTL, 0, CTL_ZERO_BYTES, stream) != hipSuccess) return;
    unsigned char* ws = (unsigned char*)d_ws;
    Args a{};
    for (int i = 0; i < 17; ++i) a.in[i] = (const float*)d_in[i];
    a.out = (float*)d_out; a.ws = ws;
    launch_mk(a, 0, N_PHASES, 0, grid, stream);
}
```

```cpp
#include <hip/hip_runtime.h>
#include <cstdio>
#include <cstdint>
#include <cmath>

typedef unsigned short bf16;
typedef short bf16x8 __attribute__((ext_vector_type(8)));
typedef float f32x4 __attribute__((ext_vector_type(4)));
typedef float f32x16 __attribute__((ext_vector_type(16)));
typedef unsigned u32x4 __attribute__((ext_vector_type(4)));
typedef unsigned u32x2 __attribute__((ext_vector_type(2)));

constexpr int BATCH = 8, SEQ = 8192, DM = 1024, M = BATCH * SEQ;
constexpr int NH = 4, HD = 64, DV = 128;
constexpr int DIN = 5120, PP = 4096;
constexpr int FF = 2816, FF2 = 5632;
constexpr int C_Q1 = 0, C_Q2 = 256, C_QR = 512, C_KR = 768, C_VR = 1024, C_GR = 1536, C_GA = 2048, C_GB = 3072;
constexpr float LOG2E = 1.4426950408889634f;
constexpr float C2 = 0.125f * LOG2E;
constexpr float NORM_EPS = 1e-6f, SUBLN_EPS = 1e-5f;
constexpr float LAM_INIT = 0.2f;

constexpr size_t MiB = 1u << 20;
constexpr size_t WS_CTL = 0;
constexpr size_t WS_CONV = 512 * 1024;
constexpr size_t WS_SSQ1 = 2 * MiB;
constexpr size_t WS_SSQ2 = 6 * MiB;
constexpr size_t WS_GST = 10 * MiB;
constexpr size_t WS_WIN = 20 * MiB, WS_WD = 30 * MiB, WS_WR = 31 * MiB, WS_WO = 32 * MiB, WS_WUP = 34 * MiB, WS_WDN = 45 * MiB;
constexpr size_t WS_XN = 64 * MiB;
constexpr size_t WS_PROJ = 192 * MiB;
constexpr size_t WS_KVP = 704 * MiB;
constexpr size_t WS_A = 864 * MiB, WS_R = 928 * MiB;
constexpr size_t WS_X1B = 192 * MiB;
constexpr size_t WS_G = 320 * MiB;
constexpr size_t WS_U = 672 * MiB;
constexpr size_t WS_HB = 672 * MiB;
constexpr size_t WS_END = 1024 * MiB;

__device__ __forceinline__ unsigned f2bf(float f) { unsigned u = __builtin_bit_cast(unsigned, f); return (u + 0x7fffu + ((u >> 16) & 1u)) >> 16; }
__device__ __forceinline__ unsigned pk2(float lo, float hi) { return f2bf(lo) | (f2bf(hi) << 16); }
__device__ __forceinline__ float bf2f(unsigned short b) { return __builtin_bit_cast(float, (unsigned)b << 16); }
__device__ __forceinline__ float bflo(unsigned w) { return __builtin_bit_cast(float, w << 16); }
__device__ __forceinline__ float bfhi(unsigned w) { return __builtin_bit_cast(float, w & 0xffff0000u); }
__device__ __forceinline__ float wave_sum(float v) {
#pragma unroll
    for (int o = 1; o < 64; o <<= 1) v += __shfl_xor(v, o);
    return v;
}
__device__ __forceinline__ float wave_max(float v) {
#pragma unroll
    for (int o = 1; o < 64; o <<= 1) v = fmaxf(v, __shfl_xor(v, o));
    return v;
}
__device__ __forceinline__ float sigmoidf_(float x) { return 1.f / (1.f + __expf(-x)); }
__device__ __forceinline__ float siluf_(float x) { return x / (1.f + __expf(-x)); }
__device__ __forceinline__ float alibi_sl2(int h) { return h == 0 ? 0.36067376022224085f : h == 1 ? 0.09016844005556021f : h == 2 ? 0.022542110013890053f : 0.005635527503472513f; }
__device__ __forceinline__ float ret_lg2(int h) { return h == 0 ? -0.04580368961312479f : h == 1 ? -0.02272007650008353f : h == 2 ? -0.011315313227834146f : -0.005646563141142063f; }

__device__ __forceinline__ int wt_src_col(int n, int mode) {
    if (mode == 0) return n;
    const int t = n >> 8, w = n & 255;
    return (w < 128) ? (t * 128 + w) : (FF + t * 128 + (w - 128));
}
__device__ __forceinline__ int lane_now() { int l; asm volatile("v_mbcnt_lo_u32_b32 %0, -1, 0\n\tv_mbcnt_hi_u32_b32 %0, -1, %0" : "=v"(l)); return l; }
namespace pg8 {
#define PG8_LAS __attribute__((address_space(3)))
typedef unsigned short bf16_t;
typedef short bf16x8 __attribute__((ext_vector_type(8)));
typedef float f32x4 __attribute__((ext_vector_type(4)));
typedef unsigned u32x4 __attribute__((ext_vector_type(4)));
constexpr int BM = 256, BK = 64, HALF = 128, HTB = HALF * BK * 2  , STAGE_BYTES = 8 * HTB, NXCD = 8, WGM = 8;

__host__ __device__ __forceinline__ int lds_byte(int r, int c) { const int st = (r >> 4) * 2 + (c >> 5), rr = r & 15, cc = c & 31, ob = rr * 64 + cc * 2; return st * 1024 + (ob ^ (((ob >> 9) & 1) << 5)); }
__host__ __device__ __forceinline__ void stage_rc(int b, int& R, int& C) { const int st = b / 1024, sb = b % 1024, swz = sb ^ (((sb >> 9) & 1) << 5); R = (st >> 1) * 16 + swz / 64; C = (st & 1) * 32 + (swz % 64) / 2; }
__host__ __device__ __forceinline__ int perm32(int rho) { const int n = rho >> 4, i = rho & 15; return 8 * (i >> 2) + 4 * n + (i & 3); }

struct Unit { int pm, pn, seg; };
struct Gemm { const bf16_t* A; const bf16_t* Bt; int M, N, K; const bf16_t* A2; const bf16_t* Bt2; };

struct StaticOrder {
    int nM, nN, nwg, G, c;
    __host__ __device__ void init(int M, int N, int G_, int c_) { nM = M / BM; nN = N / BM; nwg = nM * nN; G = G_; c = c_; }
    __host__ __device__ bool next(int i, Unit& u) const {
        const long L = (long)i * G + c; if (L >= nwg) return false;
        int wgid = (int)L; { const int q = nwg / NXCD, r = nwg % NXCD, xcd = wgid % NXCD, off = wgid / NXCD; wgid = (xcd < r ? xcd * (q + 1) : r * (q + 1) + (xcd - r) * q) + off; }
        const int nig = WGM * nN, gid = wgid / nig, fm = gid * WGM, gsz = (nM - fm) < WGM ? (nM - fm) : WGM;
        u.pm = fm + ((wgid % nig) % gsz); u.pn = (wgid % nig) / gsz; u.seg = 0; return true;
    }
    __device__ __forceinline__ void a_ready(const Unit&) const {}
    __device__ __forceinline__ void done(const Unit&) const {}
};

struct DualOrder {
    StaticOrder S;
    __host__ __device__ void init(int M, int N, int G_, int c_) { S.init(M, N, G_, c_); }
    __host__ __device__ bool next(int i, Unit& u) const { if (!S.next(i >> 1, u)) return false; u.seg = i & 1; return true; }
    __device__ __forceinline__ void a_ready(const Unit&) const {}
    __device__ __forceinline__ void done(const Unit&) const {}
};

typedef float f32x2 __attribute__((ext_vector_type(2))); typedef __bf16 bf16x2_t __attribute__((ext_vector_type(2)));
__device__ __forceinline__ unsigned cvt_pk_bf16(float lo, float hi) { f32x2 v = {lo, hi}; bf16x2_t b = __builtin_convertvector(v, bf16x2_t); return __builtin_bit_cast(unsigned, b); }
__device__ __forceinline__ float fast_sigmoid(float x) { return __builtin_amdgcn_rcpf(1.f + __builtin_amdgcn_exp2f(-1.4426950408889634f * x)); }
__device__ __forceinline__ u32x4 pack8(const f32x4 a, const f32x4 b) { u32x4 w; w.x = cvt_pk_bf16(a[0], a[1]); w.y = cvt_pk_bf16(a[2], a[3]); w.z = cvt_pk_bf16(b[0], b[1]); w.w = cvt_pk_bf16(b[2], b[3]); return w; }
__device__ __forceinline__ void unpack8(const u32x4 w, f32x4& a, f32x4& b) {
    a[0] = __builtin_bit_cast(float, w.x << 16); a[1] = __builtin_bit_cast(float, w.x & 0xffff0000u); a[2] = __builtin_bit_cast(float, w.y << 16); a[3] = __builtin_bit_cast(float, w.y & 0xffff0000u);
    b[0] = __builtin_bit_cast(float, w.z << 16); b[1] = __builtin_bit_cast(float, w.z & 0xffff0000u); b[2] = __builtin_bit_cast(float, w.w << 16); b[3] = __builtin_bit_cast(float, w.w & 0xffff0000u); }

__device__ __forceinline__ unsigned sig4_u8(const f32x4 v) { unsigned w = 0u;
#pragma unroll
    for (int i = 0; i < 4; ++i) { const float e = __builtin_amdgcn_exp2f(-1.4426950408889634f * v[i]); const unsigned q = (unsigned)(__builtin_amdgcn_rcpf(__builtin_fmaf(e, 1.f / 255.f, 1.f / 255.f)) + 0.5f); w |= q << (8 * i); }
    return w; }
__device__ __forceinline__ f32x4 u8x4_f32(const unsigned w) { return (f32x4){(float)(w & 255u), (float)((w >> 8) & 255u), (float)((w >> 16) & 255u), (float)(w >> 24)} * (1.f / 255.f); }
struct EpiProj {
    static constexpr bool PERM = true, AFTER_DRAIN = false, PERMA = false, PREFETCH = false, DUAL = false;
    bf16_t* P; bf16_t* KV; unsigned* KN;
    __device__ __forceinline__ void operator()(const f32x4 (&acc)[2][2][4][2], const Unit& u, int wr, int wc, int fr, int fq) const {
        const int pn = u.pn, pm = u.pm;
        if (pn >= 2 && pn < 6) {
            const size_t tile0 = ((size_t)(pm >> 5) * 4 * 128 + (size_t)((pm & 31) * 4 + wr)) * 16384;
            if (pn < 4) {
#pragma unroll
                for (int bj = 0; bj < 2; ++bj) { bf16_t* hb = KV + tile0 + (size_t)(2 * bj + (wc >> 1)) * 128 * 16384 + (pn == 3 ? 4096 : 0) + ((wc & 1) * 4 + fq) * 512 + fr * 8;
#pragma unroll
                    for (int ai = 0; ai < 2; ++ai)
#pragma unroll
                        for (int m = 0; m < 4; ++m) *(u32x4*)(hb + (size_t)ai * 2 * 16384 + m * 128) = pack8(acc[ai][bj][m][0], acc[ai][bj][m][1]); }
#pragma unroll
                for (int bj = 0; bj < 2; ++bj) { float hm = 0.f;
#pragma unroll
                    for (int ai = 0; ai < 2; ++ai)
#pragma unroll
                        for (int m = 0; m < 4; ++m) { const f32x4 a = acc[ai][bj][m][0], b = acc[ai][bj][m][1];
                            float q = (a[0] * a[0] + a[1] * a[1]) + (a[2] * a[2] + a[3] * a[3]) + (b[0] * b[0] + b[1] * b[1]) + (b[2] * b[2] + b[3] * b[3]);
                            q += __shfl_xor(q, 16); q += __shfl_xor(q, 32); hm = fmaxf(hm, q); }
                    hm = fmaxf(hm, __shfl_xor(hm, 1)); hm = fmaxf(hm, __shfl_xor(hm, 2)); hm = fmaxf(hm, __shfl_xor(hm, 4)); hm = fmaxf(hm, __shfl_xor(hm, 8));
                    if (fr == 0 && fq == 0) atomicMax(KN + ((pm >> 5) * 4 + 2 * bj + (wc >> 1)) * 2 + (pn - 2), __float_as_uint(hm * 1.01f)); }
            } else {
#pragma unroll
                for (int bj = 0; bj < 2; ++bj) { const int head = (pn - 4) * 2 + bj; const float sl = alibi_sl2(head);
                    bf16_t* hb = KV + tile0 + (size_t)head * 128 * 16384 + 8192 + wc * 2048 + fr * 32 + fq * 8;
#pragma unroll
                    for (int m = 0; m < 4; ++m) { const float sc = __builtin_amdgcn_exp2f(sl * (float)((fr + 16 * m) - 63));
#pragma unroll
                        for (int ai = 0; ai < 2; ++ai) *(u32x4*)(hb + (size_t)ai * 2 * 16384 + m * 512) = pack8(acc[ai][bj][m][0] * sc, acc[ai][bj][m][1] * sc); } }
            }
        } else {
            const int cpn = (pn < 2) ? pn : pn - 4;
            bf16_t* base = P + (size_t)(pm * BM + wr * 64 + fr) * PP + cpn * BM + wc * 32 + 8 * fq;
            if (pn >= 12) {
                unsigned char* gq = (unsigned char*)(P + (size_t)(pm * BM + wr * 64 + fr) * PP + C_GA) + (pn - 12) * 256 + wc * 64 + fq * 16;
#pragma unroll
                for (int ai = 0; ai < 2; ++ai)
#pragma unroll
                    for (int m = 0; m < 4; ++m) { u32x4 w; w.x = sig4_u8(acc[ai][0][m][0]); w.y = sig4_u8(acc[ai][0][m][1]); w.z = sig4_u8(acc[ai][1][m][0]); w.w = sig4_u8(acc[ai][1][m][1]);
                        *(u32x4*)(gq + (size_t)(ai * HALF + m * 16) * (PP * 2)) = w; }
            } else if (pn >= 10) {
#pragma unroll
                for (int ai = 0; ai < 2; ++ai)
#pragma unroll
                    for (int m = 0; m < 4; ++m)
#pragma unroll
                        for (int bj = 0; bj < 2; ++bj) { f32x4 a = acc[ai][bj][m][0], b = acc[ai][bj][m][1];
#pragma unroll
                            for (int i = 0; i < 4; ++i) { a[i] *= fast_sigmoid(a[i]); b[i] *= fast_sigmoid(b[i]); }
                            *(u32x4*)(base + (size_t)(ai * HALF + m * 16) * PP + bj * HALF) = pack8(a, b); }
            } else {
            const float sc = (pn < 2) ? C2 : (pn == 7) ? 0.125f : 1.f;
#pragma unroll
            for (int ai = 0; ai < 2; ++ai)
#pragma unroll
                for (int m = 0; m < 4; ++m)
#pragma unroll
                    for (int bj = 0; bj < 2; ++bj) *(u32x4*)(base + (size_t)(ai * HALF + m * 16) * PP + bj * HALF) = pack8(acc[ai][bj][m][0] * sc, acc[ai][bj][m][1] * sc);
            if (pn < 2) {
#pragma unroll
                for (int bj = 0; bj < 2; ++bj) { float hm = 0.f;
#pragma unroll
                    for (int ai = 0; ai < 2; ++ai)
#pragma unroll
                        for (int m = 0; m < 4; ++m) { const f32x4 a = acc[ai][bj][m][0], b = acc[ai][bj][m][1];
                            float q = (a[0] * a[0] + a[1] * a[1]) + (a[2] * a[2] + a[3] * a[3]) + (b[0] * b[0] + b[1] * b[1]) + (b[2] * b[2] + b[3] * b[3]);
                            q += __shfl_xor(q, 16); q += __shfl_xor(q, 32); hm = fmaxf(hm, q); }
                    hm = fmaxf(hm, __shfl_xor(hm, 1)); hm = fmaxf(hm, __shfl_xor(hm, 2)); hm = fmaxf(hm, __shfl_xor(hm, 4)); hm = fmaxf(hm, __shfl_xor(hm, 8));
                    if (fr == 0 && fq == 0) atomicMax(KN + 64 + ((pm >> 5) * 4 + 2 * bj + (wc >> 1)) * 2 + pn, __float_as_uint(hm * (C2 * C2) * 1.01f)); }
            }
            }
        }
    }
};
struct EpiMerge2 {
    static constexpr bool PERM = true, AFTER_DRAIN = false, PERMA = false, PREFETCH = false, DUAL = true;
    const bf16_t* P; bf16_t* MG;
    static __device__ __forceinline__ f32x4 u8f(const unsigned w) { return (f32x4){(float)(w & 255u), (float)((w >> 8) & 255u), (float)((w >> 16) & 255u), (float)(w >> 24)}; }
    static __device__ __forceinline__ f32x4 max1(const f32x4 v) { return (f32x4){fmaxf(v[0], 1.f), fmaxf(v[1], 1.f), fmaxf(v[2], 1.f), fmaxf(v[3], 1.f)}; }
    __device__ __forceinline__ void mid(f32x4 (&acc)[2][2][4][2], const Unit& u, int wr, int wc, int fr, int fq) const {
        const unsigned char* gq = (const unsigned char*)(P + (size_t)(u.pm * BM + wr * 64 + fr) * PP + C_GA) + u.pn * 256 + wc * 64 + fq * 16;
#pragma unroll
        for (int ai = 0; ai < 2; ++ai)
#pragma unroll
            for (int m = 0; m < 4; ++m) { const u32x4 wa = *(const u32x4*)(gq + (size_t)(ai * HALF + m * 16) * (PP * 2)), wq = *(const u32x4*)(gq + 1024 + (size_t)(ai * HALF + m * 16) * (PP * 2));
#pragma unroll
                for (int bj = 0; bj < 2; ++bj)
#pragma unroll
                    for (int n = 0; n < 2; ++n) { const unsigned da = bj ? (n ? wa.w : wa.z) : (n ? wa.y : wa.x), dr = bj ? (n ? wq.w : wq.z) : (n ? wq.y : wq.x);
                        const f32x4 qa = u8f(da), qr = max1(u8f(dr));
#pragma unroll
                        for (int i = 0; i < 4; ++i) acc[ai][bj][m][n][i] *= qa[i] * __builtin_amdgcn_rcpf(qr[i]); } }
    }
    __device__ __forceinline__ void operator()(const f32x4 (&acc)[2][2][4][2], const Unit& u, int wr, int wc, int fr, int fq) const {
        const int row0 = u.pm * BM + wr * 64 + fr, col0 = u.pn * BM + wc * 32 + 8 * fq;
        const unsigned char* gq = (const unsigned char*)(P + (size_t)row0 * PP + C_GA) + 1024 + u.pn * 256 + wc * 64 + fq * 16;
#pragma unroll
        for (int ai = 0; ai < 2; ++ai)
#pragma unroll
            for (int m = 0; m < 4; ++m) { const int row = row0 + ai * HALF + m * 16;
                const u32x4 wq = *(const u32x4*)(gq + (size_t)(ai * HALF + m * 16) * (PP * 2));
#pragma unroll
                for (int bj = 0; bj < 2; ++bj) { const f32x4 s0 = max1(u8f(bj ? wq.z : wq.x)) * (1.f / 255.f), s1 = max1(u8f(bj ? wq.w : wq.y)) * (1.f / 255.f);
                    *(u32x4*)(MG + (size_t)row * DM + col0 + bj * HALF) = pack8(acc[ai][bj][m][0] * s0, acc[ai][bj][m][1] * s1); } }
    }
};
__device__ __forceinline__ void store_ssq(float* SSQ, float a, float b, int row0, int slot, int fq) {
    const int ra = row0 + (fq >> 1) * HALF + (fq & 1) * 32;
    SSQ[(size_t)ra * 16 + slot] = a; SSQ[(size_t)(ra + 16) * 16 + slot] = b;
}
struct EpiOutProj {
    static constexpr bool PERM = true, AFTER_DRAIN = false, PERMA = false, PREFETCH = false, DUAL = false;
    const float* X; bf16_t* X1B; float* SSQ;
    __device__ __forceinline__ void operator()(const f32x4 (&acc)[2][2][4][2], const Unit& u, int wr, int wc, int fr, int fq) const {
        const int row0 = u.pm * BM + wr * 64 + fr, col0 = u.pn * BM + wc * 32 + 8 * fq;
        float sa = 0.f, sb = 0.f;
#pragma unroll
        for (int ai = 0; ai < 2; ++ai)
#pragma unroll
            for (int m = 0; m < 4; ++m) { const int row = row0 + ai * HALF + m * 16; float s = 0.f;
#pragma unroll
                for (int bj = 0; bj < 2; ++bj) { const size_t off = (size_t)row * DM + col0 + bj * HALF;
                    const f32x4 v0 = *(const f32x4*)(X + off) + acc[ai][bj][m][0], v1 = *(const f32x4*)(X + off + 4) + acc[ai][bj][m][1];
                    *(u32x4*)(X1B + off) = pack8(v0, v1);
                    s += (v0[0] * v0[0] + v0[1] * v0[1]) + (v0[2] * v0[2] + v0[3] * v0[3]) + (v1[0] * v1[0] + v1[1] * v1[1]) + (v1[2] * v1[2] + v1[3] * v1[3]); }
                s += __shfl_xor(s, 16); s += __shfl_xor(s, 32); if (((ai * 4 + m) >> 1) == fq) { if (m & 1) sb = s; else sa = s; } }
        store_ssq(SSQ, sa, sb, row0, u.pn * 4 + wc, fq);
    }
};
__device__ __forceinline__ float dpp_shr1(float x) { return __builtin_bit_cast(float, __builtin_amdgcn_update_dpp(0, __builtin_bit_cast(int, x), 0x111, 0xf, 0xf, true)); }
__device__ __forceinline__ f32x4 row_shr1(const f32x4 v) {
    const float a = v[0], b = v[1], c = v[2], d = v[3];
    return (f32x4){dpp_shr1(a), dpp_shr1(b), dpp_shr1(c), dpp_shr1(d)};
}
struct EpiUpConv {
    static constexpr bool PERM = true, AFTER_DRAIN = false, PERMA = true, PREFETCH = true, DUAL = false;
    const float* SSQ; bf16_t* G; float* HB; const float* cw; const float* cb; PG8_LAS float* halo;
    __device__ __forceinline__ void prefetch(const Unit& u, int ui, int wid, int lane) const {
        const int fr = lane & 15, fq = lane >> 4;
#pragma unroll
        for (int i = 0; i < 2; ++i) { const int k = 2 * wid + i;
            __builtin_amdgcn_global_load_lds((const unsigned*)(SSQ + (size_t)(u.pm * BM + (k >> 3) * 128 + fr * 8 + (k & 7)) * 16 + 4 * fq), (PG8_LAS unsigned*)(halo + 2560 + k * 256), 16, 0, 0); }
        const int w = wid & 3, row = 2 * w + (lane >> 5), c = (lane & 31) * 4, gcb = u.pn * HALF;
        const float* src = (row < 6) ? cw + (row >> 1) * FF2 + (row & 1) * FF + gcb + c : cb + (row & 1) * FF + gcb + c;
        __builtin_amdgcn_global_load_lds((const unsigned*)src, (PG8_LAS unsigned*)(halo + 512 + (ui & 1) * 1024 + w * 256), 16, 0, 0);
    }
    __device__ __forceinline__ void operator()(f32x4 (&acc)[2][2][4][2], const Unit& u, int wr, int wc, int fr, int fq, int ui) const {
        const int pn = u.pn, pm = u.pm, tok0 = pm * BM + wr * 128 + fr * 8, cl = wc * 32 + 8 * fq;
        const bool seq_start = (pm & 31) == 0;
        PG8_LAS float* wt = halo + 512 + (ui & 1) * 1024;
#pragma unroll
        for (int ai = 0; ai < 2; ++ai)
#pragma unroll
            for (int m = 0; m < 4; ++m) { const f32x4 a = *(const PG8_LAS f32x4*)(halo + 2560 + ((wr * 8 + 4 * ai + m) * 64 + fq * 16 + fr) * 4);
                float sq = (a[0] + a[1]) + (a[2] + a[3]); sq += __shfl_xor(sq, 16); sq += __shfl_xor(sq, 32);
                const float r = rsqrtf(sq * (1.f / DM) + NORM_EPS);
#pragma unroll
                for (int bj = 0; bj < 2; ++bj)
#pragma unroll
                    for (int n = 0; n < 2; ++n) acc[ai][bj][m][n] = acc[ai][bj][m][n] * r; }
        if (fr == 15) {
#pragma unroll
            for (int bj = 0; bj < 2; ++bj)
#pragma unroll
                for (int n = 0; n < 2; ++n)
#pragma unroll
                    for (int q = 0; q < 2; ++q) { const f32x4 v = acc[1][bj][2 + q][n];
                        if (wr == 0) *(PG8_LAS f32x4*)(halo + q * 256 + bj * HALF + cl + 4 * n) = v;
                        else *(f32x4*)(HB + ((size_t)pm * 4 + 2 + q) * FF2 + pn * BM + bj * HALF + cl + 4 * n) = v; }
        }
        if (fr == 0 && wr == 0) {
#pragma unroll
            for (int bj = 0; bj < 2; ++bj)
#pragma unroll
                for (int n = 0; n < 2; ++n)
#pragma unroll
                    for (int q = 0; q < 2; ++q) *(f32x4*)(HB + ((size_t)pm * 4 + q) * FF2 + pn * BM + bj * HALF + cl + 4 * n) = acc[0][bj][q][n];
        }
        asm volatile("s_waitcnt lgkmcnt(0)\n\ts_barrier" ::: "memory");
        const int gc = pn * HALF + cl;
        const float hk = (wr == 1 && fr == 0) ? 1.f : 0.f;
#pragma unroll
        for (int jh = 0; jh < 2; ++jh) {
            u32x2 gpk[4];
#pragma unroll
            for (int n = 0; n < 2; ++n) {
                f32x4 g6 = {}, g7 = {}, u6 = {}, u7 = {};
                if (jh == 0) {
                    g6 = row_shr1(acc[1][0][2][n]); g7 = row_shr1(acc[1][0][3][n]); u6 = row_shr1(acc[1][1][2][n]); u7 = row_shr1(acc[1][1][3][n]);
                    g6 = g6 + *(const PG8_LAS f32x4*)(halo + cl + 4 * n) * hk; g7 = g7 + *(const PG8_LAS f32x4*)(halo + 256 + cl + 4 * n) * hk;
                    u6 = u6 + *(const PG8_LAS f32x4*)(halo + HALF + cl + 4 * n) * hk; u7 = u7 + *(const PG8_LAS f32x4*)(halo + 256 + HALF + cl + 4 * n) * hk;
                }
                const f32x4 wg0 = *(const PG8_LAS f32x4*)(wt + 0 * 128 + cl + 4 * n), wg1 = *(const PG8_LAS f32x4*)(wt + 2 * 128 + cl + 4 * n), wg2 = *(const PG8_LAS f32x4*)(wt + 4 * 128 + cl + 4 * n), bg = *(const PG8_LAS f32x4*)(wt + 6 * 128 + cl + 4 * n);
                const f32x4 wu0 = *(const PG8_LAS f32x4*)(wt + 1 * 128 + cl + 4 * n), wu1 = *(const PG8_LAS f32x4*)(wt + 3 * 128 + cl + 4 * n), wu2 = *(const PG8_LAS f32x4*)(wt + 5 * 128 + cl + 4 * n), bu = *(const PG8_LAS f32x4*)(wt + 7 * 128 + cl + 4 * n);
#pragma unroll
                for (int jj = 0; jj < 4; ++jj) { const int j = 4 * jh + jj;
                    const f32x4 vg = acc[j >> 2][0][j & 3][n], vu = acc[j >> 2][1][j & 3][n];
                    const int j1 = (j >= 1) ? j - 1 : 0, j2 = (j >= 2) ? j - 2 : 0;
                    const f32x4 pg1 = (j >= 1) ? acc[j1 >> 2][0][j1 & 3][n] : g7, pg2 = (j >= 2) ? acc[j2 >> 2][0][j2 & 3][n] : (j == 1 ? g7 : g6);
                    const f32x4 pu1 = (j >= 1) ? acc[j1 >> 2][1][j1 & 3][n] : u7, pu2 = (j >= 2) ? acc[j2 >> 2][1][j2 & 3][n] : (j == 1 ? u7 : u6);
                    f32x4 zg = bg + wg2 * vg + wg1 * pg1 + wg0 * pg2; asm volatile("" : "+v"(zg));
                    f32x4 zu = bu + wu2 * vu + wu1 * pu1 + wu0 * pu2; asm volatile("" : "+v"(zu));
                    f32x4 r;
#pragma unroll
                    for (int i = 0; i < 4; ++i) r[i] = (zg[i] * zu[i]) * __builtin_amdgcn_rcpf(1.f + __builtin_amdgcn_exp2f(zg[i]));
                    u32x2 w; w.x = cvt_pk_bf16(r[0], r[1]); w.y = cvt_pk_bf16(r[2], r[3]);
                    const bool skip = (wr == 0) && (fr == 0) && (j < 2) && !seq_start;
                    if (n == 0) { gpk[jj] = w; asm volatile("" : "+v"(gpk[jj].x), "+v"(gpk[jj].y)); }
                    else if (!skip) *(u32x4*)(G + (size_t)(tok0 + j) * FF + gc) = (u32x4){gpk[jj].x, gpk[jj].y, w.x, w.y};
                }
                __builtin_amdgcn_sched_barrier(0);
            }
        }
    }
};
struct EpiDown {
    static constexpr bool PERM = true, AFTER_DRAIN = false, PERMA = false, PREFETCH = false, DUAL = false;
    const bf16_t* X1B; bf16_t* X2B; float* SSQ;
    __device__ __forceinline__ void operator()(const f32x4 (&acc)[2][2][4][2], const Unit& u, int wr, int wc, int fr, int fq) const {
        const int row0 = u.pm * BM + wr * 64 + fr, col0 = u.pn * BM + wc * 32 + 8 * fq;
        float sa = 0.f, sb = 0.f;
#pragma unroll
        for (int ai = 0; ai < 2; ++ai)
#pragma unroll
            for (int m = 0; m < 4; ++m) { const int row = row0 + ai * HALF + m * 16; float s = 0.f;
#pragma unroll
                for (int bj = 0; bj < 2; ++bj) { const size_t off = (size_t)row * DM + col0 + bj * HALF;
                    f32x4 v0, v1; unpack8(*(const u32x4*)(X1B + off), v0, v1); v0 = v0 + acc[ai][bj][m][0]; v1 = v1 + acc[ai][bj][m][1];
                    *(u32x4*)(X2B + off) = pack8(v0, v1);
                    s += (v0[0] * v0[0] + v0[1] * v0[1]) + (v0[2] * v0[2] + v0[3] * v0[3]) + (v1[0] * v1[0] + v1[1] * v1[1]) + (v1[2] * v1[2] + v1[3] * v1[3]); }
                s += __shfl_xor(s, 16); s += __shfl_xor(s, 32); if (((ai * 4 + m) >> 1) == fq) { if (m & 1) sb = s; else sa = s; } }
        store_ssq(SSQ, sa, sb, row0, u.pn * 4 + wc, fq);
    }
};
template <class Epi, class Sched, bool ALIGN_EPI = false, bool SP2 = false>
__device__ __forceinline__ void gemm_phase(PG8_LAS unsigned char* lds, const Gemm g, const Sched& S, const Epi& E, const int wid) {
    const int lane = lane_now(), tid = wid * 64 + lane, wr = wid >> 2, wc = wid & 3, fr = lane & 15, fq = lane >> 4;
    const int K = g.K, nt = K / BK;
    unsigned voffA[2], voffB[2];
#pragma unroll
    for (int i = 0; i < 2; ++i) { int R, C; stage_rc(tid * 16 + i * 8192, R, C); const int Rb = Epi::PERM ? ((R & ~31) + perm32(R & 31)) : R;
        const int Ra = Epi::PERMA ? (128 * ((R >> 6) & 1) + 8 * (R & 15) + ((R >> 4) & 3)) : R;
        voffA[i] = (unsigned)(Ra * K + C) * 2u; voffB[i] = (unsigned)(Rb * K + C) * 2u; }
    const size_t kstep = (size_t)(BK * 2);
    const size_t hstep = (size_t)HALF * K * 2;
    const size_t tstep = 2 * hstep;
    const size_t hstepA = Epi::PERMA ? (size_t)4 * K * 2 : hstep;
    const unsigned ldsw = (unsigned)wid * 1024u;
    const int aoff = lds_byte(wr * 64 + fr, fq * 8), boff = lds_byte(wc * 32 + fr, fq * 8);
#define PG8_SA(b, h) (((b) * 2 + (h)) * HTB)
#define PG8_SB(b, h) ((4 + (b) * 2 + (h)) * HTB)
#define PG8_STAGE(bufoff, gbase, voff) do { _Pragma("unroll") for (int _i = 0; _i < 2; ++_i) \
        __builtin_amdgcn_global_load_lds((const unsigned*)((const char*)(gbase) + (voff)[_i]), (PG8_LAS unsigned*)(lds + (bufoff) + ldsw + _i * 8192), 16, 0, 0); } while (0)
#define PG8_LDA(dst, b, h) do { _Pragma("unroll") for (int m = 0; m < 4; ++m) _Pragma("unroll") for (int k = 0; k < 2; ++k) dst[m][k] = *(const PG8_LAS bf16x8*)(lds + PG8_SA(b, h) + aoff + m * 2048 + k * 1024); } while (0)
#define PG8_LDB(dst, b, h) do { _Pragma("unroll") for (int n = 0; n < 2; ++n) _Pragma("unroll") for (int k = 0; k < 2; ++k) dst[n][k] = *(const PG8_LAS bf16x8*)(lds + PG8_SB(b, h) + boff + n * 2048 + k * 1024); } while (0)
#define PG8_MMA(ai, bj, At, Bt) do { __builtin_amdgcn_s_setprio(1); _Pragma("unroll") for (int m = 0; m < 4; ++m) _Pragma("unroll") for (int n = 0; n < 2; ++n) _Pragma("unroll") for (int k = 0; k < 2; ++k) \
        acc[ai][bj][m][n] = __builtin_amdgcn_mfma_f32_16x16x32_bf16(Bt[n][k], At[m][k], acc[ai][bj][m][n], 0, 0, 0); __builtin_amdgcn_s_setprio(0); } while (0)
#define PG8_WAIT_V(n) asm volatile("s_waitcnt vmcnt(" #n ")" ::: "memory")
#define PG8_WAIT_L(n) asm volatile("s_waitcnt lgkmcnt(" #n ")" ::: "memory")
#define PG8_BAR __builtin_amdgcn_s_barrier()
#define PG8_SCHED __builtin_amdgcn_sched_barrier(0)
    Unit cur, nxt; int ui = 0;
    if (!S.next(0, cur)) return;
    f32x4 acc[2][2][4][2];
#pragma unroll
    for (int a = 0; a < 2; ++a)
#pragma unroll
        for (int b = 0; b < 2; ++b)
#pragma unroll
            for (int m = 0; m < 4; ++m)
#pragma unroll
                for (int n = 0; n < 2; ++n) acc[a][b][m][n] = (f32x4){0.f, 0.f, 0.f, 0.f};
    bf16x8 At[4][2], B0[2][2], B1[2][2];
    const char* cA = (const char*)((Epi::DUAL && cur.seg) ? g.A2 : g.A) + (size_t)cur.pm * tstep; const char* cB = (const char*)((Epi::DUAL && cur.seg) ? g.Bt2 : g.Bt) + (size_t)cur.pn * tstep;
    S.a_ready(cur);
    if constexpr (Epi::PREFETCH) E.prefetch(cur, 0, wid, lane);
    if constexpr (SP2) {
        PG8_STAGE(PG8_SB(0, 0), cB, voffB); PG8_STAGE(PG8_SB(0, 1), cB + hstep, voffB); PG8_STAGE(PG8_SA(0, 0), cA, voffA); PG8_STAGE(PG8_SA(0, 1), cA + hstepA, voffA);
        if (wr == 1) PG8_BAR;
        PG8_WAIT_V(2); PG8_BAR;
        PG8_STAGE(PG8_SB(1, 0), cB + kstep, voffB); PG8_STAGE(PG8_SA(1, 0), cA + kstep, voffA); PG8_STAGE(PG8_SB(1, 1), cB + hstep + kstep, voffB);
        PG8_WAIT_V(6); PG8_BAR;
    } else {
        PG8_STAGE(PG8_SB(0, 0), cB, voffB); PG8_STAGE(PG8_SA(0, 0), cA, voffA); PG8_STAGE(PG8_SB(0, 1), cB + hstep, voffB); PG8_STAGE(PG8_SA(0, 1), cA + hstepA, voffA);
        if (wr == 1) PG8_BAR;
        PG8_WAIT_V(4); PG8_BAR;
        PG8_STAGE(PG8_SB(1, 0), cB + kstep, voffB); PG8_STAGE(PG8_SA(1, 0), cA + kstep, voffA); PG8_STAGE(PG8_SB(1, 1), cB + hstep + kstep, voffB);
        PG8_WAIT_V(6); PG8_BAR;
    }
    for (;;) {
        const bool has_next = S.next(ui + 1, nxt);
        const char* nA = has_next ? (const char*)((Epi::DUAL && nxt.seg) ? g.A2 : g.A) + (size_t)nxt.pm * tstep : cA; const char* nB = has_next ? (const char*)((Epi::DUAL && nxt.seg) ? g.Bt2 : g.Bt) + (size_t)nxt.pn * tstep : cB;
        for (int t = 0; t < nt; t += 2) {
            const bool last = (t == nt - 2);
            const char* a1 = cA + (size_t)(t + 1) * kstep;
            const char* a2 = last ? nA : cA + (size_t)(t + 2) * kstep; const char* b2 = last ? nB : cB + (size_t)(t + 2) * kstep;
            const char* a3 = a2 + kstep; const char* b3 = b2 + kstep;
            if (last && has_next) S.a_ready(nxt);
            if constexpr (SP2) {
            PG8_LDB(B0, 0, 0); PG8_LDB(B1, 0, 1); PG8_SCHED; PG8_LDA(At, 0, 0); PG8_STAGE(PG8_SA(1, 1), a1 + hstepA, voffA);
            PG8_WAIT_V(8); PG8_WAIT_L(0); PG8_BAR; PG8_MMA(0, 0, At, B0); PG8_MMA(0, 1, At, B1); PG8_BAR; PG8_SCHED;
            PG8_LDA(At, 0, 1); PG8_STAGE(PG8_SB(0, 0), b2, voffB); PG8_STAGE(PG8_SB(0, 1), b2 + hstep, voffB); PG8_STAGE(PG8_SA(0, 0), a2, voffA);
            PG8_WAIT_V(8); PG8_WAIT_L(0); PG8_BAR; PG8_MMA(1, 0, At, B0); PG8_MMA(1, 1, At, B1); PG8_BAR; PG8_SCHED;
            PG8_LDB(B0, 1, 0); PG8_LDB(B1, 1, 1); PG8_SCHED; PG8_LDA(At, 1, 0); PG8_STAGE(PG8_SA(0, 1), a2 + hstepA, voffA);
            PG8_WAIT_V(8); PG8_WAIT_L(0); PG8_BAR; PG8_MMA(0, 0, At, B0); PG8_MMA(0, 1, At, B1); PG8_BAR; PG8_SCHED;
            PG8_LDA(At, 1, 1); PG8_STAGE(PG8_SB(1, 0), b3, voffB); PG8_STAGE(PG8_SB(1, 1), b3 + hstep, voffB); PG8_STAGE(PG8_SA(1, 0), a3, voffA);
            PG8_WAIT_V(8); PG8_WAIT_L(0); PG8_BAR; PG8_MMA(1, 0, At, B0); PG8_MMA(1, 1, At, B1); PG8_BAR; PG8_SCHED;
            } else {
            PG8_LDB(B0, 0, 0); PG8_SCHED; PG8_LDA(At, 0, 0); PG8_STAGE(PG8_SA(1, 1), a1 + hstepA, voffA);
            PG8_WAIT_L(8); PG8_BAR; PG8_WAIT_L(0); PG8_MMA(0, 0, At, B0); PG8_BAR; PG8_SCHED;
            PG8_LDB(B1, 0, 1); PG8_STAGE(PG8_SB(0, 0), b2, voffB);
            PG8_BAR; PG8_WAIT_L(0); PG8_MMA(0, 1, At, B1); PG8_BAR;
            PG8_LDA(At, 0, 1); PG8_STAGE(PG8_SA(0, 0), a2, voffA);
            PG8_BAR; PG8_WAIT_L(0); PG8_MMA(1, 0, At, B0); PG8_BAR; PG8_SCHED;
            PG8_STAGE(PG8_SB(0, 1), b2 + hstep, voffB);
            PG8_WAIT_V(6); PG8_BAR; PG8_MMA(1, 1, At, B1); PG8_BAR;
            PG8_LDB(B0, 1, 0); PG8_SCHED; PG8_LDA(At, 1, 0); PG8_STAGE(PG8_SA(0, 1), a2 + hstepA, voffA);
            PG8_WAIT_L(8); PG8_BAR; PG8_WAIT_L(0); PG8_MMA(0, 0, At, B0); PG8_BAR; PG8_SCHED;
            PG8_LDB(B1, 1, 1); PG8_STAGE(PG8_SB(1, 0), b3, voffB);
            PG8_BAR; PG8_WAIT_L(0); PG8_MMA(0, 1, At, B1); PG8_BAR;
            PG8_LDA(At, 1, 1); PG8_STAGE(PG8_SA(1, 0), a3, voffA);
            PG8_BAR; PG8_WAIT_L(0); PG8_MMA(1, 0, At, B0); PG8_BAR; PG8_SCHED;
            PG8_STAGE(PG8_SB(1, 1), b3 + hstep, voffB);
            PG8_WAIT_V(6); PG8_BAR; PG8_MMA(1, 1, At, B1); PG8_BAR;
            }
        }
        if constexpr (ALIGN_EPI) { if (wr == 0) PG8_BAR; }
        if constexpr (!Epi::AFTER_DRAIN) { if constexpr (Epi::PREFETCH) E(acc, cur, wr, wc, fr, fq, ui); else if constexpr (Epi::DUAL) { if (cur.seg == 0) E.mid(acc, cur, wr, wc, fr, fq); else E(acc, cur, wr, wc, fr, fq); } else E(acc, cur, wr, wc, fr, fq); S.done(cur); }
        if (!has_next) break;
        if (!(Epi::DUAL && cur.seg == 0))
#pragma unroll
        for (int a = 0; a < 2; ++a)
#pragma unroll
            for (int b = 0; b < 2; ++b)
#pragma unroll
                for (int m = 0; m < 4; ++m)
#pragma unroll
                    for (int n = 0; n < 2; ++n) acc[a][b][m][n] = (f32x4){0.f, 0.f, 0.f, 0.f};
        cur = nxt; cA = nA; cB = nB; ++ui;
        if constexpr (Epi::PREFETCH) E.prefetch(cur, ui, wid, lane);
        if constexpr (ALIGN_EPI) { if (wr == 1) PG8_BAR; }
    }
    PG8_WAIT_V(0);
    if constexpr (!ALIGN_EPI) { if (wr == 0) PG8_BAR; }
    PG8_BAR;
    if constexpr (Epi::AFTER_DRAIN) { E.fused(acc, cur, wr, wc, fr, fq, lds, wid, lane); S.done(cur); }
#undef PG8_SA
#undef PG8_SB
#undef PG8_STAGE
#undef PG8_LDA
#undef PG8_LDB
#undef PG8_MMA
#undef PG8_WAIT_V
#undef PG8_WAIT_L
#undef PG8_BAR
#undef PG8_SCHED
}
}

#define GAS __attribute__((address_space(1)))
#define LAS __attribute__((address_space(3)))
typedef GAS unsigned gu32;
typedef GAS unsigned long long gu64;
#define RLX_AGENT __ATOMIC_RELAXED, __HIP_MEMORY_SCOPE_AGENT
#define LDS_WAIT() asm volatile("s_waitcnt lgkmcnt(0)" ::: "memory")
#define VM_WAIT() asm volatile("s_waitcnt vmcnt(0)" ::: "memory")
#define XB_TMO      128
#define XB_XCNT(j)  (256  + 64 * (j))
#define XB_XSUB(j)  (1280 + 64 * (j))
#define XB_XGEN(j)  (2304 + 64 * (j))
#define XB_TOP      3328
#define XB_TOPGEN   3392
#define XB_LSUB(j)  (3456 + 64 * (j))
#define XB_LGEN(j)  (4480 + 64 * (j))
#define XCD_BAR_WORDS 5504
#define XB_SPIN_CAP (1u << 18)

__device__ __forceinline__ unsigned xb_ld(unsigned* p)              { return __hip_atomic_load(p, __ATOMIC_RELAXED, __HIP_MEMORY_SCOPE_AGENT); }
__device__ __forceinline__ unsigned xb_add(unsigned* p, unsigned v) { return __hip_atomic_fetch_add(p, v, __ATOMIC_RELAXED, __HIP_MEMORY_SCOPE_AGENT); }
__device__ __forceinline__ unsigned xb_xcc_id() { return (unsigned)__builtin_amdgcn_s_getreg((3 << 11) | 20) & 0xFu; }
#define XB_SPIN(cond, bar) do { unsigned _sp = 0; while (cond) { __builtin_amdgcn_s_sleep(1); \
    if ((++_sp & 255u) == 0u) { if (xb_ld(&(bar)[XB_TMO])) break; if (_sp > XB_SPIN_CAP) { atomicAdd(&(bar)[XB_TMO], 1u); break; } } } } while (0)

struct XcdBarrier {
    unsigned* bar; unsigned x; int wv;
    volatile LAS unsigned* st;
};

__device__ __forceinline__ XcdBarrier xcd_barrier_post(unsigned* bar, volatile LAS unsigned* st, int wv) {
    XcdBarrier b; b.bar = bar; b.x = xb_xcc_id(); b.st = st; b.wv = wv;
    if (wv == 0 && lane_now() == 0) (void)xb_add(&bar[XB_XCNT(b.x)], 1u);
    return b;
}
__device__ __forceinline__ void xcd_barrier_complete(unsigned* bar, unsigned x, unsigned& nloc, unsigned& nx) {
    const unsigned G = gridDim.x * gridDim.y * gridDim.z;
    unsigned sum, cnt, mine, sp = 0u;
    for (;;) {
        sum = 0u; cnt = 0u; mine = 0u;
#pragma unroll
        for (unsigned j = 0; j < 16; ++j) { const unsigned c = xb_ld(&bar[XB_XCNT(j)]); sum += c; cnt += (c > 0u) ? 1u : 0u; mine = (j == x) ? c : mine; }
        if (sum == G) break;
        __builtin_amdgcn_s_sleep(1);
        if ((++sp & 255u) == 0u) { if (xb_ld(&bar[XB_TMO])) break; if (sp > XB_SPIN_CAP) { atomicAdd(&bar[XB_TMO], 1u); break; } }
    }
    nloc = mine > 0u ? mine : 1u; nx = cnt > 0u ? cnt : 1u;
}

__device__ __forceinline__ void xcd_barrier(const XcdBarrier& b) {
    asm volatile("s_waitcnt vmcnt(0)" ::: "memory");
    __syncthreads();
    if (b.wv == 0 && lane_now() == 0) {
        unsigned* bar = b.bar;
        __builtin_amdgcn_s_waitcnt(0);
        unsigned nloc = b.st[0], nx = b.st[1];
        if (nloc == 0u) { xcd_barrier_complete(bar, b.x, nloc, nx); b.st[0] = nloc; b.st[1] = nx; }
        const unsigned old = xb_add(&bar[XB_XSUB(b.x)], 1u);
        const unsigned gen = old / nloc;
        if (old + 1u == (gen + 1u) * nloc) {
            __builtin_amdgcn_fence(__ATOMIC_RELEASE, "agent");
            asm volatile("s_waitcnt vmcnt(0)" ::: "memory");
            const unsigned og = xb_add(&bar[XB_TOP], 1u);
            const unsigned tg = og / nx;
            if (og + 1u == (tg + 1u) * nx) xb_add(&bar[XB_TOPGEN], 1u);
            else XB_SPIN(xb_ld(&bar[XB_TOPGEN]) == tg, bar);
            __builtin_amdgcn_fence(__ATOMIC_ACQUIRE, "agent");
            xb_add(&bar[XB_XGEN(b.x)], 1u);
            asm volatile("s_waitcnt vmcnt(0)" ::: "memory");
        } else {
            XB_SPIN(xb_ld(&bar[XB_XGEN(b.x)]) == gen, bar);
            __builtin_amdgcn_fence(__ATOMIC_ACQUIRE, "agent");
            asm volatile("s_waitcnt vmcnt(0)" ::: "memory");
        }
    }
    __syncthreads();
}
__device__ __forceinline__ void xcd_barrier_local(const XcdBarrier& b) {
    asm volatile("s_waitcnt vmcnt(0)" ::: "memory");
    __syncthreads();
    if (b.wv == 0 && lane_now() == 0) {
        unsigned* bar = b.bar;
        __builtin_amdgcn_s_waitcnt(0);
        const unsigned nloc = b.st[0];
        const unsigned old = xb_add(&bar[XB_LSUB(b.x)], 1u);
        const unsigned gen = old / nloc;
        if (old + 1u == (gen + 1u) * nloc) xb_add(&bar[XB_LGEN(b.x)], 1u);
        else XB_SPIN(xb_ld(&bar[XB_LGEN(b.x)]) == gen, bar);
        __builtin_amdgcn_fence(__ATOMIC_ACQUIRE, "agent");
        asm volatile("s_waitcnt vmcnt(0)" ::: "memory");
    }
    __syncthreads();
}

namespace ret {
typedef short s16x4 __attribute__((ext_vector_type(4)));
typedef short v4i16_t __attribute__((ext_vector_type(4)));
typedef LAS const unsigned char* lptr;
constexpr int QS_STRIDE = 144, KD_STRIDE = 192, VS_STRIDE = 320, OUT_STRIDE = 528;
constexpr int OFF_QS = 0, OFF_ST = 18432, OFF_KS = 36864, OFF_KD = 55296, OFF_VS = 79872, OFF_END = 120832, OFF_OUT = OFF_KS, OFF_SSQ = OFF_END;
static_assert(OFF_OUT + 128 * OUT_STRIDE <= OFF_END && OFF_SSQ + 1024 <= 131072, "retention LDS map");
__device__ __forceinline__ s16x4 vtr(lptr p) { return __builtin_bit_cast(s16x4, __builtin_amdgcn_ds_read_tr16_b64_v4i16((LAS v4i16_t*)p)); }
__device__ __forceinline__ bf16x8 cat8(const s16x4 lo, const s16x4 hi) { return (bf16x8){lo[0], lo[1], lo[2], lo[3], hi[0], hi[1], hi[2], hi[3]}; }

__device__ __forceinline__ void stage_chunk(LAS unsigned char* lds, const bf16* rowbase, int h, float lg, int tid, bool with_qk) {
#pragma unroll
    for (int i = 0; i < 2; ++i) { const int it = tid + 512 * i, row = it >> 3, ch = it & 7;
        const u32x4 k = *(const u32x4*)(rowbase + (size_t)row * PP + C_KR + h * HD + ch * 8);
        f32x4 a, b; pg8::unpack8(k, a, b); const float d = __builtin_amdgcn_exp2f(lg * (float)(127 - row));
        *(LAS u32x4*)(lds + OFF_KD + row * KD_STRIDE + ch * 16) = pg8::pack8(a * d, b * d);
        if (with_qk) { *(LAS u32x4*)(lds + OFF_KS + row * QS_STRIDE + ch * 16) = k;
            *(LAS u32x4*)(lds + OFF_QS + row * QS_STRIDE + ch * 16) = *(const u32x4*)(rowbase + (size_t)row * PP + C_QR + h * HD + ch * 8); } }
#pragma unroll
    for (int i = 0; i < 4; ++i) { const int it = tid + 512 * i, row = it >> 4, ch = it & 15;
        *(LAS u32x4*)(lds + OFF_VS + row * VS_STRIDE + ch * 16) = *(const u32x4*)(rowbase + (size_t)row * PP + C_VR + h * DV + ch * 8); }
}
__device__ __forceinline__ void state_update(f32x16& st, lptr lds, int dkb, int dvb, float gC, int lane) {
    const int hi = lane >> 5, g = (lane >> 4) & 1, qq = (lane & 15) >> 2, pp = lane & 3;
    lptr ka = lds + OFF_KD + (8 * hi + qq) * KD_STRIDE + (32 * dkb + 16 * g + 4 * pp) * 2;
    lptr va = lds + OFF_VS + (8 * hi + qq) * VS_STRIDE + (32 * dvb + 16 * g + 4 * pp) * 2;
#pragma unroll
    for (int r = 0; r < 16; ++r) st[r] *= gC;
#pragma unroll
    for (int ks = 0; ks < 8; ++ks) {
        const bf16x8 a = cat8(vtr(ka + ks * 16 * KD_STRIDE), vtr(ka + (ks * 16 + 4) * KD_STRIDE));
        const bf16x8 b = cat8(vtr(va + ks * 16 * VS_STRIDE), vtr(va + (ks * 16 + 4) * VS_STRIDE));
        st = __builtin_amdgcn_mfma_f32_32x32x16_bf16(a, b, st, 0, 0, 0);
    }
}

__device__ __forceinline__ void ret_group_state(LAS unsigned char* lds, const bf16* PROJ, float* GST, int ui, int tid) {
    const int lane = tid & 63, wave = __builtin_amdgcn_readfirstlane(tid >> 6), hi = lane >> 5;
    const int bh = ui >> 3, s = ui & 7, h = bh & 3, b = bh >> 2, dkb = wave & 1, dvb = wave >> 1;
    const float lg = ret_lg2(h), gC = __builtin_amdgcn_exp2f(lg * 128.f);
    f32x16 st = {};
    const bf16* rb0 = PROJ + ((size_t)b * SEQ + (size_t)(8 * s) * 128) * PP;
    const size_t koff0 = (size_t)(tid >> 3) * PP + C_KR + h * HD + (tid & 7) * 8, voff0 = (size_t)(tid >> 4) * PP + C_VR + h * DV + (tid & 15) * 8;
    u32x4 kk[3][2], vv[3][4];
#pragma unroll
    for (int c = 0; c < 3; ++c) { const bf16* rb = rb0 + (size_t)c * 128 * PP;
#pragma unroll
        for (int i = 0; i < 2; ++i) kk[c][i] = *(const u32x4*)(rb + koff0 + (size_t)(64 * i) * PP);
#pragma unroll
        for (int i = 0; i < 4; ++i) vv[c][i] = *(const u32x4*)(rb + voff0 + (size_t)(32 * i) * PP); }
#pragma unroll
    for (int c = 0; c < 8; ++c) { const int q = c % 3;
        __syncthreads();
#pragma unroll
        for (int i = 0; i < 2; ++i) { const int row = (tid >> 3) + 64 * i, ch = tid & 7;
            f32x4 a, bq; pg8::unpack8(kk[q][i], a, bq); const float d = __builtin_amdgcn_exp2f(lg * (float)(127 - row));
            *(LAS u32x4*)(lds + OFF_KD + row * KD_STRIDE + ch * 16) = pg8::pack8(a * d, bq * d); }
#pragma unroll
        for (int i = 0; i < 4; ++i) { const int row = (tid >> 4) + 32 * i, ch = tid & 15; *(LAS u32x4*)(lds + OFF_VS + row * VS_STRIDE + ch * 16) = vv[q][i]; }
        if (c + 3 < 8) { const bf16* rb = rb0 + (size_t)(c + 3) * 128 * PP;
#pragma unroll
            for (int i = 0; i < 2; ++i) kk[q][i] = *(const u32x4*)(rb + koff0 + (size_t)(64 * i) * PP);
#pragma unroll
            for (int i = 0; i < 4; ++i) vv[q][i] = *(const u32x4*)(rb + voff0 + (size_t)(32 * i) * PP); }
        __syncthreads();
        state_update(st, (lptr)lds, dkb, dvb, gC, lane);
    }
    float* gp = GST + (size_t)ui * (HD * DV) + (size_t)(32 * dkb) * DV + 32 * dvb + (lane & 31);
#pragma unroll
    for (int r = 0; r < 16; ++r) gp[(size_t)((r & 3) + 8 * (r >> 2) + 4 * hi) * DV] = st[r];
    __syncthreads();
}

__device__ __forceinline__ void ret_outputs(LAS unsigned char* lds, const bf16* PROJ, const float* GST, bf16* RB, int ui, int tid) {
    const int lane = tid & 63, wave = __builtin_amdgcn_readfirstlane(tid >> 6), hi = lane >> 5, l31 = lane & 31;
    const int g = (lane >> 4) & 1, qq = (lane & 15) >> 2, pp = lane & 3;
    const int bh = ui >> 3, s = ui & 7, h = bh & 3, b = bh >> 2, dkb = wave & 1, dvb = wave >> 1;
    const int qblk = wave & 3, dvh = wave >> 2;
    const float lg = ret_lg2(h), gC = __builtin_amdgcn_exp2f(lg * 128.f);
    f32x16 st = {};
    for (int sp = 0; sp < s; ++sp) {
        const float w = __builtin_amdgcn_exp2f(lg * 1024.f * (float)(s - 1 - sp));
        const float* gp = GST + (size_t)(bh * 8 + sp) * (HD * DV) + (size_t)(32 * dkb) * DV + 32 * dvb + l31;
#pragma unroll
        for (int r = 0; r < 16; ++r) st[r] += w * gp[(size_t)((r & 3) + 8 * (r >> 2) + 4 * hi) * DV];
    }
    const float qdec = __builtin_amdgcn_exp2f(lg * (float)(32 * qblk + l31 + 1));
    const bf16* rb0 = PROJ + ((size_t)b * SEQ + (size_t)(8 * s) * 128) * PP;
    const size_t qoff0 = (size_t)(tid >> 3) * PP + h * HD + (tid & 7) * 8, voff0 = (size_t)(tid >> 4) * PP + C_VR + h * DV + (tid & 15) * 8;
    u32x4 kk[2], qv[2], vv[4];
#pragma unroll
    for (int i = 0; i < 2; ++i) { kk[i] = *(const u32x4*)(rb0 + qoff0 + C_KR + (size_t)(64 * i) * PP); qv[i] = *(const u32x4*)(rb0 + qoff0 + C_QR + (size_t)(64 * i) * PP); }
#pragma unroll
    for (int i = 0; i < 4; ++i) vv[i] = *(const u32x4*)(rb0 + voff0 + (size_t)(32 * i) * PP);
    for (int c = 0; c < 8; ++c) {
        const size_t row0 = (size_t)b * SEQ + (size_t)(8 * s + c) * 128;
        __syncthreads();
#pragma unroll
        for (int gq = 0; gq < 4; ++gq) { u32x2 w; w.x = pg8::cvt_pk_bf16(st[4 * gq], st[4 * gq + 1]); w.y = pg8::cvt_pk_bf16(st[4 * gq + 2], st[4 * gq + 3]);
            *(LAS u32x2*)(lds + OFF_ST + (32 * dvb + l31) * QS_STRIDE + (32 * dkb + 8 * gq + 4 * hi) * 2) = w; }
#pragma unroll
        for (int i = 0; i < 2; ++i) { const int row = (tid >> 3) + 64 * i, ch = tid & 7;
            f32x4 a, bq; pg8::unpack8(kk[i], a, bq); const float d = __builtin_amdgcn_exp2f(lg * (float)(127 - row));
            *(LAS u32x4*)(lds + OFF_KD + row * KD_STRIDE + ch * 16) = pg8::pack8(a * d, bq * d);
            *(LAS u32x4*)(lds + OFF_KS + row * QS_STRIDE + ch * 16) = kk[i]; *(LAS u32x4*)(lds + OFF_QS + row * QS_STRIDE + ch * 16) = qv[i]; }
#pragma unroll
        for (int i = 0; i < 4; ++i) { const int row = (tid >> 4) + 32 * i, ch = tid & 15; *(LAS u32x4*)(lds + OFF_VS + row * VS_STRIDE + ch * 16) = vv[i]; }
        if (c + 1 < 8) { const bf16* rb = rb0 + (size_t)(c + 1) * 128 * PP;
#pragma unroll
            for (int i = 0; i < 2; ++i) { kk[i] = *(const u32x4*)(rb + qoff0 + C_KR + (size_t)(64 * i) * PP); qv[i] = *(const u32x4*)(rb + qoff0 + C_QR + (size_t)(64 * i) * PP); }
#pragma unroll
            for (int i = 0; i < 4; ++i) vv[i] = *(const u32x4*)(rb + voff0 + (size_t)(32 * i) * PP); }
        __syncthreads();
        bf16x8 qf[4];
#pragma unroll
        for (int d0 = 0; d0 < 4; ++d0) qf[d0] = *(const LAS bf16x8*)(lds + OFF_QS + (32 * qblk + l31) * QS_STRIDE + (16 * d0 + 8 * hi) * 2);
        f32x16 o[2];
#pragma unroll
        for (int d = 0; d < 2; ++d) { o[d] = f32x16{};
#pragma unroll
            for (int d0 = 0; d0 < 4; ++d0) { const bf16x8 a = *(const LAS bf16x8*)(lds + OFF_ST + (32 * (2 * dvh + d) + l31) * QS_STRIDE + (16 * d0 + 8 * hi) * 2);
                o[d] = __builtin_amdgcn_mfma_f32_32x32x16_bf16(a, qf[d0], o[d], 0, 0, 0); }
#pragma unroll
            for (int r = 0; r < 16; ++r) o[d][r] *= qdec; }
        for (int kb = 0; kb <= qblk; ++kb) {
            f32x16 sT = {};
#pragma unroll
            for (int d0 = 0; d0 < 4; ++d0) { const bf16x8 a = *(const LAS bf16x8*)(lds + OFF_KS + (32 * kb + l31) * QS_STRIDE + (16 * d0 + 8 * hi) * 2);
                sT = __builtin_amdgcn_mfma_f32_32x32x16_bf16(a, qf[d0], sT, 0, 0, 0); }
            const int dq = 32 * (qblk - kb) + l31;
#pragma unroll
            for (int r = 0; r < 16; ++r) { const int dist = dq - ((r & 3) + 8 * (r >> 2) + 4 * hi); sT[r] = (dist >= 0) ? sT[r] * __builtin_amdgcn_exp2f(lg * (float)dist) : 0.f; }
            u32x4 pw[2];
#pragma unroll
            for (int sx = 0; sx < 2; ++sx) { pw[sx].x = pg8::cvt_pk_bf16(sT[8 * sx], sT[8 * sx + 1]); pw[sx].y = pg8::cvt_pk_bf16(sT[8 * sx + 2], sT[8 * sx + 3]);
                pw[sx].z = pg8::cvt_pk_bf16(sT[8 * sx + 4], sT[8 * sx + 5]); pw[sx].w = pg8::cvt_pk_bf16(sT[8 * sx + 6], sT[8 * sx + 7]); }
#pragma unroll
            for (int d = 0; d < 2; ++d)
#pragma unroll
                for (int sx = 0; sx < 2; ++sx) { lptr vp = (lptr)lds + OFF_VS + (32 * kb + 16 * sx + 4 * hi + qq) * VS_STRIDE + (32 * (2 * dvh + d) + 16 * g + 4 * pp) * 2;
                    const bf16x8 a = cat8(vtr(vp), vtr(vp + 8 * VS_STRIDE));
                    o[d] = __builtin_amdgcn_mfma_f32_32x32x16_bf16(a, __builtin_bit_cast(bf16x8, pw[sx]), o[d], 0, 0, 0); }
        }
        state_update(st, (lptr)lds, dkb, dvb, gC, lane);
        float ss = 0.f;
#pragma unroll
        for (int d = 0; d < 2; ++d)
#pragma unroll
            for (int r = 0; r < 16; ++r) ss += o[d][r] * o[d][r];
        ss += __shfl_xor(ss, 32);
        __syncthreads();
#pragma unroll
        for (int d = 0; d < 2; ++d)
#pragma unroll
            for (int gq = 0; gq < 4; ++gq) *(LAS f32x4*)(lds + OFF_OUT + (32 * qblk + l31) * OUT_STRIDE + (32 * (2 * dvh + d) + 8 * gq + 4 * hi) * 4) = (f32x4){o[d][4 * gq], o[d][4 * gq + 1], o[d][4 * gq + 2], o[d][4 * gq + 3]};
        if (hi == 0) *(LAS float*)(lds + OFF_SSQ + (dvh * 128 + 32 * qblk + l31) * 4) = ss;
        __syncthreads();
        { const int row = tid >> 2, seg = tid & 3;
          const float rstd = rsqrtf((*(const LAS float*)(lds + OFF_SSQ + row * 4) + *(const LAS float*)(lds + OFF_SSQ + (128 + row) * 4)) * (1.f / DV) + SUBLN_EPS);
          const bf16* gsrc = PROJ + (row0 + row) * PP + C_GR + h * DV + seg * 32; bf16* dst = RB + (row0 + row) * 512 + h * DV + seg * 32;
#pragma unroll
          for (int cc = 0; cc < 4; ++cc) { const f32x4 v0 = *(const LAS f32x4*)(lds + OFF_OUT + row * OUT_STRIDE + (seg * 32 + cc * 8) * 4), v1 = *(const LAS f32x4*)(lds + OFF_OUT + row * OUT_STRIDE + (seg * 32 + cc * 8 + 4) * 4);
              f32x4 g0, g1; pg8::unpack8(*(const u32x4*)(gsrc + cc * 8), g0, g1); f32x4 r0, r1;
#pragma unroll
              for (int i = 0; i < 4; ++i) { r0[i] = v0[i] * rstd * g0[i]; r1[i] = v1[i] * rstd * g1[i]; }
              *(u32x4*)(dst + cc * 8) = pg8::pack8(r0, r1); } }
    }
    __syncthreads();
}
}

namespace attn {
typedef short s16x4 __attribute__((ext_vector_type(4)));
typedef short v4i16_t __attribute__((ext_vector_type(4)));
typedef LAS const unsigned char* lptr;
constexpr int KSLOT = 16384, L_K2 = 8192, L_V = 65536, VSLOT = 16384;
#ifndef ATT_SKIP
#define ATT_SKIP 1
#endif
#ifndef ATT_THR
#define ATT_THR 60.0f
#endif
__device__ __forceinline__ void glds16s(const void* sbase, unsigned voff, unsigned lds_dst) { unsigned keep;
    asm volatile("s_mov_b32 %0, m0\n\ts_mov_b32 m0, %3\n\ts_nop 0\n\tglobal_load_lds_dwordx4 %1, %2\n\ts_mov_b32 m0, %0" : "=&s"(keep) : "v"(voff), "s"(sbase), "s"(lds_dst) : "memory"); }
__device__ __forceinline__ void glds16(const void* gsrc, unsigned lds_dst) { unsigned keep;
    asm volatile("s_mov_b32 %0, m0\n\ts_mov_b32 m0, %2\n\ts_nop 0\n\tglobal_load_lds_dwordx4 %1, off\n\ts_mov_b32 m0, %0" : "=&s"(keep) : "v"(gsrc), "s"(lds_dst) : "memory"); }
__device__ __forceinline__ s16x4 vtr(lptr p) { return __builtin_bit_cast(s16x4, __builtin_amdgcn_ds_read_tr16_b64_v4i16((LAS v4i16_t*)p)); }
__device__ __forceinline__ bf16x8 cat8(const s16x4 lo, const s16x4 hi) { return (bf16x8){lo[0], lo[1], lo[2], lo[3], hi[0], hi[1], hi[2], hi[3]}; }
#define ATT_WAIT_BAR() asm volatile("s_waitcnt vmcnt(0) lgkmcnt(0)\n\ts_barrier" ::: "memory")
#define ATT_WAIT_BAR4() asm volatile("s_waitcnt vmcnt(4) lgkmcnt(0)\n\ts_barrier" ::: "memory")

#define ATT_SB() __builtin_amdgcn_sched_barrier(0)
__device__ __forceinline__ float max3f(float a, float b, float c) { float r; asm("v_max3_f32 %0, %1, %2, %3" : "=v"(r) : "v"(a), "v"(b), "v"(c)); return r; }
__device__ __forceinline__ bf16x8 vfrag(lptr vp, int ks, int d) { const lptr va = vp + d * 4096 + (32 * (ks >> 1) + 16 * (ks & 1)) * 64; return cat8(vtr(va), vtr(va + 8 * 64)); }
__device__ __forceinline__ void vload4(bf16x8 (&buf)[8], int half, lptr vp, int ks) {
#pragma unroll
    for (int d = 0; d < 4; ++d) buf[4 * half + d] = vfrag(vp, ks, d);
}
__device__ __forceinline__ void pv_step(f32x16 (&o)[4], const u32x4& pwk, const bf16x8 (&buf)[8], int half) {
    const bf16x8 pb = __builtin_bit_cast(bf16x8, pwk);
#pragma unroll
    for (int d = 0; d < 4; ++d) o[d] = __builtin_amdgcn_mfma_f32_32x32x16_bf16(buf[4 * half + d], pb, o[d], 0, 0, 0);
}
__device__ __forceinline__ void kload8(bf16x8 (&kf)[8], lptr kp) {
#pragma unroll
    for (int d0 = 0; d0 < 4; ++d0) { kf[2 * d0] = *(const LAS bf16x8*)(kp + d0 * 2048); kf[2 * d0 + 1] = *(const LAS bf16x8*)(kp + d0 * 2048 + 512); }
}
__device__ __forceinline__ void kload4(bf16x8 (&kf)[8], lptr kp, int half) {
#pragma unroll
    for (int d0 = 2 * half; d0 < 2 * half + 2; ++d0) { kf[2 * d0] = *(const LAS bf16x8*)(kp + d0 * 2048); kf[2 * d0 + 1] = *(const LAS bf16x8*)(kp + d0 * 2048 + 512); }
}
template <int MODE> __device__ __forceinline__ void qk_scores(const bf16x8 (&kf)[8], const bf16x8 (&qr)[4], f32x16 (&o)[4], f32x16& p0, f32x16& p1, float& cinit, float shift, bool band, int kb, int qrel, lptr vp, bf16x8 (&tmp)[8]) {
#pragma unroll
    for (int r = 0; r < 16; ++r) { p0[r] = cinit; p1[r] = cinit; }
#pragma unroll
    for (int d0 = 0; d0 < 4; ++d0) {
        p0 = __builtin_amdgcn_mfma_f32_32x32x16_bf16(kf[2 * d0], qr[d0], p0, 0, 0, 0);
        p1 = __builtin_amdgcn_mfma_f32_32x32x16_bf16(kf[2 * d0 + 1], qr[d0], p1, 0, 0, 0);
    }
    ATT_SB();
    vload4(tmp, 0, vp, 0); vload4(tmp, 1, vp, 1);
    ATT_SB();
}
template <int MODE> __device__ __forceinline__ void softmax_head(f32x16 (&o)[4], float& lsum, f32x16& p0, f32x16& p1, float& cinit, float shift, bool band, int kb, int qrel) {
    if (!(MODE & 2)) {
    if (band) {
#pragma unroll
        for (int r = 0; r < 16; ++r) { const int kv = kb + (r & 3) + 8 * (r >> 2); if (kv > qrel) p0[r] = -INFINITY; if (kv + 32 > qrel) p1[r] = -INFINITY; }
    }
    ATT_SB(); asm volatile("s_nop 7\n\ts_nop 7"); ATT_SB();
    float rm = max3f(p0[0], p0[1], p1[0]), rb = max3f(p0[2], p0[3], p1[1]);
    rm = max3f(rm, p1[2], p1[3]);
#pragma unroll
    for (int r = 4; r < 16; r += 4) { rm = max3f(rm, p0[r], p0[r + 1]); rb = max3f(rb, p0[r + 2], p0[r + 3]); rm = max3f(rm, p1[r], p1[r + 1]); rb = max3f(rb, p1[r + 2], p1[r + 3]); }
    rm = max3f(rm, rb, rb);
    { auto rr = __builtin_amdgcn_permlane32_swap(__float_as_uint(rm), __float_as_uint(rm), false, false); rm = fmaxf(__uint_as_float(rr[0]), __uint_as_float(rr[1])); }
    if (__any(rm > ATT_THR)) {
        const float dl = fmaxf(rm, 0.f), f = __builtin_amdgcn_exp2f(-dl);
        cinit -= dl;
#pragma unroll
        for (int r = 0; r < 16; ++r) { p0[r] -= dl; p1[r] -= dl; }
        lsum *= f;
#pragma unroll
        for (int d = 0; d < 4; ++d)
#pragma unroll
            for (int r = 0; r < 16; ++r) o[d][r] *= f;
    }
    }
    cinit += shift;
}
struct AW { float b1, b2, b3, a8, c1, c2, c3; };
template <int MODE> __device__ __forceinline__ u32x4 exp_pack(const f32x16& p, int s, float& lsum, float cks, const AW& aw) {
    float e[8];
#pragma unroll
    for (int j = 0; j < 8; ++j) e[j] = (MODE & 2) ? p[8 * s + j] : __builtin_amdgcn_exp2f(p[8 * s + j]);
    const float g0 = __builtin_fmaf(aw.b3, e[3], __builtin_fmaf(aw.b2, e[2], __builtin_fmaf(aw.b1, e[1], e[0])));
    const float g1 = __builtin_fmaf(aw.b3, e[7], __builtin_fmaf(aw.b2, e[6], __builtin_fmaf(aw.b1, e[5], e[4])));
    lsum = __builtin_fmaf(cks, __builtin_fmaf(aw.a8, g1, g0), lsum);
    u32x4 w; w.x = pg8::cvt_pk_bf16(e[0], e[1]); w.y = pg8::cvt_pk_bf16(e[2], e[3]); w.z = pg8::cvt_pk_bf16(e[4], e[5]); w.w = pg8::cvt_pk_bf16(e[6], e[7]);
    return w;
}
__device__ __forceinline__ void qk_half(const bf16x8 (&kf)[8], const bf16x8 (&qr)[4], f32x16& p0, f32x16& p1, int half) {
    if (half == 0) {
        p0 = __builtin_amdgcn_mfma_f32_32x32x16_bf16(kf[0], qr[0], f32x16{}, 0, 0, 0); p1 = __builtin_amdgcn_mfma_f32_32x32x16_bf16(kf[1], qr[0], f32x16{}, 0, 0, 0);
        p0 = __builtin_amdgcn_mfma_f32_32x32x16_bf16(kf[2], qr[1], p0, 0, 0, 0); p1 = __builtin_amdgcn_mfma_f32_32x32x16_bf16(kf[3], qr[1], p1, 0, 0, 0);
    } else {
        p0 = __builtin_amdgcn_mfma_f32_32x32x16_bf16(kf[4], qr[2], p0, 0, 0, 0); p1 = __builtin_amdgcn_mfma_f32_32x32x16_bf16(kf[5], qr[2], p1, 0, 0, 0);
        p0 = __builtin_amdgcn_mfma_f32_32x32x16_bf16(kf[6], qr[3], p0, 0, 0, 0); p1 = __builtin_amdgcn_mfma_f32_32x32x16_bf16(kf[7], qr[3], p1, 0, 0, 0);
    }
}
__device__ __forceinline__ void softmax_head2(f32x16 (&o)[4], float& lsum, f32x16& p0, f32x16& p1, float& c, bool band, int kb, int qrel) {
    if (band) {
#pragma unroll
        for (int r = 0; r < 16; ++r) { const int kv = kb + (r & 3) + 8 * (r >> 2); if (kv > qrel) p0[r] = -INFINITY; if (kv + 32 > qrel) p1[r] = -INFINITY; }
    }
    ATT_SB();
    float rm = max3f(p0[0], p0[1], p1[0]), rb = max3f(p0[2], p0[3], p1[1]);
    rm = max3f(rm, p1[2], p1[3]);
#pragma unroll
    for (int r = 4; r < 16; r += 4) { rm = max3f(rm, p0[r], p0[r + 1]); rb = max3f(rb, p0[r + 2], p0[r + 3]); rm = max3f(rm, p1[r], p1[r + 1]); rb = max3f(rb, p1[r + 2], p1[r + 3]); }
    rm = max3f(rm, rb, rb) + c;
    { auto rr = __builtin_amdgcn_permlane32_swap(__float_as_uint(rm), __float_as_uint(rm), false, false); rm = fmaxf(__uint_as_float(rr[0]), __uint_as_float(rr[1])); }
    if (__any(rm > ATT_THR)) {
        const float dl = fmaxf(rm, 0.f), f = __builtin_amdgcn_exp2f(-dl);
        c -= dl; lsum *= f;
#pragma unroll
        for (int d = 0; d < 4; ++d)
#pragma unroll
            for (int r = 0; r < 16; ++r) o[d][r] *= f;
    }
}
__device__ __forceinline__ u32x4 exp_pack2(const f32x16& p, int s, float c, float& lsum, float cks, const AW& aw) {
    float e[8];
#pragma unroll
    for (int j = 0; j < 8; ++j) e[j] = __builtin_amdgcn_exp2f(p[8 * s + j] + c);
    const float g0 = __builtin_fmaf(aw.b3, e[3], __builtin_fmaf(aw.b2, e[2], __builtin_fmaf(aw.b1, e[1], e[0])));
    const float g1 = __builtin_fmaf(aw.b3, e[7], __builtin_fmaf(aw.b2, e[6], __builtin_fmaf(aw.b1, e[5], e[4])));
    lsum = __builtin_fmaf(cks, __builtin_fmaf(aw.a8, g1, g0), lsum);
    u32x4 w; w.x = pg8::cvt_pk_bf16(e[0], e[1]); w.y = pg8::cvt_pk_bf16(e[2], e[3]); w.z = pg8::cvt_pk_bf16(e[4], e[5]); w.w = pg8::cvt_pk_bf16(e[6], e[7]);
    return w;
}
struct ESl { float g0, g1; };
__device__ __forceinline__ void exp_slice(ESl& x, u32x4& w, const f32x16& p, int s, int d, float c, const AW& aw) {
    const float a = __builtin_amdgcn_exp2f(p[8 * s + 2 * d] + c), b = __builtin_amdgcn_exp2f(p[8 * s + 2 * d + 1] + c);
    const unsigned pk = pg8::cvt_pk_bf16(a, b);
    if (d == 0) { w.x = pk; x.g0 = __builtin_fmaf(aw.b1, b, a); } else if (d == 1) { w.y = pk; x.g0 = __builtin_fmaf(aw.b3, b, __builtin_fmaf(aw.b2, a, x.g0)); }
    else if (d == 2) { w.z = pk; x.g1 = __builtin_fmaf(aw.b1, b, a); } else { w.w = pk; x.g1 = __builtin_fmaf(aw.b3, b, __builtin_fmaf(aw.b2, a, x.g1)); }
}
#define ATT_PIN1(v) asm volatile("" : "+v"(v))
__device__ __forceinline__ void pv_exp_step(f32x16 (&o)[4], const u32x4& pwk, bf16x8 (&buf)[8], int half, lptr vp, int vks, u32x4& wn, const f32x16& pnx, int s, float c, float& lsum, float cks, const AW& aw) {
    const bf16x8 pb = __builtin_bit_cast(bf16x8, pwk); ESl x;
#pragma unroll
    for (int d = 0; d < 4; ++d) {
        o[d] = __builtin_amdgcn_mfma_f32_32x32x16_bf16(buf[4 * half + d], pb, o[d], 0, 0, 0);
        exp_slice(x, wn, pnx, s, d, c, aw);
        if (vks >= 0) buf[4 * half + d] = vfrag(vp, vks, d);
        if (d == 3) lsum = __builtin_fmaf(cks, __builtin_fmaf(aw.a8, x.g1, x.g0), lsum);
        if (d == 0) ATT_PIN1(wn.x); else if (d == 1) ATT_PIN1(wn.y); else if (d == 2) ATT_PIN1(wn.z); else { ATT_PIN1(wn.w); ATT_PIN1(lsum); }
        ATT_SB();
    }
}
__device__ __forceinline__ void qk_exp_half(const bf16x8 (&kf)[8], const bf16x8 (&qr)[4], f32x16& p0, f32x16& p1, bool nxt, u32x4& wn, const f32x16& pcur, float c, float& lsum, const AW& aw) {
    ESl x;
#pragma unroll
    for (int d = 0; d < 4; ++d) {
        if (nxt) { if (d == 0) p0 = __builtin_amdgcn_mfma_f32_32x32x16_bf16(kf[4], qr[2], p0, 0, 0, 0); else if (d == 1) p1 = __builtin_amdgcn_mfma_f32_32x32x16_bf16(kf[5], qr[2], p1, 0, 0, 0);
                   else if (d == 2) p0 = __builtin_amdgcn_mfma_f32_32x32x16_bf16(kf[6], qr[3], p0, 0, 0, 0); else p1 = __builtin_amdgcn_mfma_f32_32x32x16_bf16(kf[7], qr[3], p1, 0, 0, 0); }
        exp_slice(x, wn, pcur, 0, d, c, aw);
        if (d == 3) lsum = __builtin_fmaf(1.f, __builtin_fmaf(aw.a8, x.g1, x.g0), lsum);
        if (d == 0) ATT_PIN1(wn.x); else if (d == 1) ATT_PIN1(wn.y); else if (d == 2) ATT_PIN1(wn.z); else { ATT_PIN1(wn.w); ATT_PIN1(lsum); }
        ATT_SB();
    }
}
template <int MODE> __device__ __forceinline__ void attn_unit(LAS unsigned char* lds, const bf16* PROJ, const bf16* KVP, bf16* AB, const float* gsub, float lam, int bh, int qb, float dq2, int tid) {
    const int lane = tid & 63, r32 = lane & 31, hi = lane >> 5, g = (lane >> 4) & 1, qq = (lane & 15) >> 2, pp = lane & 3;
    const int wid = __builtin_amdgcn_readfirstlane(tid >> 6), map = wid >> 2, qblk = wid & 3;
    const int b = bh >> 2, h = bh & 3, q0 = qb * 128;
    const size_t rowbase = (size_t)b * SEQ;
    const float sl2 = alibi_sl2(h);
    const unsigned lds0 = (unsigned)(uintptr_t)lds;
    const char* kvw = (const char*)(KVP + (size_t)bh * 128 * 16384) + wid * 1024;
    const unsigned lane16 = (unsigned)lane * 16u;
#define ATT_DMA_K(t, kslot) do { const char* _g = kvw + (size_t)(t) * 32768; const unsigned _k = lds0 + (kslot) * KSLOT + wid * 1024; \
        glds16s(_g, lane16, (unsigned)__builtin_amdgcn_readfirstlane(_k)); glds16s(_g + 8192, lane16, (unsigned)__builtin_amdgcn_readfirstlane(_k + L_K2)); } while (0)
#define ATT_DMA_V(t, vslot) do { const char* _g = kvw + (size_t)(t) * 32768 + 16384; const unsigned _v = lds0 + L_V + (vslot) * VSLOT + wid * 1024; \
        glds16s(_g, lane16, (unsigned)__builtin_amdgcn_readfirstlane(_v)); glds16s(_g + 8192, lane16, (unsigned)__builtin_amdgcn_readfirstlane(_v + 8192)); } while (0)
    const int NT = 2 * (qb + 1);
    int t0 = 0;
#if ATT_SKIP
    { const float dneed = (152.f + dq2) / sl2;
      const int tq = (int)__builtin_floorf(((float)q0 - dneed - 63.f) * (1.f / 64.f)) + 1;
      t0 = __builtin_amdgcn_readfirstlane(tq > 0 ? tq : 0); }
#endif
    ATT_DMA_K(t0, 0); ATT_DMA_V(t0, 0); ATT_DMA_K(t0 + 1, 1); ATT_DMA_V(t0 + 1, 1);
    if (t0 + 2 < NT) { ATT_DMA_K(t0 + 2, 2); ATT_DMA_V(t0 + 2, 2); }
    const bf16* Qw = PROJ + (rowbase + q0 + 32 * qblk + r32) * PP + (map ? C_Q2 : C_Q1) + h * HD;
    bf16x8 qr[4];
#pragma unroll
    for (int d0 = 0; d0 < 4; ++d0) qr[d0] = *(const bf16x8*)(Qw + d0 * 16 + hi * 8);
    auto uni = [](float x) { return __builtin_bit_cast(float, __builtin_amdgcn_readfirstlane(__builtin_bit_cast(int, x))); };
    const AW aw = {uni(__builtin_amdgcn_exp2f(sl2)), uni(__builtin_amdgcn_exp2f(2.f * sl2)), uni(__builtin_amdgcn_exp2f(3.f * sl2)), uni(__builtin_amdgcn_exp2f(8.f * sl2)),
                   uni(__builtin_amdgcn_exp2f(16.f * sl2)), uni(__builtin_amdgcn_exp2f(32.f * sl2)), uni(__builtin_amdgcn_exp2f(48.f * sl2))};
    const float whi = __builtin_amdgcn_exp2f(sl2 * (float)(4 * hi - 63));
    float lsum = 0.f;
    f32x16 o[4];
#pragma unroll
    for (int d = 0; d < 4; ++d) o[d] = f32x16{};
    float cinit = sl2 * 63.f;
    const float shift = 64.f * sl2;
    const int qrel = 32 * qblk + r32;
    const lptr ldsc = (lptr)lds;
    const lptr vp0 = ldsc + L_V + (4 * hi + qq) * 64 + (16 * g + 4 * pp) * 2;
    const lptr kp0 = ldsc + (map ? L_K2 : 0) + hi * 1024 + r32 * 16;
    u32x4 pw[4];
#pragma unroll
    for (int i = 0; i < 4; ++i) pw[i] = (u32x4){0u, 0u, 0u, 0u};
    bf16x8 hold[8], tmp[8];
    int sl_cur = 0;
    asm volatile("" : "+v"(qr[0]), "+v"(qr[1]), "+v"(qr[2]), "+v"(qr[3]));
    ATT_WAIT_BAR();
    f32x16 pA0, pA1, pB0, pB1;
    kload8(hold, kp0);
    qk_half(hold, qr, pA0, pA1, 0); qk_half(hold, qr, pA0, pA1, 1);
    auto step = [&](int t, f32x16& pc0, f32x16& pc1, f32x16& pn0, f32x16& pn1) __attribute__((always_inline)) {
        if (t > t0) { if (t + 2 < NT) ATT_WAIT_BAR4(); else ATT_WAIT_BAR(); }
        const bool nxt = (t + 1 < NT), band = (t >= NT - 2); const int kb = 64 * (t - (NT - 2)) + 4 * hi;
        const lptr vp = vp0 + sl_cur * VSLOT;
        if (nxt) kload4(hold, kp0 + ((sl_cur + 1) & 3) * KSLOT, 0);
        vload4(tmp, 0, vp, 0); vload4(tmp, 1, vp, 1);
        ATT_SB();
        if (nxt) qk_half(hold, qr, pn0, pn1, 0);
        if (nxt) kload4(hold, kp0 + ((sl_cur + 1) & 3) * KSLOT, 1);
        ATT_SB();
        softmax_head2(o, lsum, pc0, pc1, cinit, band, kb, qrel);
        ATT_SB();
        if (t + 3 < NT) { ATT_DMA_K(t + 3, (sl_cur + 3) & 3); ATT_DMA_V(t + 3, (sl_cur + 3) & 3); }
        ATT_SB();
        { u32x4 wa, wb;
        qk_exp_half(hold, qr, pn0, pn1, nxt, wa, pc0, cinit, lsum, aw);
        pv_exp_step(o, wa, tmp, 0, vp, 2, wb, pc0, 1, cinit, lsum, aw.c1, aw);
        pv_exp_step(o, wb, tmp, 1, vp, 3, wa, pc1, 0, cinit, lsum, aw.c2, aw);
        pv_exp_step(o, wa, tmp, 0, vp, -1, wb, pc1, 1, cinit, lsum, aw.c3, aw);
        pv_step(o, wb, tmp, 1); ATT_SB(); }
        cinit += shift;
        sl_cur = (sl_cur + 1) & 3;
    };
    for (int t = t0; t < NT; t += 2) { step(t, pA0, pA1, pB0, pB1); if (t + 1 < NT) step(t + 1, pB0, pB1, pA0, pA1); }
    float rl;
    { const float lw = lsum * whi; auto rr = __builtin_amdgcn_permlane32_swap(__float_as_uint(lw), __float_as_uint(lw), false, false); rl = __builtin_amdgcn_rcpf(__uint_as_float(rr[0]) + __uint_as_float(rr[1])); }
    ATT_WAIT_BAR();
    LAS float* xch = (LAS float*)(lds + qblk * 16384) + lane;
    if (map == 1) {
#pragma unroll
        for (int d = 0; d < 4; ++d)
#pragma unroll
            for (int r = 0; r < 16; ++r) xch[(d * 16 + r) * 64] = o[d][r] * rl;
    }
    ATT_WAIT_BAR();
    if (map == 0) {
        float ss = 0.f;
#pragma unroll
        for (int d = 0; d < 4; ++d)
#pragma unroll
            for (int r = 0; r < 16; ++r) { const float a = o[d][r] * rl - lam * xch[(d * 16 + r) * 64]; o[d][r] = a; ss += a * a; }
        ss += __shfl_xor(ss, 32);
        const float rstd = rsqrtf(ss * (1.f / DV) + SUBLN_EPS) * (1.f - LAM_INIT);
        bf16* dst = AB + (rowbase + q0 + 32 * qblk + r32) * 512 + h * DV + 8 * hi;
#pragma unroll
        for (int d = 0; d < 4; ++d)
#pragma unroll
            for (int pq = 0; pq < 2; ++pq) { u32x2 w[2];
#pragma unroll
                for (int e = 0; e < 2; ++e) { const int gq = 2 * pq + e; const f32x4 gg = *(const f32x4*)(gsub + 32 * d + 8 * gq + 4 * hi);
                    w[e].x = pg8::cvt_pk_bf16(o[d][4 * gq] * rstd * gg[0], o[d][4 * gq + 1] * rstd * gg[1]); w[e].y = pg8::cvt_pk_bf16(o[d][4 * gq + 2] * rstd * gg[2], o[d][4 * gq + 3] * rstd * gg[3]); }
                auto rx = __builtin_amdgcn_permlane32_swap(w[0].x, w[1].x, false, false); auto ry = __builtin_amdgcn_permlane32_swap(w[0].y, w[1].y, false, false);
                *(u32x4*)(dst + 32 * d + 16 * pq) = (u32x4){rx[0], ry[0], rx[1], ry[1]}; }
    }
    ATT_WAIT_BAR();
#undef ATT_DMA_K
#undef ATT_DMA_V
}
template <int MODE> __device__ __forceinline__ void attn_phase(LAS unsigned char* lds, const bf16* PROJ, const bf16* KVP, const unsigned* KN, bf16* AB, const float* gsub, const float* lq1, const float* lk1, const float* lq2, const float* lk2, int vcu, int G, int tid, unsigned* aq = nullptr) {
    const int lane = tid & 63;
    const float lam = __expf(wave_sum(lq1[lane] * lk1[lane])) - __expf(wave_sum(lq2[lane] * lk2[lane])) + LAM_INIT;
    auto bound = [&](int bh) { float dq2 = 0.f;
#pragma unroll
        for (int mp = 0; mp < 2; ++mp) { const float kn = __uint_as_float(__hip_atomic_load(KN + bh * 2 + mp, __ATOMIC_RELAXED, __HIP_MEMORY_SCOPE_AGENT)), qn = __uint_as_float(__hip_atomic_load(KN + 64 + bh * 2 + mp, __ATOMIC_RELAXED, __HIP_MEMORY_SCOPE_AGENT));
            dq2 = fmaxf(dq2, 2.f * __builtin_sqrtf(2.f * qn) * __builtin_sqrtf(2.f * kn) * 1.0001f); }
        return dq2; };
    LAS int* slot = (LAS int*)(lds + 131072 + 768);
    for (int v = vcu; v < 256; v += G) {
        const int b = v >> 5, w = v & 31;
        for (int it = 0;; ++it) {
            int h, qb;
            if (aq) {
                if (tid == 0) *slot = (int)__hip_atomic_fetch_add(aq, 1u, __ATOMIC_RELAXED, __HIP_MEMORY_SCOPE_AGENT);
                __syncthreads();
                const int u = __builtin_amdgcn_readfirstlane(*slot);
                if (u >= 256) break;
                h = 3 - (u >> 6); qb = 63 - (u & 63);
            } else { if (it >= 8) break; h = (it & 1) ? 3 - (it >> 1) : (it >> 1); qb = (it & 4) ? 63 - w : w; }
            const int bh = b * 4 + h;
            attn_unit<MODE>(lds, PROJ, KVP, AB, gsub, lam, bh, qb, bound(bh), tid);
        }
    }
}
}

constexpr int NWAVES = 8;
constexpr int RING_OFF = 0, RING_BYTES = 131072;
constexpr int LDSCTL_OFF = RING_BYTES, MISC_OFF = LDSCTL_OFF + 320;
constexpr int LDS_BYTES = 159744;
constexpr size_t CTL_ZERO_BYTES = 1 * MiB;
constexpr int CW_BAR = 4096;
constexpr int CW_AQ = 2048;
constexpr int CW_MIS = 1024;
constexpr int CW_KN = 32768;
constexpr int N_PHASES = 10;
constexpr int HALO_OFF = RING_BYTES + 1024;
constexpr int MAX_LAUNCH = 4;
static_assert((CW_BAR + MAX_LAUNCH * XCD_BAR_WORDS) * 4 <= (int)CTL_ZERO_BYTES, "barrier words inside the memset region");
static_assert(HALO_OFF + 2048 + 2 * 4096 + 16384 <= LDS_BYTES, "halo + conv weight tables + rstd partials inside the LDS allocation");

struct Frame {
    LAS unsigned char* lds; volatile LAS unsigned* MISC; gu32* ctl;
    int tid, lane, wave, vcu, G;
};

__device__ __forceinline__ void p0_transpose_item(const float* W, int K, int N, bf16* WT, const float* rs, int mode, LAS float* scr, int item, int lane) {
    const int nblk = N / 32, kb = item / nblk, nb = item % nblk, k0 = 64 * kb, n0 = 32 * nb, s0 = wt_src_col(n0, mode);
#pragma unroll
    for (int i = 0; i < 8; ++i) { const int kk = 8 * i + (lane >> 3), c4 = (lane & 7) * 4; const float s = rs ? rs[k0 + kk] : 1.f;
        const f32x4 v = *(const f32x4*)(W + (size_t)(k0 + kk) * N + s0 + c4) * s; LAS float* d = scr + kk * 33 + c4; d[0] = v.x; d[1] = v.y; d[2] = v.z; d[3] = v.w; }
    LDS_WAIT(); asm volatile("" ::: "memory");
    const int c = lane & 7;
#pragma unroll
    for (int j = 0; j < 4; ++j) { const int n = (lane >> 3) + 8 * j; const LAS float* s = scr + (8 * c) * 33 + n;
        u32x4 o; o.x = pk2(s[0 * 33], s[1 * 33]); o.y = pk2(s[2 * 33], s[3 * 33]); o.z = pk2(s[4 * 33], s[5 * 33]); o.w = pk2(s[6 * 33], s[7 * 33]);
        *(u32x4*)(WT + (size_t)(n0 + n) * K + k0 + 8 * c) = o; }
    LDS_WAIT(); asm volatile("" ::: "memory");
}
__device__ __forceinline__ void rms_row_to_bf16(const float* xrow, const float* g, bf16* orow, int lane) {
    const f32x4* xr = (const f32x4*)xrow + lane; f32x4 v[4]; float s = 0.f;
#pragma unroll
    for (int j = 0; j < 4; ++j) { v[j] = xr[64 * j]; s += (v[j].x * v[j].x + v[j].y * v[j].y) + (v[j].z * v[j].z + v[j].w * v[j].w); }
    const float rstd = rsqrtf(wave_sum(s) * (1.f / DM) + NORM_EPS);
    u32x2* o = (u32x2*)orow + lane;
#pragma unroll
    for (int j = 0; j < 4; ++j) { const f32x4 gg = ((const f32x4*)g)[lane + 64 * j];
        u32x2 w; w.x = pk2(v[j].x * rstd * gg.x, v[j].y * rstd * gg.y); w.y = pk2(v[j].z * rstd * gg.z, v[j].w * rstd * gg.w); o[64 * j] = w; }
}

struct Args { const float* in[17]; float* out; unsigned char* ws; int ph_lo, ph_hi, li, opt; };

__global__ void __launch_bounds__(NWAVES * 64, 2) mk_fwd(Args args) {
    extern __shared__ __attribute__((aligned(16))) unsigned char lds[];
    Frame F;
    F.lds = (LAS unsigned char*)lds; F.MISC = (volatile LAS unsigned*)(F.lds + MISC_OFF);
    F.tid = threadIdx.x; F.lane = F.tid & 63; F.wave = __builtin_amdgcn_readfirstlane(F.tid >> 6);
    F.G = gridDim.x; { const int bx = blockIdx.x; F.vcu = (F.G % 8 == 0) ? (bx % 8) * (F.G / 8) + bx / 8 : bx; }
    unsigned char* ws = args.ws;
    F.ctl = (gu32*)(ws + WS_CTL);
    const float* x = args.in[0]; const float* g_mix = args.in[1]; const float* w_in = args.in[2];
    const float* w_dp = args.in[8]; const float* w_rp = args.in[9]; const float* w_out = args.in[10];
    const float* g_ffn = args.in[11]; const float* w_up = args.in[12]; const float* conv_w = args.in[13]; const float* conv_b = args.in[14];
    const float* w_down = args.in[15]; const float* g_final = args.in[16];
    float* out = args.out;
    bf16* WIN = (bf16*)(ws + WS_WIN); bf16* WD = (bf16*)(ws + WS_WD); bf16* WR = (bf16*)(ws + WS_WR); bf16* WO = (bf16*)(ws + WS_WO); bf16* WUP = (bf16*)(ws + WS_WUP); bf16* WDN = (bf16*)(ws + WS_WDN);
    bf16* XN = (bf16*)(ws + WS_XN); bf16* PROJ = (bf16*)(ws + WS_PROJ); bf16* AB = (bf16*)(ws + WS_A); bf16* RB = (bf16*)(ws + WS_R);
    bf16* X1B = (bf16*)(ws + WS_X1B); bf16* GB = (bf16*)(ws + WS_G); bf16* UB = (bf16*)(ws + WS_U); float* SSQ1 = (float*)(ws + WS_SSQ1);
    bf16* KVP = (bf16*)(ws + WS_KVP); bf16* MG = XN; bf16* X2B = XN; float* SSQ2 = (float*)(ws + WS_SSQ2); float* GST = (float*)(ws + WS_GST); float* HB = (float*)(ws + WS_HB);
    for (int u = F.tid; u < (LDS_BYTES - LDSCTL_OFF) / 4; u += NWAVES * 64) ((LAS unsigned*)(F.lds + LDSCTL_OFF))[u] = 0u;
    __syncthreads();
    XcdBarrier bar = xcd_barrier_post((unsigned*)(F.ctl + CW_BAR) + args.li * XCD_BAR_WORDS, F.MISC + 8, F.wave);
    const int lo = args.ph_lo, hi = args.ph_hi;
    if (F.tid == 0 && (bar.x != (blockIdx.x & 7u) || F.G != 256)) atomicOr((unsigned*)(F.ctl + CW_MIS + 64 * args.li), 1u);
    bool local_ok = false;
#define IN(k) (lo <= (k) && (k) < hi)
#define SEAM(k) do { if (IN(k) && IN((k) + 1)) { if (local_ok && (k) != 0 && (k) != 4) xcd_barrier_local(bar); else xcd_barrier(bar); } } while (0)

    if (IN(0)) {
        LAS float* scr = (LAS float*)(F.lds + RING_OFF + F.wave * 16384);
        const int gw = F.vcu * NWAVES + F.wave, NGW = F.G * NWAVES;
        constexpr int I_IN = (DM / 64) * (DIN / 32), I_D = (512 / 64) * (DM / 32), I_O = (DM / 64) * (DM / 32), I_UP = (DM / 64) * (FF2 / 32), I_DN = (FF / 64) * (DM / 32);
        constexpr int NITEMS = I_IN + 2 * I_D + I_O + I_UP + I_DN;
        for (int it = gw; it < NITEMS; it += NGW) {
            int r = it;
            if (r < I_IN) { p0_transpose_item(w_in, DM, DIN, WIN, nullptr, 0, scr, r, F.lane); continue; } r -= I_IN;
            if (r < I_D) { p0_transpose_item(w_dp, 512, DM, WD, nullptr, 0, scr, r, F.lane); continue; } r -= I_D;
            if (r < I_D) { p0_transpose_item(w_rp, 512, DM, WR, nullptr, 0, scr, r, F.lane); continue; } r -= I_D;
            if (r < I_O) { p0_transpose_item(w_out, DM, DM, WO, nullptr, 0, scr, r, F.lane); continue; } r -= I_O;
            if (r < I_UP) { p0_transpose_item(w_up, DM, FF2, WUP, g_ffn, 1, scr, r, F.lane); continue; } r -= I_UP;
            p0_transpose_item(w_down, FF, DM, WDN, nullptr, 0, scr, r, F.lane);
        }
        { float* cs = (float*)(ws + WS_CONV);
          for (int i = (int)blockIdx.x * (NWAVES * 64) + F.tid; i < 4 * FF2; i += F.G * (NWAVES * 64)) { const int row = i / FF2, c = i % FF2;
              cs[i] = ((row < 3) ? conv_w[i] : conv_b[c]) * ((c < FF) ? -LOG2E : -1.f / LOG2E); } }
        for (int m = gw; m < M; m += 2 * NGW) {
            const f32x4* xa = (const f32x4*)(x + (size_t)m * DM) + 2 * F.lane; const int m2 = (m + NGW < M) ? m + NGW : m; const f32x4* xb = (const f32x4*)(x + (size_t)m2 * DM) + 2 * F.lane;
            f32x4 va[4], vb[4]; float sa = 0.f, sb = 0.f;
#pragma unroll
            for (int j = 0; j < 2; ++j) { va[2 * j] = xa[128 * j]; va[2 * j + 1] = xa[128 * j + 1]; vb[2 * j] = xb[128 * j]; vb[2 * j + 1] = xb[128 * j + 1]; }
#pragma unroll
            for (int j = 0; j < 4; ++j) { sa += (va[j].x * va[j].x + va[j].y * va[j].y) + (va[j].z * va[j].z + va[j].w * va[j].w); sb += (vb[j].x * vb[j].x + vb[j].y * vb[j].y) + (vb[j].z * vb[j].z + vb[j].w * vb[j].w); }
            const float ra = rsqrtf(wave_sum(sa) * (1.f / DM) + NORM_EPS), rb = rsqrtf(wave_sum(sb) * (1.f / DM) + NORM_EPS);
            u32x4* oa = (u32x4*)(XN + (size_t)m * DM) + F.lane; u32x4* ob = (u32x4*)(XN + (size_t)m2 * DM) + F.lane;
#pragma unroll
            for (int j = 0; j < 2; ++j) { const f32x4 g0 = ((const f32x4*)g_mix)[2 * F.lane + 128 * j], g1 = ((const f32x4*)g_mix)[2 * F.lane + 128 * j + 1];
                u32x4 w; w.x = pk2(va[2 * j].x * ra * g0.x, va[2 * j].y * ra * g0.y); w.y = pk2(va[2 * j].z * ra * g0.z, va[2 * j].w * ra * g0.w);
                w.z = pk2(va[2 * j + 1].x * ra * g1.x, va[2 * j + 1].y * ra * g1.y); w.w = pk2(va[2 * j + 1].z * ra * g1.z, va[2 * j + 1].w * ra * g1.w); oa[64 * j] = w;
                w.x = pk2(vb[2 * j].x * rb * g0.x, vb[2 * j].y * rb * g0.y); w.y = pk2(vb[2 * j].z * rb * g0.z, vb[2 * j].w * rb * g0.w);
                w.z = pk2(vb[2 * j + 1].x * rb * g1.x, vb[2 * j + 1].y * rb * g1.y); w.w = pk2(vb[2 * j + 1].z * rb * g1.z, vb[2 * j + 1].w * rb * g1.w); ob[64 * j] = w; }
        }
    }
    SEAM(0);
    if (lo == 0 && hi > 1) local_ok = __builtin_amdgcn_readfirstlane((int)xb_ld((unsigned*)(F.ctl + CW_MIS + 64 * args.li))) == 0;
    if (IN(1)) {
        pg8::Gemm g{XN, WIN, M, DIN, DM}; pg8::StaticOrder S; S.init(M, DIN, F.G, (int)blockIdx.x);
        pg8::EpiProj E{PROJ, KVP, (unsigned*)(F.ctl + CW_KN)};
        pg8::gemm_phase<pg8::EpiProj, pg8::StaticOrder, true, true>(F.lds + RING_OFF, g, S, E, F.wave);
    }
    SEAM(1);
    if (IN(2)) { if (!(args.opt & 1)) for (int ui = F.vcu; ui < 256; ui += F.G) ret::ret_group_state(F.lds + RING_OFF, PROJ, GST, ui, F.tid); }
    SEAM(2);
    if (IN(3)) { const int tidL = F.wave * 64 + lane_now();
        if (!(args.opt & 1)) for (int ui = F.vcu; ui < 256; ui += F.G) ret::ret_outputs(F.lds + RING_OFF, PROJ, GST, RB, ui ^ 7, tidL);
        if (!(args.opt & 2)) attn::attn_phase<0>(F.lds + RING_OFF, PROJ, KVP, (const unsigned*)(F.ctl + CW_KN), AB, args.in[7], args.in[3], args.in[4], args.in[5], args.in[6], F.vcu, F.G, tidL, (F.G == 256) ? (unsigned*)(F.ctl + CW_AQ + 64 * (8 * args.li + (int)(blockIdx.x & 7))) : nullptr);
#ifdef PROBE_MODE
        if (args.opt & 4) attn::attn_phase<PROBE_MODE>(F.lds + RING_OFF, PROJ, KVP, (const unsigned*)(F.ctl + CW_KN), XN, args.in[7], args.in[3], args.in[4], args.in[5], args.in[6], F.vcu, F.G, tidL);
#endif
    }
    SEAM(3);
    if (IN(4)) {
        pg8::Gemm g{AB, WD, M, DM, 512, RB, WR}; pg8::DualOrder S; S.init(M, DM, F.G, (int)blockIdx.x);
        pg8::EpiMerge2 E{PROJ, MG};
        pg8::gemm_phase<pg8::EpiMerge2, pg8::DualOrder, true, true>(F.lds + RING_OFF, g, S, E, F.wave);
    }
    SEAM(4);
    if (IN(5)) {
        pg8::Gemm g{MG, WO, M, DM, DM}; pg8::StaticOrder S; S.init(M, DM, F.G, (int)blockIdx.x);
        pg8::EpiOutProj E{x, X1B, SSQ1};
        pg8::gemm_phase<pg8::EpiOutProj, pg8::StaticOrder, true, true>(F.lds + RING_OFF, g, S, E, F.wave);
    }
    SEAM(5);
    if (IN(6)) {
        pg8::Gemm g{X1B, WUP, M, FF2, DM}; pg8::StaticOrder S; S.init(M, FF2, F.G, (int)blockIdx.x);
        pg8::EpiUpConv E{SSQ1, GB, HB, (const float*)(ws + WS_CONV), (const float*)(ws + WS_CONV) + 3 * FF2, (LAS float*)(F.lds + HALO_OFF)};
        pg8::gemm_phase<pg8::EpiUpConv, pg8::StaticOrder, true, true>(F.lds + RING_OFF, g, S, E, F.wave);
    }
    SEAM(6);
    if (IN(7)) {
        const bool gp = (F.G == 256);
        const int nw = gp ? 32 : F.G, w = gp ? (int)(blockIdx.x >> 3) : (int)blockIdx.x, pm0 = gp ? (int)(blockIdx.x & 7) * 32 : 0, npm = gp ? 32 : M / 256;
        const int nit = npm * (FF / 4);
        const int tidL = F.wave * 64 + lane_now();
        for (int it = w * (NWAVES * 64) + tidL; it < nit; it += nw * (NWAVES * 64)) {
            const int pm = pm0 + it / (FF / 4), gc = (it % (FF / 4)) * 4;
            if ((pm & 31) == 0) continue;
            const int uc = (gc >> 7) * 256 + (gc & 127);
            const float* h0 = HB + (size_t)(pm - 1) * 4 * FF2, * h1 = HB + (size_t)pm * 4 * FF2;
            const f32x4 gm2 = *(const f32x4*)(h0 + 2 * FF2 + uc), gm1 = *(const f32x4*)(h0 + 3 * FF2 + uc), g0 = *(const f32x4*)(h1 + uc), g1 = *(const f32x4*)(h1 + FF2 + uc);
            const f32x4 um2 = *(const f32x4*)(h0 + 2 * FF2 + uc + 128), um1 = *(const f32x4*)(h0 + 3 * FF2 + uc + 128), u0 = *(const f32x4*)(h1 + uc + 128), u1 = *(const f32x4*)(h1 + FF2 + uc + 128);
            f32x4 wg[3], wu[3];
            const float* cs = (const float*)(ws + WS_CONV);
#pragma unroll
            for (int k = 0; k < 3; ++k) { wg[k] = *(const f32x4*)(cs + k * FF2 + gc); wu[k] = *(const f32x4*)(cs + k * FF2 + FF + gc); }
            const f32x4 bg = *(const f32x4*)(cs + 3 * FF2 + gc), bu = *(const f32x4*)(cs + 3 * FF2 + FF + gc);
            const f32x4 zg0 = bg + wg[2] * g0 + wg[1] * gm1 + wg[0] * gm2, zu0 = bu + wu[2] * u0 + wu[1] * um1 + wu[0] * um2;
            const f32x4 zg1 = bg + wg[2] * g1 + wg[1] * g0 + wg[0] * gm1, zu1 = bu + wu[2] * u1 + wu[1] * u0 + wu[0] * um1;
            f32x4 r0, r1;
#pragma unroll
            for (int i = 0; i < 4; ++i) { r0[i] = (zg0[i] * zu0[i]) * __builtin_amdgcn_rcpf(1.f + __builtin_amdgcn_exp2f(zg0[i])); r1[i] = (zg1[i] * zu1[i]) * __builtin_amdgcn_rcpf(1.f + __builtin_amdgcn_exp2f(zg1[i])); }
            u32x2 w0, w1; w0.x = pg8::cvt_pk_bf16(r0[0], r0[1]); w0.y = pg8::cvt_pk_bf16(r0[2], r0[3]); w1.x = pg8::cvt_pk_bf16(r1[0], r1[1]); w1.y = pg8::cvt_pk_bf16(r1[2], r1[3]);
            *(u32x2*)(GB + (size_t)pm * 256 * FF + gc) = w0; *(u32x2*)(GB + ((size_t)pm * 256 + 1) * FF + gc) = w1;
        }
    }
    SEAM(7);
    if (IN(8)) {
        pg8::Gemm g{GB, WDN, M, DM, FF}; pg8::StaticOrder S; S.init(M, DM, F.G, (int)blockIdx.x);
        pg8::EpiDown E{X1B, X2B, SSQ2};
        pg8::gemm_phase<pg8::EpiDown, pg8::StaticOrder, true, true>(F.lds + RING_OFF, g, S, E, F.wave);
    }
    SEAM(8);
    if (IN(9)) {
        const int laneL = lane_now();
        const bool gp = (F.G == 256);
        const int gw = (gp ? (int)(blockIdx.x >> 3) : F.vcu) * NWAVES + F.wave, NGW = (gp ? 32 : F.G) * NWAVES, m0 = gp ? (int)(blockIdx.x & 7) * 8192 : 0, nm = gp ? 8192 : M;
        for (int mm = gw; mm < nm; mm += 4 * NGW) {
            u32x4 xv[4][2]; float sq[4];
#pragma unroll
            for (int r = 0; r < 4; ++r) { const int m = m0 + ((mm + r * NGW < nm) ? mm + r * NGW : mm); const u32x4* xr = (const u32x4*)(X2B + (size_t)m * DM) + laneL;
                xv[r][0] = xr[0]; xv[r][1] = xr[64]; sq[r] = (laneL < 16) ? SSQ2[(size_t)m * 16 + laneL] : 0.f; }
#pragma unroll
            for (int r = 0; r < 4; ++r) { const int m = m0 + ((mm + r * NGW < nm) ? mm + r * NGW : mm); float q = sq[r];
                q += __shfl_xor(q, 1); q += __shfl_xor(q, 2); q += __shfl_xor(q, 4); q += __shfl_xor(q, 8);
                const float rstd = rsqrtf(__shfl(q, 0) * (1.f / DM) + NORM_EPS);
                f32x4* orow = (f32x4*)(out + (size_t)m * DM) + 2 * laneL;
#pragma unroll
                for (int j = 0; j < 2; ++j) { f32x4 a, b; pg8::unpack8(xv[r][j], a, b);
                    const f32x4 g0 = ((const f32x4*)g_final)[2 * laneL + 128 * j], g1 = ((const f32x4*)g_final)[2 * laneL + 128 * j + 1];
                    orow[128 * j] = a * rstd * g0; orow[128 * j + 1] = b * rstd * g1; } }
        }
    }
#undef IN
#undef SEAM
}

static void launch_mk(Args a, int lo, int hi, int li, int grid, hipStream_t stream, int opt = 0) {
    a.ph_lo = lo; a.ph_hi = hi; a.li = li; a.opt = opt;
    hipLaunchKernelGGL(mk_fwd, dim3(grid), dim3(NWAVES * 64), LDS_BYTES, stream, a);
}
extern "C" void kernel_launch(void* const* d_in, const int* in_sizes, int n_in, void* d_out, int out_size, void* d_ws, size_t ws_size, hipStream_t stream) {
    static int grid = 0;
    if (grid == 0) {
        if (n_in != 17 || out_size != M * DM || ws_size < WS_END) { fprintf(stderr, "kernel_launch: unexpected shapes (n_in %d out %d ws %zu)\n", n_in, out_size, ws_size); grid = -1; return; }
        int dev = 0, cus = 0, per_cu = 0;
        if (hipGetDevice(&dev) != hipSuccess || hipDeviceGetAttribute(&cus, hipDeviceAttributeMultiprocessorCount, dev) != hipSuccess) { grid = -1; return; }
        if (hipFuncSetAttribute((const void*)mk_fwd, hipFuncAttributeMaxDynamicSharedMemorySize, LDS_BYTES) != hipSuccess) { fprintf(stderr, "kernel_launch: hipFuncSetAttribute failed\n"); grid = -1; return; }
        if (hipOccupancyMaxActiveBlocksPerMultiprocessor(&per_cu, (const void*)mk_fwd, NWAVES * 64, LDS_BYTES) != hipSuccess || per_cu < 1) { fprintf(stderr, "kernel_launch: occupancy query says %d\n", per_cu); }
        (void)hipGetLastError();
        grid = cus;
    }
    if (grid < 0) return;
    if (hipMemsetAsync((char*)d_ws + WS_CTL, 0, CTL_ZERO_BYTES, stream) != hipSuccess) return;
    unsigned char* ws = (unsigned char*)d_ws;
    Args a{};
    for (int i = 0; i < 17; ++i) a.in[i] = (const float*)d_in[i];
    a.out = (float*)d_out; a.ws = ws;
    launch_mk(a, 0, N_PHASES, 0, grid, stream);
}
```

```cpp
#include <hip/hip_runtime.h>
#include <cstdio>
#include <cstdint>
#include <cmath>

typedef unsigned short bf16;
typedef short bf16x8 __attribute__((ext_vector_type(8)));
typedef float f32x4 __attribute__((ext_vector_type(4)));
typedef float f32x16 __attribute__((ext_vector_type(16)));
typedef unsigned u32x4 __attribute__((ext_vector_type(4)));
typedef unsigned u32x2 __attribute__((ext_vector_type(2)));

constexpr int BATCH = 8, SEQ = 8192, DM = 1024, M = BATCH * SEQ;
constexpr int NH = 4, HD = 64, DV = 128;
constexpr int DIN = 5120, PP = 4096;
constexpr int FF = 2816, FF2 = 5632;
constexpr int C_Q1 = 0, C_Q2 = 256, C_QR = 512, C_KR = 768, C_VR = 1024, C_GR = 1536, C_GA = 2048, C_GB = 3072;
constexpr float LOG2E = 1.4426950408889634f;
constexpr float C2 = 0.125f * LOG2E;
constexpr float NORM_EPS = 1e-6f, SUBLN_EPS = 1e-5f;
constexpr float LAM_INIT = 0.2f;

constexpr size_t MiB = 1u << 20;
constexpr size_t WS_CTL = 0;
constexpr size_t WS_CONV = 512 * 1024;
constexpr size_t WS_SSQ1 = 2 * MiB;
constexpr size_t WS_SSQ2 = 6 * MiB;
constexpr size_t WS_GST = 10 * MiB;
constexpr size_t WS_WIN = 20 * MiB, WS_WD = 30 * MiB, WS_WR = 31 * MiB, WS_WO = 32 * MiB, WS_WUP = 34 * MiB, WS_WDN = 45 * MiB;
constexpr size_t WS_XN = 64 * MiB;
constexpr size_t WS_PROJ = 192 * MiB;
constexpr size_t WS_KVP = 704 * MiB;
constexpr size_t WS_A = 864 * MiB, WS_R = 928 * MiB;
constexpr size_t WS_X1B = 192 * MiB;
constexpr size_t WS_G = 320 * MiB;
constexpr size_t WS_U = 672 * MiB;
constexpr size_t WS_HB = 672 * MiB;
constexpr size_t WS_END = 1024 * MiB;

__device__ __forceinline__ unsigned f2bf(float f) { unsigned u = __builtin_bit_cast(unsigned, f); return (u + 0x7fffu + ((u >> 16) & 1u)) >> 16; }
__device__ __forceinline__ unsigned pk2(float lo, float hi) { return f2bf(lo) | (f2bf(hi) << 16); }
__device__ __forceinline__ float bf2f(unsigned short b) { return __builtin_bit_cast(float, (unsigned)b << 16); }
__device__ __forceinline__ float bflo(unsigned w) { return __builtin_bit_cast(float, w << 16); }
__device__ __forceinline__ float bfhi(unsigned w) { return __builtin_bit_cast(float, w & 0xffff0000u); }
__device__ __forceinline__ float wave_sum(float v) {
#pragma unroll
    for (int o = 1; o < 64; o <<= 1) v += __shfl_xor(v, o);
    return v;
}
__device__ __forceinline__ float wave_max(float v) {
#pragma unroll
    for (int o = 1; o < 64; o <<= 1) v = fmaxf(v, __shfl_xor(v, o));
    return v;
}
__device__ __forceinline__ float sigmoidf_(float x) { return 1.f / (1.f + __expf(-x)); }
__device__ __forceinline__ float siluf_(float x) { return x / (1.f + __expf(-x)); }
__device__ __forceinline__ float alibi_sl2(int h) { return h == 0 ? 0.36067376022224085f : h == 1 ? 0.09016844005556021f : h == 2 ? 0.022542110013890053f : 0.005635527503472513f; }
__device__ __forceinline__ float ret_lg2(int h) { return h == 0 ? -0.04580368961312479f : h == 1 ? -0.02272007650008353f : h == 2 ? -0.011315313227834146f : -0.005646563141142063f; }

__device__ __forceinline__ int wt_src_col(int n, int mode) {
    if (mode == 0) return n;
    const int t = n >> 8, w = n & 255;
    return (w < 128) ? (t * 128 + w) : (FF + t * 128 + (w - 128));
}
__device__ __forceinline__ int lane_now() { int l; asm volatile("v_mbcnt_lo_u32_b32 %0, -1, 0\n\tv_mbcnt_hi_u32_b32 %0, -1, %0" : "=v"(l)); return l; }
namespace pg8 {
#define PG8_LAS __attribute__((address_space(3)))
typedef unsigned short bf16_t;
typedef short bf16x8 __attribute__((ext_vector_type(8)));
typedef float f32x4 __attribute__((ext_vector_type(4)));
typedef unsigned u32x4 __attribute__((ext_vector_type(4)));
constexpr int BM = 256, BK = 64, HALF = 128, HTB = HALF * BK * 2  , STAGE_BYTES = 8 * HTB, NXCD = 8, WGM = 8;

__host__ __device__ __forceinline__ int lds_byte(int r, int c) { const int st = (r >> 4) * 2 + (c >> 5), rr = r & 15, cc = c & 31, ob = rr * 64 + cc * 2; return st * 1024 + (ob ^ (((ob >> 9) & 1) << 5)); }
__host__ __device__ __forceinline__ void stage_rc(int b, int& R, int& C) { const int st = b / 1024, sb = b % 1024, swz = sb ^ (((sb >> 9) & 1) << 5); R = (st >> 1) * 16 + swz / 64; C = (st & 1) * 32 + (swz % 64) / 2; }
__host__ __device__ __forceinline__ int perm32(int rho) { const int n = rho >> 4, i = rho & 15; return 8 * (i >> 2) + 4 * n + (i & 3); }

struct Unit { int pm, pn, seg; };
struct Gemm { const bf16_t* A; const bf16_t* Bt; int M, N, K; const bf16_t* A2; const bf16_t* Bt2; };

struct StaticOrder {
    int nM, nN, nwg, G, c;
    __host__ __device__ void init(int M, int N, int G_, int c_) { nM = M / BM; nN = N / BM; nwg = nM * nN; G = G_; c = c_; }
    __host__ __device__ bool next(int i, Unit& u) const {
        const long L = (long)i * G + c; if (L >= nwg) return false;
        int wgid = (int)L; { const int q = nwg / NXCD, r = nwg % NXCD, xcd = wgid % NXCD, off = wgid / NXCD; wgid = (xcd < r ? xcd * (q + 1) : r * (q + 1) + (xcd - r) * q) + off; }
        const int nig = WGM * nN, gid = wgid / nig, fm = gid * WGM, gsz = (nM - fm) < WGM ? (nM - fm) : WGM;
        u.pm = fm + ((wgid % nig) % gsz); u.pn = (wgid % nig) / gsz; u.seg = 0; return true;
    }
    __device__ __forceinline__ void a_ready(const Unit&) const {}
    __device__ __forceinline__ void done(const Unit&) const {}
};

struct DualOrder {
    StaticOrder S;
    __host__ __device__ void init(int M, int N, int G_, int c_) { S.init(M, N, G_, c_); }
    __host__ __device__ bool next(int i, Unit& u) const { if (!S.next(i >> 1, u)) return false; u.seg = i & 1; return true; }
    __device__ __forceinline__ void a_ready(const Unit&) const {}
    __device__ __forceinline__ void done(const Unit&) const {}
};

typedef float f32x2 __attribute__((ext_vector_type(2))); typedef __bf16 bf16x2_t __attribute__((ext_vector_type(2)));
__device__ __forceinline__ unsigned cvt_pk_bf16(float lo, float hi) { f32x2 v = {lo, hi}; bf16x2_t b = __builtin_convertvector(v, bf16x2_t); return __builtin_bit_cast(unsigned, b); }
__device__ __forceinline__ float fast_sigmoid(float x) { return __builtin_amdgcn_rcpf(1.f + __builtin_amdgcn_exp2f(-1.4426950408889634f * x)); }
__device__ __forceinline__ u32x4 pack8(const f32x4 a, const f32x4 b) { u32x4 w; w.x = cvt_pk_bf16(a[0], a[1]); w.y = cvt_pk_bf16(a[2], a[3]); w.z = cvt_pk_bf16(b[0], b[1]); w.w = cvt_pk_bf16(b[2], b[3]); return w; }
__device__ __forceinline__ void unpack8(const u32x4 w, f32x4& a, f32x4& b) {
    a[0] = __builtin_bit_cast(float, w.x << 16); a[1] = __builtin_bit_cast(float, w.x & 0xffff0000u); a[2] = __builtin_bit_cast(float, w.y << 16); a[3] = __builtin_bit_cast(float, w.y & 0xffff0000u);
    b[0] = __builtin_bit_cast(float, w.z << 16); b[1] = __builtin_bit_cast(float, w.z & 0xffff0000u); b[2] = __builtin_bit_cast(float, w.w << 16); b[3] = __builtin_bit_cast(float, w.w & 0xffff0000u); }

__device__ __forceinline__ unsigned sig4_u8(const f32x4 v) { unsigned w = 0u;
#pragma unroll
    for (int i = 0; i < 4; ++i) { const float e = __builtin_amdgcn_exp2f(-1.4426950408889634f * v[i]); const unsigned q = (unsigned)(__builtin_amdgcn_rcpf(__builtin_fmaf(e, 1.f / 255.f, 1.f / 255.f)) + 0.5f); w |= q << (8 * i); }
    return w; }
__device__ __forceinline__ f32x4 u8x4_f32(const unsigned w) { return (f32x4){(float)(w & 255u), (float)((w >> 8) & 255u), (float)((w >> 16) & 255u), (float)(w >> 24)} * (1.f / 255.f); }
struct EpiProj {
    static constexpr bool PERM = true, AFTER_DRAIN = false, PERMA = false, PREFETCH = false, DUAL = false;
    bf16_t* P; bf16_t* KV; unsigned* KN;
    __device__ __forceinline__ void operator()(const f32x4 (&acc)[2][2][4][2], const Unit& u, int wr, int wc, int fr, int fq) const {
        const int pn = u.pn, pm = u.pm;
        if (pn >= 2 && pn < 6) {
            const size_t tile0 = ((size_t)(pm >> 5) * 4 * 128 + (size_t)((pm & 31) * 4 + wr)) * 16384;
            if (pn < 4) {
#pragma unroll
                for (int bj = 0; bj < 2; ++bj) { bf16_t* hb = KV + tile0 + (size_t)(2 * bj + (wc >> 1)) * 128 * 16384 + (pn == 3 ? 4096 : 0) + ((wc & 1) * 4 + fq) * 512 + fr * 8;
#pragma unroll
                    for (int ai = 0; ai < 2; ++ai)
#pragma unroll
                        for (int m = 0; m < 4; ++m) *(u32x4*)(hb + (size_t)ai * 2 * 16384 + m * 128) = pack8(acc[ai][bj][m][0], acc[ai][bj][m][1]); }
#pragma unroll
                for (int bj = 0; bj < 2; ++bj) { float hm = 0.f;
#pragma unroll
                    for (int ai = 0; ai < 2; ++ai)
#pragma unroll
                        for (int m = 0; m < 4; ++m) { const f32x4 a = acc[ai][bj][m][0], b = acc[ai][bj][m][1];
                            float q = (a[0] * a[0] + a[1] * a[1]) + (a[2] * a[2] + a[3] * a[3]) + (b[0] * b[0] + b[1] * b[1]) + (b[2] * b[2] + b[3] * b[3]);
                            q += __shfl_xor(q, 16); q += __shfl_xor(q, 32); hm = fmaxf(hm, q); }
                    hm = fmaxf(hm, __shfl_xor(hm, 1)); hm = fmaxf(hm, __shfl_xor(hm, 2)); hm = fmaxf(hm, __shfl_xor(hm, 4)); hm = fmaxf(hm, __shfl_xor(hm, 8));
                    if (fr == 0 && fq == 0) atomicMax(KN + ((pm >> 5) * 4 + 2 * bj + (wc >> 1)) * 2 + (pn - 2), __float_as_uint(hm * 1.01f)); }
            } else {
#pragma unroll
                for (int bj = 0; bj < 2; ++bj) { const int head = (pn - 4) * 2 + bj; const float sl = alibi_sl2(head);
                    bf16_t* hb = KV + tile0 + (size_t)head * 128 * 16384 + 8192 + wc * 2048 + fr * 32 + fq * 8;
#pragma unroll
                    for (int m = 0; m < 4; ++m) { const float sc = __builtin_amdgcn_exp2f(sl * (float)((fr + 16 * m) - 63));
#pragma unroll
                        for (int ai = 0; ai < 2; ++ai) *(u32x4*)(hb + (size_t)ai * 2 * 16384 + m * 512) = pack8(acc[ai][bj][m][0] * sc, acc[ai][bj][m][1] * sc); } }
            }
        } else {
            const int cpn = (pn < 2) ? pn : pn - 4;
            bf16_t* base = P + (size_t)(pm * BM + wr * 64 + fr) * PP + cpn * BM + wc * 32 + 8 * fq;
            if (pn >= 12) {
                unsigned char* gq = (unsigned char*)(P + (size_t)(pm * BM + wr * 64 + fr) * PP + C_GA) + (pn - 12) * 256 + wc * 64 + fq * 16;
#pragma unroll
                for (int ai = 0; ai < 2; ++ai)
#pragma unroll
                    for (int m = 0; m < 4; ++m) { u32x4 w; w.x = sig4_u8(acc[ai][0][m][0]); w.y = sig4_u8(acc[ai][0][m][1]); w.z = sig4_u8(acc[ai][1][m][0]); w.w = sig4_u8(acc[ai][1][m][1]);
                        *(u32x4*)(gq + (size_t)(ai * HALF + m * 16) * (PP * 2)) = w; }
            } else if (pn >= 10) {
#pragma unroll
                for (int ai = 0; ai < 2; ++ai)
#pragma unroll
                    for (int m = 0; m < 4; ++m)
#pragma unroll
                        for (int bj = 0; bj < 2; ++bj) { f32x4 a = acc[ai][bj][m][0], b = acc[ai][bj][m][1];
#pragma unroll
                            for (int i = 0; i < 4; ++i) { a[i] *= fast_sigmoid(a[i]); b[i] *= fast_sigmoid(b[i]); }
                            *(u32x4*)(base + (size_t)(ai * HALF + m * 16) * PP + bj * HALF) = pack8(a, b); }
            } else {
            const float sc = (pn < 2) ? C2 : (pn == 7) ? 0.125f : 1.f;
#pragma unroll
            for (int ai = 0; ai < 2; ++ai)
#pragma unroll
                for (int m = 0; m < 4; ++m)
#pragma unroll
                    for (int bj = 0; bj < 2; ++bj) *(u32x4*)(base + (size_t)(ai * HALF + m * 16) * PP + bj * HALF) = pack8(acc[ai][bj][m][0] * sc, acc[ai][bj][m][1] * sc);
            if (pn < 2) {
#pragma unroll
                for (int bj = 0; bj < 2; ++bj) { float hm = 0.f;
#pragma unroll
                    for (int ai = 0; ai < 2; ++ai)
#pragma unroll
                        for (int m = 0; m < 4; ++m) { const f32x4 a = acc[ai][bj][m][0], b = acc[ai][bj][m][1];
                            float q = (a[0] * a[0] + a[1] * a[1]) + (a[2] * a[2] + a[3] * a[3]) + (b[0] * b[0] + b[1] * b[1]) + (b[2] * b[2] + b[3] * b[3]);
                            q += __shfl_xor(q, 16); q += __shfl_xor(q, 32); hm = fmaxf(hm, q); }
                    hm = fmaxf(hm, __shfl_xor(hm, 1)); hm = fmaxf(hm, __shfl_xor(hm, 2)); hm = fmaxf(hm, __shfl_xor(hm, 4)); hm = fmaxf(hm, __shfl_xor(hm, 8));
                    if (fr == 0 && fq == 0) atomicMax(KN + 64 + ((pm >> 5) * 4 + 2 * bj + (wc >> 1)) * 2 + pn, __float_as_uint(hm * (C2 * C2) * 1.01f)); }
            }
            }
        }
    }
};
struct EpiMerge2 {
    static constexpr bool PERM = true, AFTER_DRAIN = false, PERMA = false, PREFETCH = false, DUAL = true;
    const bf16_t* P; bf16_t* MG;
    static __device__ __forceinline__ f32x4 u8f(const unsigned w) { return (f32x4){(float)(w & 255u), (float)((w >> 8) & 255u), (float)((w >> 16) & 255u), (float)(w >> 24)}; }
    static __device__ __forceinline__ f32x4 max1(const f32x4 v) { return (f32x4){fmaxf(v[0], 1.f), fmaxf(v[1], 1.f), fmaxf(v[2], 1.f), fmaxf(v[3], 1.f)}; }
    __device__ __forceinline__ void mid(f32x4 (&acc)[2][2][4][2], const Unit& u, int wr, int wc, int fr, int fq) const {
        const unsigned char* gq = (const unsigned char*)(P + (size_t)(u.pm * BM + wr * 64 + fr) * PP + C_GA) + u.pn * 256 + wc * 64 + fq * 16;
#pragma unroll
        for (int ai = 0; ai < 2; ++ai)
#pragma unroll
            for (int m = 0; m < 4; ++m) { const u32x4 wa = *(const u32x4*)(gq + (size_t)(ai * HALF + m * 16) * (PP * 2)), wq = *(const u32x4*)(gq + 1024 + (size_t)(ai * HALF + m * 16) * (PP * 2));
#pragma unroll
                for (int bj = 0; bj < 2; ++bj)
#pragma unroll
                    for (int n = 0; n < 2; ++n) { const unsigned da = bj ? (n ? wa.w : wa.z) : (n ? wa.y : wa.x), dr = bj ? (n ? wq.w : wq.z) : (n ? wq.y : wq.x);
                        const f32x4 qa = u8f(da), qr = max1(u8f(dr));
#pragma unroll
                        for (int i = 0; i < 4; ++i) acc[ai][bj][m][n][i] *= qa[i] * __builtin_amdgcn_rcpf(qr[i]); } }
    }
    __device__ __forceinline__ void operator()(const f32x4 (&acc)[2][2][4][2], const Unit& u, int wr, int wc, int fr, int fq) const {
        const int row0 = u.pm * BM + wr * 64 + fr, col0 = u.pn * BM + wc * 32 + 8 * fq;
        const unsigned char* gq = (const unsigned char*)(P + (size_t)row0 * PP + C_GA) + 1024 + u.pn * 256 + wc * 64 + fq * 16;
#pragma unroll
        for (int ai = 0; ai < 2; ++ai)
#pragma unroll
            for (int m = 0; m < 4; ++m) { const int row = row0 + ai * HALF + m * 16;
                const u32x4 wq = *(const u32x4*)(gq + (size_t)(ai * HALF + m * 16) * (PP * 2));
#pragma unroll
                for (int bj = 0; bj < 2; ++bj) { const f32x4 s0 = max1(u8f(bj ? wq.z : wq.x)) * (1.f / 255.f), s1 = max1(u8f(bj ? wq.w : wq.y)) * (1.f / 255.f);
                    *(u32x4*)(MG + (size_t)row * DM + col0 + bj * HALF) = pack8(acc[ai][bj][m][0] * s0, acc[ai][bj][m][1] * s1); } }
    }
};
__device__ __forceinline__ void store_ssq(float* SSQ, float a, float b, int row0, int slot, int fq) {
    const int ra = row0 + (fq >> 1) * HALF + (fq & 1) * 32;
    SSQ[(size_t)ra * 16 + slot] = a; SSQ[(size_t)(ra + 16) * 16 + slot] = b;
}
struct EpiOutProj {
    static constexpr bool PERM = true, AFTER_DRAIN = false, PERMA = false, PREFETCH = false, DUAL = false;
    const float* X; bf16_t* X1B; float* SSQ;
    __device__ __forceinline__ void operator()(const f32x4 (&acc)[2][2][4][2], const Unit& u, int wr, int wc, int fr, int fq) const {
        const int row0 = u.pm * BM + wr * 64 + fr, col0 = u.pn * BM + wc * 32 + 8 * fq;
        float sa = 0.f, sb = 0.f;
#pragma unroll
        for (int ai = 0; ai < 2; ++ai)
#pragma unroll
            for (int m = 0; m < 4; ++m) { const int row = row0 + ai * HALF + m * 16; float s = 0.f;
#pragma unroll
                for (int bj = 0; bj < 2; ++bj) { const size_t off = (size_t)row * DM + col0 + bj * HALF;
                    const f32x4 v0 = *(const f32x4*)(X + off) + acc[ai][bj][m][0], v1 = *(const f32x4*)(X + off + 4) + acc[ai][bj][m][1];
                    *(u32x4*)(X1B + off) = pack8(v0, v1);
                    s += (v0[0] * v0[0] + v0[1] * v0[1]) + (v0[2] * v0[2] + v0[3] * v0[3]) + (v1[0] * v1[0] + v1[1] * v1[1]) + (v1[2] * v1[2] + v1[3] * v1[3]); }
                s += __shfl_xor(s, 16); s += __shfl_xor(s, 32); if (((ai * 4 + m) >> 1) == fq) { if (m & 1) sb = s; else sa = s; } }
        store_ssq(SSQ, sa, sb, row0, u.pn * 4 + wc, fq);
    }
};
__device__ __forceinline__ float dpp_shr1(float x) { return __builtin_bit_cast(float, __builtin_amdgcn_update_dpp(0, __builtin_bit_cast(int, x), 0x111, 0xf, 0xf, true)); }
__device__ __forceinline__ f32x4 row_shr1(const f32x4 v) {
    const float a = v[0], b = v[1], c = v[2], d = v[3];
    return (f32x4){dpp_shr1(a), dpp_shr1(b), dpp_shr1(c), dpp_shr1(d)};
}
struct EpiUpConv {
    static constexpr bool PERM = true, AFTER_DRAIN = false, PERMA = true, PREFETCH = true, DUAL = false;
    const float* SSQ; bf16_t* G; float* HB; const float* cw; const float* cb; PG8_LAS float* halo;
    __device__ __forceinline__ void prefetch(const Unit& u, int ui, int wid, int lane) const {
        const int fr = lane & 15, fq = lane >> 4;
#pragma unroll
        for (int i = 0; i < 2; ++i) { const int k = 2 * wid + i;
            __builtin_amdgcn_global_load_lds((const unsigned*)(SSQ + (size_t)(u.pm * BM + (k >> 3) * 128 + fr * 8 + (k & 7)) * 16 + 4 * fq), (PG8_LAS unsigned*)(halo + 2560 + k * 256), 16, 0, 0); }
        const int w = wid & 3, row = 2 * w + (lane >> 5), c = (lane & 31) * 4, gcb = u.pn * HALF;
        const float* src = (row < 6) ? cw + (row >> 1) * FF2 + (row & 1) * FF + gcb + c : cb + (row & 1) * FF + gcb + c;
        __builtin_amdgcn_global_load_lds((const unsigned*)src, (PG8_LAS unsigned*)(halo + 512 + (ui & 1) * 1024 + w * 256), 16, 0, 0);
    }
    __device__ __forceinline__ void operator()(f32x4 (&acc)[2][2][4][2], const Unit& u, int wr, int wc, int fr, int fq, int ui) const {
        const int pn = u.pn, pm = u.pm, tok0 = pm * BM + wr * 128 + fr * 8, cl = wc * 32 + 8 * fq;
        const bool seq_start = (pm & 31) == 0;
        PG8_LAS float* wt = halo + 512 + (ui & 1) * 1024;
#pragma unroll
        for (int ai = 0; ai < 2; ++ai)
#pragma unroll
            for (int m = 0; m < 4; ++m) { const f32x4 a = *(const PG8_LAS f32x4*)(halo + 2560 + ((wr * 8 + 4 * ai + m) * 64 + fq * 16 + fr) * 4);
                float sq = (a[0] + a[1]) + (a[2] + a[3]); sq += __shfl_xor(sq, 16); sq += __shfl_xor(sq, 32);
                const float r = rsqrtf(sq * (1.f / DM) + NORM_EPS);
#pragma unroll
                for (int bj = 0; bj < 2; ++bj)
#pragma unroll
                    for (int n = 0; n < 2; ++n) acc[ai][bj][m][n] = acc[ai][bj][m][n] * r; }
        if (fr == 15) {
#pragma unroll
            for (int bj = 0; bj < 2; ++bj)
#pragma unroll
                for (int n = 0; n < 2; ++n)
#pragma unroll
                    for (int q = 0; q < 2; ++q) { const f32x4 v = acc[1][bj][2 + q][n];
                        if (wr == 0) *(PG8_LAS f32x4*)(halo + q * 256 + bj * HALF + cl + 4 * n) = v;
                        else *(f32x4*)(HB + ((size_t)pm * 4 + 2 + q) * FF2 + pn * BM + bj * HALF + cl + 4 * n) = v; }
        }
        if (fr == 0 && wr == 0) {
#pragma unroll
            for (int bj = 0; bj < 2; ++bj)
#pragma unroll
                for (int n = 0; n < 2; ++n)
#pragma unroll
                    for (int q = 0; q < 2; ++q) *(f32x4*)(HB + ((size_t)pm * 4 + q) * FF2 + pn * BM + bj * HALF + cl + 4 * n) = acc[0][bj][q][n];
        }
        asm volatile("s_waitcnt lgkmcnt(0)\n\ts_barrier" ::: "memory");
        const int gc = pn * HALF + cl;
        const float hk = (wr == 1 && fr == 0) ? 1.f : 0.f;
#pragma unroll
        for (int jh = 0; jh < 2; ++jh) {
            u32x2 gpk[4];
#pragma unroll
            for (int n = 0; n < 2; ++n) {
                f32x4 g6 = {}, g7 = {}, u6 = {}, u7 = {};
                if (jh == 0) {
                    g6 = row_shr1(acc[1][0][2][n]); g7 = row_shr1(acc[1][0][3][n]); u6 = row_shr1(acc[1][1][2][n]); u7 = row_shr1(acc[1][1][3][n]);
                    g6 = g6 + *(const PG8_LAS f32x4*)(halo + cl + 4 * n) * hk; g7 = g7 + *(const PG8_LAS f32x4*)(halo + 256 + cl + 4 * n) * hk;
                    u6 = u6 + *(const PG8_LAS f32x4*)(halo + HALF + cl + 4 * n) * hk; u7 = u7 + *(const PG8_LAS f32x4*)(halo + 256 + HALF + cl + 4 * n) * hk;
                }
                const f32x4 wg0 = *(const PG8_LAS f32x4*)(wt + 0 * 128 + cl + 4 * n), wg1 = *(const PG8_LAS f32x4*)(wt + 2 * 128 + cl + 4 * n), wg2 = *(const PG8_LAS f32x4*)(wt + 4 * 128 + cl + 4 * n), bg = *(const PG8_LAS f32x4*)(wt + 6 * 128 + cl + 4 * n);
                const f32x4 wu0 = *(const PG8_LAS f32x4*)(wt + 1 * 128 + cl + 4 * n), wu1 = *(const PG8_LAS f32x4*)(wt + 3 * 128 + cl + 4 * n), wu2 = *(const PG8_LAS f32x4*)(wt + 5 * 128 + cl + 4 * n), bu = *(const PG8_LAS f32x4*)(wt + 7 * 128 + cl + 4 * n);
#pragma unroll
                for (int jj = 0; jj < 4; ++jj) { const int j = 4 * jh + jj;
                    const f32x4 vg = acc[j >> 2][0][j & 3][n], vu = acc[j >> 2][1][j & 3][n];
                    const int j1 = (j >= 1) ? j - 1 : 0, j2 = (j >= 2) ? j - 2 : 0;
                    const f32x4 pg1 = (j >= 1) ? acc[j1 >> 2][0][j1 & 3][n] : g7, pg2 = (j >= 2) ? acc[j2 >> 2][0][j2 & 3][n] : (j == 1 ? g7 : g6);
                    const f32x4 pu1 = (j >= 1) ? acc[j1 >> 2][1][j1 & 3][n] : u7, pu2 = (j >= 2) ? acc[j2 >> 2][1][j2 & 3][n] : (j == 1 ? u7 : u6);
                    f32x4 zg = bg + wg2 * vg + wg1 * pg1 + wg0 * pg2; asm volatile("" : "+v"(zg));
                    f32x4 zu = bu + wu2 * vu + wu1 * pu1 + wu0 * pu2; asm volatile("" : "+v"(zu));
                    f32x4 r;
#pragma unroll
                    for (int i = 0; i < 4; ++i) r[i] = (zg[i] * zu[i]) * __builtin_amdgcn_rcpf(1.f + __builtin_amdgcn_exp2f(zg[i]));
                    u32x2 w; w.x = cvt_pk_bf16(r[0], r[1]); w.y = cvt_pk_bf16(r[2], r[3]);
                    const bool skip = (wr == 0) && (fr == 0) && (j < 2) && !seq_start;
                    if (n == 0) { gpk[jj] = w; asm volatile("" : "+v"(gpk[jj].x), "+v"(gpk[jj].y)); }
                    else if (!skip) *(u32x4*)(G + (size_t)(tok0 + j) * FF + gc) = (u32x4){gpk[jj].x, gpk[jj].y, w.x, w.y};
                }
                __builtin_amdgcn_sched_barrier(0);
            }
        }
    }
};
struct EpiDown {
    static constexpr bool PERM = true, AFTER_DRAIN = false, PERMA = false, PREFETCH = false, DUAL = false;
    const bf16_t* X1B; bf16_t* X2B; float* SSQ;
    __device__ __forceinline__ void operator()(const f32x4 (&acc)[2][2][4][2], const Unit& u, int wr, int wc, int fr, int fq) const {
        const int row0 = u.pm * BM + wr * 64 + fr, col0 = u.pn * BM + wc * 32 + 8 * fq;
        float sa = 0.f, sb = 0.f;
#pragma unroll
        for (int ai = 0; ai < 2; ++ai)
#pragma unroll
            for (int m = 0; m < 4; ++m) { const int row = row0 + ai * HALF + m * 16; float s = 0.f;
#pragma unroll
                for (int bj = 0; bj < 2; ++bj) { const size_t off = (size_t)row * DM + col0 + bj * HALF;
                    f32x4 v0, v1; unpack8(*(const u32x4*)(X1B + off), v0, v1); v0 = v0 + acc[ai][bj][m][0]; v1 = v1 + acc[ai][bj][m][1];
                    *(u32x4*)(X2B + off) = pack8(v0, v1);
                    s += (v0[0] * v0[0] + v0[1] * v0[1]) + (v0[2] * v0[2] + v0[3] * v0[3]) + (v1[0] * v1[0] + v1[1] * v1[1]) + (v1[2] * v1[2] + v1[3] * v1[3]); }
                s += __shfl_xor(s, 16); s += __shfl_xor(s, 32); if (((ai * 4 + m) >> 1) == fq) { if (m & 1) sb = s; else sa = s; } }
        store_ssq(SSQ, sa, sb, row0, u.pn * 4 + wc, fq);
    }
};
template <class Epi, class Sched, bool ALIGN_EPI = false, bool SP2 = false>
__device__ __forceinline__ void gemm_phase(PG8_LAS unsigned char* lds, const Gemm g, const Sched& S, const Epi& E, const int wid) {
    const int lane = lane_now(), tid = wid * 64 + lane, wr = wid >> 2, wc = wid & 3, fr = lane & 15, fq = lane >> 4;
    const int K = g.K, nt = K / BK;
    unsigned voffA[2], voffB[2];
#pragma unroll
    for (int i = 0; i < 2; ++i) { int R, C; stage_rc(tid * 16 + i * 8192, R, C); const int Rb = Epi::PERM ? ((R & ~31) + perm32(R & 31)) : R;
        const int Ra = Epi::PERMA ? (128 * ((R >> 6) & 1) + 8 * (R & 15) + ((R >> 4) & 3)) : R;
        voffA[i] = (unsigned)(Ra * K + C) * 2u; voffB[i] = (unsigned)(Rb * K + C) * 2u; }
    const size_t kstep = (size_t)(BK * 2);
    const size_t hstep = (size_t)HALF * K * 2;
    const size_t tstep = 2 * hstep;
    const size_t hstepA = Epi::PERMA ? (size_t)4 * K * 2 : hstep;
    const unsigned ldsw = (unsigned)wid * 1024u;
    const int aoff = lds_byte(wr * 64 + fr, fq * 8), boff = lds_byte(wc * 32 + fr, fq * 8);
#define PG8_SA(b, h) (((b) * 2 + (h)) * HTB)
#define PG8_SB(b, h) ((4 + (b) * 2 + (h)) * HTB)
#define PG8_STAGE(bufoff, gbase, voff) do { _Pragma("unroll") for (int _i = 0; _i < 2; ++_i) \
        __builtin_amdgcn_global_load_lds((const unsigned*)((const char*)(gbase) + (voff)[_i]), (PG8_LAS unsigned*)(lds + (bufoff) + ldsw + _i * 8192), 16, 0, 0); } while (0)
#define PG8_LDA(dst, b, h) do { _Pragma("unroll") for (int m = 0; m < 4; ++m) _Pragma("unroll") for (int k = 0; k < 2; ++k) dst[m][k] = *(const PG8_LAS bf16x8*)(lds + PG8_SA(b, h) + aoff + m * 2048 + k * 1024); } while (0)
#define PG8_LDB(dst, b, h) do { _Pragma("unroll") for (int n = 0; n < 2; ++n) _Pragma("unroll") for (int k = 0; k < 2; ++k) dst[n][k] = *(const PG8_LAS bf16x8*)(lds + PG8_SB(b, h) + boff + n * 2048 + k * 1024); } while (0)
#define PG8_MMA(ai, bj, At, Bt) do { __builtin_amdgcn_s_setprio(1); _Pragma("unroll") for (int m = 0; m < 4; ++m) _Pragma("unroll") for (int n = 0; n < 2; ++n) _Pragma("unroll") for (int k = 0; k < 2; ++k) \
        acc[ai][bj][m][n] = __builtin_amdgcn_mfma_f32_16x16x32_bf16(Bt[n][k], At[m][k], acc[ai][bj][m][n], 0, 0, 0); __builtin_amdgcn_s_setprio(0); } while (0)
#define PG8_WAIT_V(n) asm volatile("s_waitcnt vmcnt(" #n ")" ::: "memory")
#define PG8_WAIT_L(n) asm volatile("s_waitcnt lgkmcnt(" #n ")" ::: "memory")
#define PG8_BAR __builtin_amdgcn_s_barrier()
#define PG8_SCHED __builtin_amdgcn_sched_barrier(0)
    Unit cur, nxt; int ui = 0;
    if (!S.next(0, cur)) return;
    f32x4 acc[2][2][4][2];
#pragma unroll
    for (int a = 0; a < 2; ++a)
#pragma unroll
        for (int b = 0; b < 2; ++b)
#pragma unroll
            for (int m = 0; m < 4; ++m)
#pragma unroll
                for (int n = 0; n < 2; ++n) acc[a][b][m][n] = (f32x4){0.f, 0.f, 0.f, 0.f};
    bf16x8 At[4][2], B0[2][2], B1[2][2];
    const char* cA = (const char*)((Epi::DUAL && cur.seg) ? g.A2 : g.A) + (size_t)cur.pm * tstep; const char* cB = (const char*)((Epi::DUAL && cur.seg) ? g.Bt2 : g.Bt) + (size_t)cur.pn * tstep;
    S.a_ready(cur);
    if constexpr (Epi::PREFETCH) E.prefetch(cur, 0, wid, lane);
    if constexpr (SP2) {
        PG8_STAGE(PG8_SB(0, 0), cB, voffB); PG8_STAGE(PG8_SB(0, 1), cB + hstep, voffB); PG8_STAGE(PG8_SA(0, 0), cA, voffA); PG8_STAGE(PG8_SA(0, 1), cA + hstepA, voffA);
        if (wr == 1) PG8_BAR;
        PG8_WAIT_V(2); PG8_BAR;
        PG8_STAGE(PG8_SB(1, 0), cB + kstep, voffB); PG8_STAGE(PG8_SA(1, 0), cA + kstep, voffA); PG8_STAGE(PG8_SB(1, 1), cB + hstep + kstep, voffB);
        PG8_WAIT_V(6); PG8_BAR;
    } else {
        PG8_STAGE(PG8_SB(0, 0), cB, voffB); PG8_STAGE(PG8_SA(0, 0), cA, voffA); PG8_STAGE(PG8_SB(0, 1), cB + hstep, voffB); PG8_STAGE(PG8_SA(0, 1), cA + hstepA, voffA);
        if (wr == 1) PG8_BAR;
        PG8_WAIT_V(4); PG8_BAR;
        PG8_STAGE(PG8_SB(1, 0), cB + kstep, voffB); PG8_STAGE(PG8_SA(1, 0), cA + kstep, voffA); PG8_STAGE(PG8_SB(1, 1), cB + hstep + kstep, voffB);
        PG8_WAIT_V(6); PG8_BAR;
    }
    for (;;) {
        const bool has_next = S.next(ui + 1, nxt);
        const char* nA = has_next ? (const char*)((Epi::DUAL && nxt.seg) ? g.A2 : g.A) + (size_t)nxt.pm * tstep : cA; const char* nB = has_next ? (const char*)((Epi::DUAL && nxt.seg) ? g.Bt2 : g.Bt) + (size_t)nxt.pn * tstep : cB;
        for (int t = 0; t < nt; t += 2) {
            const bool last = (t == nt - 2);
            const char* a1 = cA + (size_t)(t + 1) * kstep;
            const char* a2 = last ? nA : cA + (size_t)(t + 2) * kstep; const char* b2 = last ? nB : cB + (size_t)(t + 2) * kstep;
            const char* a3 = a2 + kstep; const char* b3 = b2 + kstep;
            if (last && has_next) S.a_ready(nxt);
            if constexpr (SP2) {
            PG8_LDB(B0, 0, 0); PG8_LDB(B1, 0, 1); PG8_SCHED; PG8_LDA(At, 0, 0); PG8_STAGE(PG8_SA(1, 1), a1 + hstepA, voffA);
            PG8_WAIT_V(8); PG8_WAIT_L(0); PG8_BAR; PG8_MMA(0, 0, At, B0); PG8_MMA(0, 1, At, B1); PG8_BAR; PG8_SCHED;
            PG8_LDA(At, 0, 1); PG8_STAGE(PG8_SB(0, 0), b2, voffB); PG8_STAGE(PG8_SB(0, 1), b2 + hstep, voffB); PG8_STAGE(PG8_SA(0, 0), a2, voffA);
            PG8_WAIT_V(8); PG8_WAIT_L(0); PG8_BAR; PG8_MMA(1, 0, At, B0); PG8_MMA(1, 1, At, B1); PG8_BAR; PG8_SCHED;
            PG8_LDB(B0, 1, 0); PG8_LDB(B1, 1, 1); PG8_SCHED; PG8_LDA(At, 1, 0); PG8_STAGE(PG8_SA(0, 1), a2 + hstepA, voffA);
            PG8_WAIT_V(8); PG8_WAIT_L(0); PG8_BAR; PG8_MMA(0, 0, At, B0); PG8_MMA(0, 1, At, B1); PG8_BAR; PG8_SCHED;
            PG8_LDA(At, 1, 1); PG8_STAGE(PG8_SB(1, 0), b3, voffB); PG8_STAGE(PG8_SB(1, 1), b3 + hstep, voffB); PG8_STAGE(PG8_SA(1, 0), a3, voffA);
            PG8_WAIT_V(8); PG8_WAIT_L(0); PG8_BAR; PG8_MMA(1, 0, At, B0); PG8_MMA(1, 1, At, B1); PG8_BAR; PG8_SCHED;
            } else {
            PG8_LDB(B0, 0, 0); PG8_SCHED; PG8_LDA(At, 0, 0); PG8_STAGE(PG8_SA(1, 1), a1 + hstepA, voffA);
            PG8_WAIT_L(8); PG8_BAR; PG8_WAIT_L(0); PG8_MMA(0, 0, At, B0); PG8_BAR; PG8_SCHED;
            PG8_LDB(B1, 0, 1); PG8_STAGE(PG8_SB(0, 0), b2, voffB);
            PG8_BAR; PG8_WAIT_L(0); PG8_MMA(0, 1, At, B1); PG8_BAR;
            PG8_LDA(At, 0, 1); PG8_STAGE(PG8_SA(0, 0), a2, voffA);
            PG8_BAR; PG8_WAIT_L(0); PG8_MMA(1, 0, At, B0); PG8_BAR; PG8_SCHED;
            PG8_STAGE(PG8_SB(0, 1), b2 + hstep, voffB);
            PG8_WAIT_V(6); PG8_BAR; PG8_MMA(1, 1, At, B1); PG8_BAR;
            PG8_LDB(B0, 1, 0); PG8_SCHED; PG8_LDA(At, 1, 0); PG8_STAGE(PG8_SA(0, 1), a2 + hstepA, voffA);
            PG8_WAIT_L(8); PG8_BAR; PG8_WAIT_L(0); PG8_MMA(0, 0, At, B0); PG8_BAR; PG8_SCHED;
            PG8_LDB(B1, 1, 1); PG8_STAGE(PG8_SB(1, 0), b3, voffB);
            PG8_BAR; PG8_WAIT_L(0); PG8_MMA(0, 1, At, B1); PG8_BAR;
            PG8_LDA(At, 1, 1); PG8_STAGE(PG8_SA(1, 0), a3, voffA);
            PG8_BAR; PG8_WAIT_L(0); PG8_MMA(1, 0, At, B0); PG8_BAR; PG8_SCHED;
            PG8_STAGE(PG8_SB(1, 1), b3 + hstep, voffB);
            PG8_WAIT_V(6); PG8_BAR; PG8_MMA(1, 1, At, B1); PG8_BAR;
            }
        }
        if constexpr (ALIGN_EPI) { if (wr == 0) PG8_BAR; }
        if constexpr (!Epi::AFTER_DRAIN) { if constexpr (Epi::PREFETCH) E(acc, cur, wr, wc, fr, fq, ui); else if constexpr (Epi::DUAL) { if (cur.seg == 0) E.mid(acc, cur, wr, wc, fr, fq); else E(acc, cur, wr, wc, fr, fq); } else E(acc, cur, wr, wc, fr, fq); S.done(cur); }
        if (!has_next) break;
        if (!(Epi::DUAL && cur.seg == 0))
#pragma unroll
        for (int a = 0; a < 2; ++a)
#pragma unroll
            for (int b = 0; b < 2; ++b)
#pragma unroll
                for (int m = 0; m < 4; ++m)
#pragma unroll
                    for (int n = 0; n < 2; ++n) acc[a][b][m][n] = (f32x4){0.f, 0.f, 0.f, 0.f};
        cur = nxt; cA = nA; cB = nB; ++ui;
        if constexpr (Epi::PREFETCH) E.prefetch(cur, ui, wid, lane);
        if constexpr (ALIGN_EPI) { if (wr == 1) PG8_BAR; }
    }
    PG8_WAIT_V(0);
    if constexpr (!ALIGN_EPI) { if (wr == 0) PG8_BAR; }
    PG8_BAR;
    if constexpr (Epi::AFTER_DRAIN) { E.fused(acc, cur, wr, wc, fr, fq, lds, wid, lane); S.done(cur); }
#undef PG8_SA
#undef PG8_SB
#undef PG8_STAGE
#undef PG8_LDA
#undef PG8_LDB
#undef PG8_MMA
#undef PG8_WAIT_V
#undef PG8_WAIT_L
#undef PG8_BAR
#undef PG8_SCHED
}
}

#define GAS __attribute__((address_space(1)))
#define LAS __attribute__((address_space(3)))
typedef GAS unsigned gu32;
typedef GAS unsigned long long gu64;
#define RLX_AGENT __ATOMIC_RELAXED, __HIP_MEMORY_SCOPE_AGENT
#define LDS_WAIT() asm volatile("s_waitcnt lgkmcnt(0)" ::: "memory")
#define VM_WAIT() asm volatile("s_waitcnt vmcnt(0)" ::: "memory")
#define XB_TMO      128
#define XB_XCNT(j)  (256  + 64 * (j))
#define XB_XSUB(j)  (1280 + 64 * (j))
#define XB_XGEN(j)  (2304 + 64 * (j))
#define XB_TOP      3328
#define XB_TOPGEN   3392
#define XB_LSUB(j)  (3456 + 64 * (j))
#define XB_LGEN(j)  (4480 + 64 * (j))
#define XCD_BAR_WORDS 5504
#define XB_SPIN_CAP (1u << 18)

__device__ __forceinline__ unsigned xb_ld(unsigned* p)              { return __hip_atomic_load(p, __ATOMIC_RELAXED, __HIP_MEMORY_SCOPE_AGENT); }
__device__ __forceinline__ unsigned xb_add(unsigned* p, unsigned v) { return __hip_atomic_fetch_add(p, v, __ATOMIC_RELAXED, __HIP_MEMORY_SCOPE_AGENT); }
__device__ __forceinline__ unsigned xb_xcc_id() { return (unsigned)__builtin_amdgcn_s_getreg((3 << 11) | 20) & 0xFu; }
#define XB_SPIN(cond, bar) do { unsigned _sp = 0; while (cond) { __builtin_amdgcn_s_sleep(1); \
    if ((++_sp & 255u) == 0u) { if (xb_ld(&(bar)[XB_TMO])) break; if (_sp > XB_SPIN_CAP) { atomicAdd(&(bar)[XB_TMO], 1u); break; } } } } while (0)

struct XcdBarrier {
    unsigned* bar; unsigned x; int wv;
    volatile LAS unsigned* st;
};

__device__ __forceinline__ XcdBarrier xcd_barrier_post(unsigned* bar, volatile LAS unsigned* st, int wv) {
    XcdBarrier b; b.bar = bar; b.x = xb_xcc_id(); b.st = st; b.wv = wv;
    if (wv == 0 && lane_now() == 0) (void)xb_add(&bar[XB_XCNT(b.x)], 1u);
    return b;
}
__device__ __forceinline__ void xcd_barrier_complete(unsigned* bar, unsigned x, unsigned& nloc, unsigned& nx) {
    const unsigned G = gridDim.x * gridDim.y * gridDim.z;
    unsigned sum, cnt, mine, sp = 0u;
    for (;;) {
        sum = 0u; cnt = 0u; mine = 0u;
#pragma unroll
        for (unsigned j = 0; j < 16; ++j) { const unsigned c = xb_ld(&bar[XB_XCNT(j)]); sum += c; cnt += (c > 0u) ? 1u : 0u; mine = (j == x) ? c : mine; }
        if (sum == G) break;
        __builtin_amdgcn_s_sleep(1);
        if ((++sp & 255u) == 0u) { if (xb_ld(&bar[XB_TMO])) break; if (sp > XB_SPIN_CAP) { atomicAdd(&bar[XB_TMO], 1u); break; } }
    }
    nloc = mine > 0u ? mine : 1u; nx = cnt > 0u ? cnt : 1u;
}

__device__ __forceinline__ void xcd_barrier(const XcdBarrier& b) {
    asm volatile("s_waitcnt vmcnt(0)" ::: "memory");
    __syncthreads();
    if (b.wv == 0 && lane_now() == 0) {
        unsigned* bar = b.bar;
        __builtin_amdgcn_s_waitcnt(0);
        unsigned nloc = b.st[0], nx = b.st[1];
        if (nloc == 0u) { xcd_barrier_complete(bar, b.x, nloc, nx); b.st[0] = nloc; b.st[1] = nx; }
        const unsigned old = xb_add(&bar[XB_XSUB(b.x)], 1u);
        const unsigned gen = old / nloc;
        if (old + 1u == (gen + 1u) * nloc) {
            __builtin_amdgcn_fence(__ATOMIC_RELEASE, "agent");
            asm volatile("s_waitcnt vmcnt(0)" ::: "memory");
            const unsigned og = xb_add(&bar[XB_TOP], 1u);
            const unsigned tg = og / nx;
            if (og + 1u == (tg + 1u) * nx) xb_add(&bar[XB_TOPGEN], 1u);
            else XB_SPIN(xb_ld(&bar[XB_TOPGEN]) == tg, bar);
            __builtin_amdgcn_fence(__ATOMIC_ACQUIRE, "agent");
            xb_add(&bar[XB_XGEN(b.x)], 1u);
            asm volatile("s_waitcnt vmcnt(0)" ::: "memory");
        } else {
            XB_SPIN(xb_ld(&bar[XB_XGEN(b.x)]) == gen, bar);
            __builtin_amdgcn_fence(__ATOMIC_ACQUIRE, "agent");
            asm volatile("s_waitcnt vmcnt(0)" ::: "memory");
        }
    }
    __syncthreads();
}
__device__ __forceinline__ void xcd_barrier_local(const XcdBarrier& b) {
    asm volatile("s_waitcnt vmcnt(0)" ::: "memory");
    __syncthreads();
    if (b.wv == 0 && lane_now() == 0) {
        unsigned* bar = b.bar;
        __builtin_amdgcn_s_waitcnt(0);
        const unsigned nloc = b.st[0];
        const unsigned old = xb_add(&bar[XB_LSUB(b.x)], 1u);
        const unsigned gen = old / nloc;
        if (old + 1u == (gen + 1u) * nloc) xb_add(&bar[XB_LGEN(b.x)], 1u);
        else XB_SPIN(xb_ld(&bar[XB_LGEN(b.x)]) == gen, bar);
        __builtin_amdgcn_fence(__ATOMIC_ACQUIRE, "agent");
        asm volatile("s_waitcnt vmcnt(0)" ::: "memory");
    }
    __syncthreads();
}

namespace ret {
typedef short s16x4 __attribute__((ext_vector_type(4)));
typedef short v4i16_t __attribute__((ext_vector_type(4)));
typedef LAS const unsigned char* lptr;
constexpr int QS_STRIDE = 144, KD_STRIDE = 192, VS_STRIDE = 320, OUT_STRIDE = 528;
constexpr int OFF_QS = 0, OFF_ST = 18432, OFF_KS = 36864, OFF_KD = 55296, OFF_VS = 79872, OFF_END = 120832, OFF_OUT = OFF_KS, OFF_SSQ = OFF_END;
static_assert(OFF_OUT + 128 * OUT_STRIDE <= OFF_END && OFF_SSQ + 1024 <= 131072, "retention LDS map");
__device__ __forceinline__ s16x4 vtr(lptr p) { return __builtin_bit_cast(s16x4, __builtin_amdgcn_ds_read_tr16_b64_v4i16((LAS v4i16_t*)p)); }
__device__ __forceinline__ bf16x8 cat8(const s16x4 lo, const s16x4 hi) { return (bf16x8){lo[0], lo[1], lo[2], lo[3], hi[0], hi[1], hi[2], hi[3]}; }

__device__ __forceinline__ void stage_chunk(LAS unsigned char* lds, const bf16* rowbase, int h, float lg, int tid, bool with_qk) {
#pragma unroll
    for (int i = 0; i < 2; ++i) { const int it = tid + 512 * i, row = it >> 3, ch = it & 7;
        const u32x4 k = *(const u32x4*)(rowbase + (size_t)row * PP + C_KR + h * HD + ch * 8);
        f32x4 a, b; pg8::unpack8(k, a, b); const float d = __builtin_amdgcn_exp2f(lg * (float)(127 - row));
        *(LAS u32x4*)(lds + OFF_KD + row * KD_STRIDE + ch * 16) = pg8::pack8(a * d, b * d);
        if (with_qk) { *(LAS u32x4*)(lds + OFF_KS + row * QS_STRIDE + ch * 16) = k;
            *(LAS u32x4*)(lds + OFF_QS + row * QS_STRIDE + ch * 16) = *(const u32x4*)(rowbase + (size_t)row * PP + C_QR + h * HD + ch * 8); } }
#pragma unroll
    for (int i = 0; i < 4; ++i) { const int it = tid + 512 * i, row = it >> 4, ch = it & 15;
        *(LAS u32x4*)(lds + OFF_VS + row * VS_STRIDE + ch * 16) = *(const u32x4*)(rowbase + (size_t)row * PP + C_VR + h * DV + ch * 8); }
}
__device__ __forceinline__ void state_update(f32x16& st, lptr lds, int dkb, int dvb, float gC, int lane) {
    const int hi = lane >> 5, g = (lane >> 4) & 1, qq = (lane & 15) >> 2, pp = lane & 3;
    lptr ka = lds + OFF_KD + (8 * hi + qq) * KD_STRIDE + (32 * dkb + 16 * g + 4 * pp) * 2;
    lptr va = lds + OFF_VS + (8 * hi + qq) * VS_STRIDE + (32 * dvb + 16 * g + 4 * pp) * 2;
#pragma unroll
    for (int r = 0; r < 16; ++r) st[r] *= gC;
#pragma unroll
    for (int ks = 0; ks < 8; ++ks) {
        const bf16x8 a = cat8(vtr(ka + ks * 16 * KD_STRIDE), vtr(ka + (ks * 16 + 4) * KD_STRIDE));
        const bf16x8 b = cat8(vtr(va + ks * 16 * VS_STRIDE), vtr(va + (ks * 16 + 4) * VS_STRIDE));
        st = __builtin_amdgcn_mfma_f32_32x32x16_bf16(a, b, st, 0, 0, 0);
    }
}

__device__ __forceinline__ void ret_group_state(LAS unsigned char* lds, const bf16* PROJ, float* GST, int ui, int tid) {
    const int lane = tid & 63, wave = __builtin_amdgcn_readfirstlane(tid >> 6), hi = lane >> 5;
    const int bh = ui >> 3, s = ui & 7, h = bh & 3, b = bh >> 2, dkb = wave & 1, dvb = wave >> 1;
    const float lg = ret_lg2(h), gC = __builtin_amdgcn_exp2f(lg * 128.f);
    f32x16 st = {};
    const bf16* rb0 = PROJ + ((size_t)b * SEQ + (size_t)(8 * s) * 128) * PP;
    const size_t koff0 = (size_t)(tid >> 3) * PP + C_KR + h * HD + (tid & 7) * 8, voff0 = (size_t)(tid >> 4) * PP + C_VR + h * DV + (tid & 15) * 8;
    u32x4 kk[3][2], vv[3][4];
#pragma unroll
    for (int c = 0; c < 3; ++c) { const bf16* rb = rb0 + (size_t)c * 128 * PP;
#pragma unroll
        for (int i = 0; i < 2; ++i) kk[c][i] = *(const u32x4*)(rb + koff0 + (size_t)(64 * i) * PP);
#pragma unroll
        for (int i = 0; i < 4; ++i) vv[c][i] = *(const u32x4*)(rb + voff0 + (size_t)(32 * i) * PP); }
#pragma unroll
    for (int c = 0; c < 8; ++c) { const int q = c % 3;
        __syncthreads();
#pragma unroll
        for (int i = 0; i < 2; ++i) { const int row = (tid >> 3) + 64 * i, ch = tid & 7;
            f32x4 a, bq; pg8::unpack8(kk[q][i], a, bq); const float d = __builtin_amdgcn_exp2f(lg * (float)(127 - row));
            *(LAS u32x4*)(lds + OFF_KD + row * KD_STRIDE + ch * 16) = pg8::pack8(a * d, bq * d); }
#pragma unroll
        for (int i = 0; i < 4; ++i) { const int row = (tid >> 4) + 32 * i, ch = tid & 15; *(LAS u32x4*)(lds + OFF_VS + row * VS_STRIDE + ch * 16) = vv[q][i]; }
        if (c + 3 < 8) { const bf16* rb = rb0 + (size_t)(c + 3) * 128 * PP;
#pragma unroll
            for (int i = 0; i < 2; ++i) kk[q][i] = *(const u32x4*)(rb + koff0 + (size_t)(64 * i) * PP);
#pragma unroll
            for (int i = 0; i < 4; ++i) vv[q][i] = *(const u32x4*)(rb + voff0 + (size_t)(32 * i) * PP); }
        __syncthreads();
        state_update(st, (lptr)lds, dkb, dvb, gC, lane);
    }
    f32x4* gq = (f32x4*)(GST + (size_t)ui * (HD * DV)) + wave * 256 + lane;
#pragma unroll
    for (int q = 0; q < 4; ++q) gq[q * 64] = (f32x4){st[4 * q], st[4 * q + 1], st[4 * q + 2], st[4 * q + 3]};
    __syncthreads();
}

__device__ __forceinline__ void ret_outputs(LAS unsigned char* lds, const bf16* PROJ, const float* GST, bf16* RB, int ui, int tid) {
    const int lane = tid & 63, wave = __builtin_amdgcn_readfirstlane(tid >> 6), hi = lane >> 5, l31 = lane & 31;
    const int g = (lane >> 4) & 1, qq = (lane & 15) >> 2, pp = lane & 3;
    const int bh = ui >> 3, s = ui & 7, h = bh & 3, b = bh >> 2, dkb = wave & 1, dvb = wave >> 1;
    const int qblk = wave & 3, dvh = wave >> 2;
    const float lg = ret_lg2(h), gC = __builtin_amdgcn_exp2f(lg * 128.f);
    f32x16 st = {};
    for (int sp = 0; sp < s; ++sp) {
        const float w = __builtin_amdgcn_exp2f(lg * 1024.f * (float)(s - 1 - sp));
        const f32x4* gq = (const f32x4*)(GST + (size_t)(bh * 8 + sp) * (HD * DV)) + wave * 256 + lane;
#pragma unroll
        for (int q = 0; q < 4; ++q) { const f32x4 v = gq[q * 64];
#pragma unroll
            for (int i = 0; i < 4; ++i) st[4 * q + i] += w * v[i]; }
    }
    const float qdec = __builtin_amdgcn_exp2f(lg * (float)(32 * qblk + l31 + 1));
    const bf16* rb0 = PROJ + ((size_t)b * SEQ + (size_t)(8 * s) * 128) * PP;
    const size_t qoff0 = (size_t)(tid >> 3) * PP + h * HD + (tid & 7) * 8, voff0 = (size_t)(tid >> 4) * PP + C_VR + h * DV + (tid & 15) * 8;
    u32x4 kk[2], qv[2], vv[4];
#pragma unroll
    for (int i = 0; i < 2; ++i) { kk[i] = *(const u32x4*)(rb0 + qoff0 + C_KR + (size_t)(64 * i) * PP); qv[i] = *(const u32x4*)(rb0 + qoff0 + C_QR + (size_t)(64 * i) * PP); }
#pragma unroll
    for (int i = 0; i < 4; ++i) vv[i] = *(const u32x4*)(rb0 + voff0 + (size_t)(32 * i) * PP);
    for (int c = 0; c < 8; ++c) {
        const size_t row0 = (size_t)b * SEQ + (size_t)(8 * s + c) * 128;
        __syncthreads();
#pragma unroll
        for (int gq = 0; gq < 4; ++gq) { u32x2 w; w.x = pg8::cvt_pk_bf16(st[4 * gq], st[4 * gq + 1]); w.y = pg8::cvt_pk_bf16(st[4 * gq + 2], st[4 * gq + 3]);
            *(LAS u32x2*)(lds + OFF_ST + (32 * dvb + l31) * QS_STRIDE + (32 * dkb + 8 * gq + 4 * hi) * 2) = w; }
#pragma unroll
        for (int i = 0; i < 2; ++i) { const int row = (tid >> 3) + 64 * i, ch = tid & 7;
            f32x4 a, bq; pg8::unpack8(kk[i], a, bq); const float d = __builtin_amdgcn_exp2f(lg * (float)(127 - row));
            *(LAS u32x4*)(lds + OFF_KD + row * KD_STRIDE + ch * 16) = pg8::pack8(a * d, bq * d);
            *(LAS u32x4*)(lds + OFF_KS + row * QS_STRIDE + ch * 16) = kk[i]; *(LAS u32x4*)(lds + OFF_QS + row * QS_STRIDE + ch * 16) = qv[i]; }
#pragma unroll
        for (int i = 0; i < 4; ++i) { const int row = (tid >> 4) + 32 * i, ch = tid & 15; *(LAS u32x4*)(lds + OFF_VS + row * VS_STRIDE + ch * 16) = vv[i]; }
        if (c + 1 < 8) { const bf16* rb = rb0 + (size_t)(c + 1) * 128 * PP;
#pragma unroll
            for (int i = 0; i < 2; ++i) { kk[i] = *(const u32x4*)(rb + qoff0 + C_KR + (size_t)(64 * i) * PP); qv[i] = *(const u32x4*)(rb + qoff0 + C_QR + (size_t)(64 * i) * PP); }
#pragma unroll
            for (int i = 0; i < 4; ++i) vv[i] = *(const u32x4*)(rb + voff0 + (size_t)(32 * i) * PP); }
        __syncthreads();
        bf16x8 qf[4];
#pragma unroll
        for (int d0 = 0; d0 < 4; ++d0) qf[d0] = *(const LAS bf16x8*)(lds + OFF_QS + (32 * qblk + l31) * QS_STRIDE + (16 * d0 + 8 * hi) * 2);
        f32x16 o[2];
#pragma unroll
        for (int d = 0; d < 2; ++d) { o[d] = f32x16{};
#pragma unroll
            for (int d0 = 0; d0 < 4; ++d0) { const bf16x8 a = *(const LAS bf16x8*)(lds + OFF_ST + (32 * (2 * dvh + d) + l31) * QS_STRIDE + (16 * d0 + 8 * hi) * 2);
                o[d] = __builtin_amdgcn_mfma_f32_32x32x16_bf16(a, qf[d0], o[d], 0, 0, 0); }
#pragma unroll
            for (int r = 0; r < 16; ++r) o[d][r] *= qdec; }
        for (int kb = 0; kb <= qblk; ++kb) {
            f32x16 sT = {};
#pragma unroll
            for (int d0 = 0; d0 < 4; ++d0) { const bf16x8 a = *(const LAS bf16x8*)(lds + OFF_KS + (32 * kb + l31) * QS_STRIDE + (16 * d0 + 8 * hi) * 2);
                sT = __builtin_amdgcn_mfma_f32_32x32x16_bf16(a, qf[d0], sT, 0, 0, 0); }
            const int dq = 32 * (qblk - kb) + l31;
#pragma unroll
            for (int r = 0; r < 16; ++r) { const int dist = dq - ((r & 3) + 8 * (r >> 2) + 4 * hi); sT[r] = (dist >= 0) ? sT[r] * __builtin_amdgcn_exp2f(lg * (float)dist) : 0.f; }
            u32x4 pw[2];
#pragma unroll
            for (int sx = 0; sx < 2; ++sx) { pw[sx].x = pg8::cvt_pk_bf16(sT[8 * sx], sT[8 * sx + 1]); pw[sx].y = pg8::cvt_pk_bf16(sT[8 * sx + 2], sT[8 * sx + 3]);
                pw[sx].z = pg8::cvt_pk_bf16(sT[8 * sx + 4], sT[8 * sx + 5]); pw[sx].w = pg8::cvt_pk_bf16(sT[8 * sx + 6], sT[8 * sx + 7]); }
#pragma unroll
            for (int d = 0; d < 2; ++d)
#pragma unroll
                for (int sx = 0; sx < 2; ++sx) { lptr vp = (lptr)lds + OFF_VS + (32 * kb + 16 * sx + 4 * hi + qq) * VS_STRIDE + (32 * (2 * dvh + d) + 16 * g + 4 * pp) * 2;
                    const bf16x8 a = cat8(vtr(vp), vtr(vp + 8 * VS_STRIDE));
                    o[d] = __builtin_amdgcn_mfma_f32_32x32x16_bf16(a, __builtin_bit_cast(bf16x8, pw[sx]), o[d], 0, 0, 0); }
        }
        state_update(st, (lptr)lds, dkb, dvb, gC, lane);
        float ss = 0.f;
#pragma unroll
        for (int d = 0; d < 2; ++d)
#pragma unroll
            for (int r = 0; r < 16; ++r) ss += o[d][r] * o[d][r];
        ss += __shfl_xor(ss, 32);
        __syncthreads();
#pragma unroll
        for (int d = 0; d < 2; ++d)
#pragma unroll
            for (int gq = 0; gq < 4; ++gq) *(LAS f32x4*)(lds + OFF_OUT + (32 * qblk + l31) * OUT_STRIDE + (32 * (2 * dvh + d) + 8 * gq + 4 * hi) * 4) = (f32x4){o[d][4 * gq], o[d][4 * gq + 1], o[d][4 * gq + 2], o[d][4 * gq + 3]};
        if (hi == 0) *(LAS float*)(lds + OFF_SSQ + (dvh * 128 + 32 * qblk + l31) * 4) = ss;
        __syncthreads();
        { const int row = tid >> 2, seg = tid & 3;
          const float rstd = rsqrtf((*(const LAS float*)(lds + OFF_SSQ + row * 4) + *(const LAS float*)(lds + OFF_SSQ + (128 + row) * 4)) * (1.f / DV) + SUBLN_EPS);
          const bf16* gsrc = PROJ + (row0 + row) * PP + C_GR + h * DV + seg * 32; bf16* dst = RB + (row0 + row) * 512 + h * DV + seg * 32;
#pragma unroll
          for (int cc = 0; cc < 4; ++cc) { const f32x4 v0 = *(const LAS f32x4*)(lds + OFF_OUT + row * OUT_STRIDE + (seg * 32 + cc * 8) * 4), v1 = *(const LAS f32x4*)(lds + OFF_OUT + row * OUT_STRIDE + (seg * 32 + cc * 8 + 4) * 4);
              f32x4 g0, g1; pg8::unpack8(*(const u32x4*)(gsrc + cc * 8), g0, g1); f32x4 r0, r1;
#pragma unroll
              for (int i = 0; i < 4; ++i) { r0[i] = v0[i] * rstd * g0[i]; r1[i] = v1[i] * rstd * g1[i]; }
              *(u32x4*)(dst + cc * 8) = pg8::pack8(r0, r1); } }
    }
    __syncthreads();
}
}

namespace attn {
typedef short s16x4 __attribute__((ext_vector_type(4)));
typedef short v4i16_t __attribute__((ext_vector_type(4)));
typedef LAS const unsigned char* lptr;
constexpr int KSLOT = 16384, L_K2 = 8192, L_V = 65536, VSLOT = 16384;
#ifndef ATT_SKIP
#define ATT_SKIP 1
#endif
#ifndef ATT_THR
#define ATT_THR 60.0f
#endif
__device__ __forceinline__ void glds16s(const void* sbase, unsigned voff, unsigned lds_dst) { unsigned keep;
    asm volatile("s_mov_b32 %0, m0\n\ts_mov_b32 m0, %3\n\ts_nop 0\n\tglobal_load_lds_dwordx4 %1, %2\n\ts_mov_b32 m0, %0" : "=&s"(keep) : "v"(voff), "s"(sbase), "s"(lds_dst) : "memory"); }
__device__ __forceinline__ void glds16(const void* gsrc, unsigned lds_dst) { unsigned keep;
    asm volatile("s_mov_b32 %0, m0\n\ts_mov_b32 m0, %2\n\ts_nop 0\n\tglobal_load_lds_dwordx4 %1, off\n\ts_mov_b32 m0, %0" : "=&s"(keep) : "v"(gsrc), "s"(lds_dst) : "memory"); }
__device__ __forceinline__ s16x4 vtr(lptr p) { return __builtin_bit_cast(s16x4, __builtin_amdgcn_ds_read_tr16_b64_v4i16((LAS v4i16_t*)p)); }
__device__ __forceinline__ bf16x8 cat8(const s16x4 lo, const s16x4 hi) { return (bf16x8){lo[0], lo[1], lo[2], lo[3], hi[0], hi[1], hi[2], hi[3]}; }
#define ATT_WAIT_BAR() asm volatile("s_waitcnt vmcnt(0) lgkmcnt(0)\n\ts_barrier" ::: "memory")
#define ATT_WAIT_BAR4() asm volatile("s_waitcnt vmcnt(4) lgkmcnt(0)\n\ts_barrier" ::: "memory")

#define ATT_SB() __builtin_amdgcn_sched_barrier(0)
__device__ __forceinline__ float max3f(float a, float b, float c) { float r; asm("v_max3_f32 %0, %1, %2, %3" : "=v"(r) : "v"(a), "v"(b), "v"(c)); return r; }
__device__ __forceinline__ bf16x8 vfrag(lptr vp, int ks, int d) { const lptr va = vp + d * 4096 + (32 * (ks >> 1) + 16 * (ks & 1)) * 64; return cat8(vtr(va), vtr(va + 8 * 64)); }
__device__ __forceinline__ void vload4(bf16x8 (&buf)[8], int half, lptr vp, int ks) {
#pragma unroll
    for (int d = 0; d < 4; ++d) buf[4 * half + d] = vfrag(vp, ks, d);
}
__device__ __forceinline__ void pv_step(f32x16 (&o)[4], const u32x4& pwk, const bf16x8 (&buf)[8], int half) {
    const bf16x8 pb = __builtin_bit_cast(bf16x8, pwk);
#pragma unroll
    for (int d = 0; d < 4; ++d) o[d] = __builtin_amdgcn_mfma_f32_32x32x16_bf16(buf[4 * half + d], pb, o[d], 0, 0, 0);
}
__device__ __forceinline__ void kload8(bf16x8 (&kf)[8], lptr kp) {
#pragma unroll
    for (int d0 = 0; d0 < 4; ++d0) { kf[2 * d0] = *(const LAS bf16x8*)(kp + d0 * 2048); kf[2 * d0 + 1] = *(const LAS bf16x8*)(kp + d0 * 2048 + 512); }
}
__device__ __forceinline__ void kload4(bf16x8 (&kf)[8], lptr kp, int half) {
#pragma unroll
    for (int d0 = 2 * half; d0 < 2 * half + 2; ++d0) { kf[2 * d0] = *(const LAS bf16x8*)(kp + d0 * 2048); kf[2 * d0 + 1] = *(const LAS bf16x8*)(kp + d0 * 2048 + 512); }
}
template <int MODE> __device__ __forceinline__ void qk_scores(const bf16x8 (&kf)[8], const bf16x8 (&qr)[4], f32x16 (&o)[4], f32x16& p0, f32x16& p1, float& cinit, float shift, bool band, int kb, int qrel, lptr vp, bf16x8 (&tmp)[8]) {
#pragma unroll
    for (int r = 0; r < 16; ++r) { p0[r] = cinit; p1[r] = cinit; }
#pragma unroll
    for (int d0 = 0; d0 < 4; ++d0) {
        p0 = __builtin_amdgcn_mfma_f32_32x32x16_bf16(kf[2 * d0], qr[d0], p0, 0, 0, 0);
        p1 = __builtin_amdgcn_mfma_f32_32x32x16_bf16(kf[2 * d0 + 1], qr[d0], p1, 0, 0, 0);
    }
    ATT_SB();
    vload4(tmp, 0, vp, 0); vload4(tmp, 1, vp, 1);
    ATT_SB();
}
template <int MODE> __device__ __forceinline__ void softmax_head(f32x16 (&o)[4], float& lsum, f32x16& p0, f32x16& p1, float& cinit, float shift, bool band, int kb, int qrel) {
    if (!(MODE & 2)) {
    if (band) {
#pragma unroll
        for (int r = 0; r < 16; ++r) { const int kv = kb + (r & 3) + 8 * (r >> 2); if (kv > qrel) p0[r] = -INFINITY; if (kv + 32 > qrel) p1[r] = -INFINITY; }
    }
    ATT_SB(); asm volatile("s_nop 7\n\ts_nop 7"); ATT_SB();
    float rm = max3f(p0[0], p0[1], p1[0]), rb = max3f(p0[2], p0[3], p1[1]);
    rm = max3f(rm, p1[2], p1[3]);
#pragma unroll
    for (int r = 4; r < 16; r += 4) { rm = max3f(rm, p0[r], p0[r + 1]); rb = max3f(rb, p0[r + 2], p0[r + 3]); rm = max3f(rm, p1[r], p1[r + 1]); rb = max3f(rb, p1[r + 2], p1[r + 3]); }
    rm = max3f(rm, rb, rb);
    { auto rr = __builtin_amdgcn_permlane32_swap(__float_as_uint(rm), __float_as_uint(rm), false, false); rm = fmaxf(__uint_as_float(rr[0]), __uint_as_float(rr[1])); }
    if (__any(rm > ATT_THR)) {
        const float dl = fmaxf(rm, 0.f), f = __builtin_amdgcn_exp2f(-dl);
        cinit -= dl;
#pragma unroll
        for (int r = 0; r < 16; ++r) { p0[r] -= dl; p1[r] -= dl; }
        lsum *= f;
#pragma unroll
        for (int d = 0; d < 4; ++d)
#pragma unroll
            for (int r = 0; r < 16; ++r) o[d][r] *= f;
    }
    }
    cinit += shift;
}
struct AW { float b1, b2, b3, a8, c1, c2, c3; };
template <int MODE> __device__ __forceinline__ u32x4 exp_pack(const f32x16& p, int s, float& lsum, float cks, const AW& aw) {
    float e[8];
#pragma unroll
    for (int j = 0; j < 8; ++j) e[j] = (MODE & 2) ? p[8 * s + j] : __builtin_amdgcn_exp2f(p[8 * s + j]);
    const float g0 = __builtin_fmaf(aw.b3, e[3], __builtin_fmaf(aw.b2, e[2], __builtin_fmaf(aw.b1, e[1], e[0])));
    const float g1 = __builtin_fmaf(aw.b3, e[7], __builtin_fmaf(aw.b2, e[6], __builtin_fmaf(aw.b1, e[5], e[4])));
    lsum = __builtin_fmaf(cks, __builtin_fmaf(aw.a8, g1, g0), lsum);
    u32x4 w; w.x = pg8::cvt_pk_bf16(e[0], e[1]); w.y = pg8::cvt_pk_bf16(e[2], e[3]); w.z = pg8::cvt_pk_bf16(e[4], e[5]); w.w = pg8::cvt_pk_bf16(e[6], e[7]);
    return w;
}
__device__ __forceinline__ void qk_half(const bf16x8 (&kf)[8], const bf16x8 (&qr)[4], f32x16& p0, f32x16& p1, int half) {
    if (half == 0) {
        p0 = __builtin_amdgcn_mfma_f32_32x32x16_bf16(kf[0], qr[0], f32x16{}, 0, 0, 0); p1 = __builtin_amdgcn_mfma_f32_32x32x16_bf16(kf[1], qr[0], f32x16{}, 0, 0, 0);
        p0 = __builtin_amdgcn_mfma_f32_32x32x16_bf16(kf[2], qr[1], p0, 0, 0, 0); p1 = __builtin_amdgcn_mfma_f32_32x32x16_bf16(kf[3], qr[1], p1, 0, 0, 0);
    } else {
        p0 = __builtin_amdgcn_mfma_f32_32x32x16_bf16(kf[4], qr[2], p0, 0, 0, 0); p1 = __builtin_amdgcn_mfma_f32_32x32x16_bf16(kf[5], qr[2], p1, 0, 0, 0);
        p0 = __builtin_amdgcn_mfma_f32_32x32x16_bf16(kf[6], qr[3], p0, 0, 0, 0); p1 = __builtin_amdgcn_mfma_f32_32x32x16_bf16(kf[7], qr[3], p1, 0, 0, 0);
    }
}
__device__ __forceinline__ void softmax_head2(f32x16 (&o)[4], float& lsum, f32x16& p0, f32x16& p1, float& c, bool band, int kb, int qrel) {
    if (band) {
#pragma unroll
        for (int r = 0; r < 16; ++r) { const int kv = kb + (r & 3) + 8 * (r >> 2); if (kv > qrel) p0[r] = -INFINITY; if (kv + 32 > qrel) p1[r] = -INFINITY; }
    }
    ATT_SB();
    float rm = max3f(p0[0], p0[1], p1[0]), rb = max3f(p0[2], p0[3], p1[1]);
    rm = max3f(rm, p1[2], p1[3]);
#pragma unroll
    for (int r = 4; r < 16; r += 4) { rm = max3f(rm, p0[r], p0[r + 1]); rb = max3f(rb, p0[r + 2], p0[r + 3]); rm = max3f(rm, p1[r], p1[r + 1]); rb = max3f(rb, p1[r + 2], p1[r + 3]); }
    rm = max3f(rm, rb, rb) + c;
    { auto rr = __builtin_amdgcn_permlane32_swap(__float_as_uint(rm), __float_as_uint(rm), false, false); rm = fmaxf(__uint_as_float(rr[0]), __uint_as_float(rr[1])); }
    if (__any(rm > ATT_THR)) {
        const float dl = fmaxf(rm, 0.f), f = __builtin_amdgcn_exp2f(-dl);
        c -= dl; lsum *= f;
#pragma unroll
        for (int d = 0; d < 4; ++d)
#pragma unroll
            for (int r = 0; r < 16; ++r) o[d][r] *= f;
    }
}
__device__ __forceinline__ u32x4 exp_pack2(const f32x16& p, int s, float c, float& lsum, float cks, const AW& aw) {
    float e[8];
#pragma unroll
    for (int j = 0; j < 8; ++j) e[j] = __builtin_amdgcn_exp2f(p[8 * s + j] + c);
    const float g0 = __builtin_fmaf(aw.b3, e[3], __builtin_fmaf(aw.b2, e[2], __builtin_fmaf(aw.b1, e[1], e[0])));
    const float g1 = __builtin_fmaf(aw.b3, e[7], __builtin_fmaf(aw.b2, e[6], __builtin_fmaf(aw.b1, e[5], e[4])));
    lsum = __builtin_fmaf(cks, __builtin_fmaf(aw.a8, g1, g0), lsum);
    u32x4 w; w.x = pg8::cvt_pk_bf16(e[0], e[1]); w.y = pg8::cvt_pk_bf16(e[2], e[3]); w.z = pg8::cvt_pk_bf16(e[4], e[5]); w.w = pg8::cvt_pk_bf16(e[6], e[7]);
    return w;
}
struct ESl { float g0, g1; };
__device__ __forceinline__ void exp_slice(ESl& x, u32x4& w, const f32x16& p, int s, int d, float c, const AW& aw) {
    const float a = __builtin_amdgcn_exp2f(p[8 * s + 2 * d] + c), b = __builtin_amdgcn_exp2f(p[8 * s + 2 * d + 1] + c);
    const unsigned pk = pg8::cvt_pk_bf16(a, b);
    if (d == 0) { w.x = pk; x.g0 = __builtin_fmaf(aw.b1, b, a); } else if (d == 1) { w.y = pk; x.g0 = __builtin_fmaf(aw.b3, b, __builtin_fmaf(aw.b2, a, x.g0)); }
    else if (d == 2) { w.z = pk; x.g1 = __builtin_fmaf(aw.b1, b, a); } else { w.w = pk; x.g1 = __builtin_fmaf(aw.b3, b, __builtin_fmaf(aw.b2, a, x.g1)); }
}
#define ATT_PIN1(v) asm volatile("" : "+v"(v))
__device__ __forceinline__ void pv_exp_step(f32x16 (&o)[4], const u32x4& pwk, bf16x8 (&buf)[8], int half, lptr vp, int vks, u32x4& wn, const f32x16& pnx, int s, float c, float& lsum, float cks, const AW& aw) {
    const bf16x8 pb = __builtin_bit_cast(bf16x8, pwk); ESl x;
#pragma unroll
    for (int d = 0; d < 4; ++d) {
        o[d] = __builtin_amdgcn_mfma_f32_32x32x16_bf16(buf[4 * half + d], pb, o[d], 0, 0, 0);
        exp_slice(x, wn, pnx, s, d, c, aw);
        if (vks >= 0) buf[4 * half + d] = vfrag(vp, vks, d);
        if (d == 3) lsum = __builtin_fmaf(cks, __builtin_fmaf(aw.a8, x.g1, x.g0), lsum);
        if (d == 0) ATT_PIN1(wn.x); else if (d == 1) ATT_PIN1(wn.y); else if (d == 2) ATT_PIN1(wn.z); else { ATT_PIN1(wn.w); ATT_PIN1(lsum); }
        ATT_SB();
    }
}
__device__ __forceinline__ void qk_exp_half(const bf16x8 (&kf)[8], const bf16x8 (&qr)[4], f32x16& p0, f32x16& p1, bool nxt, u32x4& wn, const f32x16& pcur, float c, float& lsum, const AW& aw) {
    ESl x;
#pragma unroll
    for (int d = 0; d < 4; ++d) {
        if (nxt) { if (d == 0) p0 = __builtin_amdgcn_mfma_f32_32x32x16_bf16(kf[4], qr[2], p0, 0, 0, 0); else if (d == 1) p1 = __builtin_amdgcn_mfma_f32_32x32x16_bf16(kf[5], qr[2], p1, 0, 0, 0);
                   else if (d == 2) p0 = __builtin_amdgcn_mfma_f32_32x32x16_bf16(kf[6], qr[3], p0, 0, 0, 0); else p1 = __builtin_amdgcn_mfma_f32_32x32x16_bf16(kf[7], qr[3], p1, 0, 0, 0); }
        exp_slice(x, wn, pcur, 0, d, c, aw);
        if (d == 3) lsum = __builtin_fmaf(1.f, __builtin_fmaf(aw.a8, x.g1, x.g0), lsum);
        if (d == 0) ATT_PIN1(wn.x); else if (d == 1) ATT_PIN1(wn.y); else if (d == 2) ATT_PIN1(wn.z); else { ATT_PIN1(wn.w); ATT_PIN1(lsum); }
        ATT_SB();
    }
}
template <int MODE> __device__ __forceinline__ void attn_unit(LAS unsigned char* lds, const bf16* PROJ, const bf16* KVP, bf16* AB, const float* gsub, float lam, int bh, int qb, float dq2, int tid) {
    const int lane = tid & 63, r32 = lane & 31, hi = lane >> 5, g = (lane >> 4) & 1, qq = (lane & 15) >> 2, pp = lane & 3;
    const int wid = __builtin_amdgcn_readfirstlane(tid >> 6), map = wid >> 2, qblk = wid & 3;
    const int b = bh >> 2, h = bh & 3, q0 = qb * 128;
    const size_t rowbase = (size_t)b * SEQ;
    const float sl2 = alibi_sl2(h);
    const unsigned lds0 = (unsigned)(uintptr_t)lds;
    const char* kvw = (const char*)(KVP + (size_t)bh * 128 * 16384) + wid * 1024;
    const unsigned lane16 = (unsigned)lane * 16u;
#define ATT_DMA_K(t, kslot) do { const char* _g = kvw + (size_t)(t) * 32768; const unsigned _k = lds0 + (kslot) * KSLOT + wid * 1024; \
        glds16s(_g, lane16, (unsigned)__builtin_amdgcn_readfirstlane(_k)); glds16s(_g + 8192, lane16, (unsigned)__builtin_amdgcn_readfirstlane(_k + L_K2)); } while (0)
#define ATT_DMA_V(t, vslot) do { const char* _g = kvw + (size_t)(t) * 32768 + 16384; const unsigned _v = lds0 + L_V + (vslot) * VSLOT + wid * 1024; \
        glds16s(_g, lane16, (unsigned)__builtin_amdgcn_readfirstlane(_v)); glds16s(_g + 8192, lane16, (unsigned)__builtin_amdgcn_readfirstlane(_v + 8192)); } while (0)
    const int NT = 2 * (qb + 1);
    int t0 = 0;
#if ATT_SKIP
    { const float dneed = (152.f + dq2) / sl2;
      const int tq = (int)__builtin_floorf(((float)q0 - dneed - 63.f) * (1.f / 64.f)) + 1;
      t0 = __builtin_amdgcn_readfirstlane(tq > 0 ? tq : 0); }
#endif
    ATT_DMA_K(t0, 0); ATT_DMA_V(t0, 0); ATT_DMA_K(t0 + 1, 1); ATT_DMA_V(t0 + 1, 1);
    if (t0 + 2 < NT) { ATT_DMA_K(t0 + 2, 2); ATT_DMA_V(t0 + 2, 2); }
    const bf16* Qw = PROJ + (rowbase + q0 + 32 * qblk + r32) * PP + (map ? C_Q2 : C_Q1) + h * HD;
    bf16x8 qr[4];
#pragma unroll
    for (int d0 = 0; d0 < 4; ++d0) qr[d0] = *(const bf16x8*)(Qw + d0 * 16 + hi * 8);
    auto uni = [](float x) { return __builtin_bit_cast(float, __builtin_amdgcn_readfirstlane(__builtin_bit_cast(int, x))); };
    const AW aw = {uni(__builtin_amdgcn_exp2f(sl2)), uni(__builtin_amdgcn_exp2f(2.f * sl2)), uni(__builtin_amdgcn_exp2f(3.f * sl2)), uni(__builtin_amdgcn_exp2f(8.f * sl2)),
                   uni(__builtin_amdgcn_exp2f(16.f * sl2)), uni(__builtin_amdgcn_exp2f(32.f * sl2)), uni(__builtin_amdgcn_exp2f(48.f * sl2))};
    const float whi = __builtin_amdgcn_exp2f(sl2 * (float)(4 * hi - 63));
    float lsum = 0.f;
    f32x16 o[4];
#pragma unroll
    for (int d = 0; d < 4; ++d) o[d] = f32x16{};
    float cinit = sl2 * 63.f;
    const float shift = 64.f * sl2;
    const int qrel = 32 * qblk + r32;
    const lptr ldsc = (lptr)lds;
    const lptr vp0 = ldsc + L_V + (4 * hi + qq) * 64 + (16 * g + 4 * pp) * 2;
    const lptr kp0 = ldsc + (map ? L_K2 : 0) + hi * 1024 + r32 * 16;
    u32x4 pw[4];
#pragma unroll
    for (int i = 0; i < 4; ++i) pw[i] = (u32x4){0u, 0u, 0u, 0u};
    bf16x8 hold[8], tmp[8];
    int sl_cur = 0;
    asm volatile("" : "+v"(qr[0]), "+v"(qr[1]), "+v"(qr[2]), "+v"(qr[3]));
    ATT_WAIT_BAR();
    f32x16 pA0, pA1, pB0, pB1;
    kload8(hold, kp0);
    qk_half(hold, qr, pA0, pA1, 0); qk_half(hold, qr, pA0, pA1, 1);
    auto step = [&](int t, f32x16& pc0, f32x16& pc1, f32x16& pn0, f32x16& pn1) __attribute__((always_inline)) {
        if (t > t0) { if (t + 2 < NT) ATT_WAIT_BAR4(); else ATT_WAIT_BAR(); }
        const bool nxt = (t + 1 < NT), band = (t >= NT - 2); const int kb = 64 * (t - (NT - 2)) + 4 * hi;
        const lptr vp = vp0 + sl_cur * VSLOT;
        if (nxt) kload4(hold, kp0 + ((sl_cur + 1) & 3) * KSLOT, 0);
        vload4(tmp, 0, vp, 0); vload4(tmp, 1, vp, 1);
        ATT_SB();
        if (nxt) qk_half(hold, qr, pn0, pn1, 0);
        if (nxt) kload4(hold, kp0 + ((sl_cur + 1) & 3) * KSLOT, 1);
        ATT_SB();
        softmax_head2(o, lsum, pc0, pc1, cinit, band, kb, qrel);
        ATT_SB();
        if (t + 3 < NT) { ATT_DMA_K(t + 3, (sl_cur + 3) & 3); ATT_DMA_V(t + 3, (sl_cur + 3) & 3); }
        ATT_SB();
        { u32x4 wa, wb;
        qk_exp_half(hold, qr, pn0, pn1, nxt, wa, pc0, cinit, lsum, aw);
        pv_exp_step(o, wa, tmp, 0, vp, 2, wb, pc0, 1, cinit, lsum, aw.c1, aw);
        pv_exp_step(o, wb, tmp, 1, vp, 3, wa, pc1, 0, cinit, lsum, aw.c2, aw);
        pv_exp_step(o, wa, tmp, 0, vp, -1, wb, pc1, 1, cinit, lsum, aw.c3, aw);
        pv_step(o, wb, tmp, 1); ATT_SB(); }
        cinit += shift;
        sl_cur = (sl_cur + 1) & 3;
    };
    for (int t = t0; t < NT; t += 2) { step(t, pA0, pA1, pB0, pB1); if (t + 1 < NT) step(t + 1, pB0, pB1, pA0, pA1); }
    float rl;
    { const float lw = lsum * whi; auto rr = __builtin_amdgcn_permlane32_swap(__float_as_uint(lw), __float_as_uint(lw), false, false); rl = __builtin_amdgcn_rcpf(__uint_as_float(rr[0]) + __uint_as_float(rr[1])); }
    ATT_WAIT_BAR();
    LAS float* xch = (LAS float*)(lds + qblk * 16384) + lane;
    if (map == 1) {
#pragma unroll
        for (int d = 0; d < 4; ++d)
#pragma unroll
            for (int r = 0; r < 16; ++r) xch[(d * 16 + r) * 64] = o[d][r] * rl;
    }
    ATT_WAIT_BAR();
    if (map == 0) {
        float ss = 0.f;
#pragma unroll
        for (int d = 0; d < 4; ++d)
#pragma unroll
            for (int r = 0; r < 16; ++r) { const float a = o[d][r] * rl - lam * xch[(d * 16 + r) * 64]; o[d][r] = a; ss += a * a; }
        ss += __shfl_xor(ss, 32);
        const float rstd = rsqrtf(ss * (1.f / DV) + SUBLN_EPS) * (1.f - LAM_INIT);
        bf16* dst = AB + (rowbase + q0 + 32 * qblk + r32) * 512 + h * DV + 8 * hi;
#pragma unroll
        for (int d = 0; d < 4; ++d)
#pragma unroll
            for (int pq = 0; pq < 2; ++pq) { u32x2 w[2];
#pragma unroll
                for (int e = 0; e < 2; ++e) { const int gq = 2 * pq + e; const f32x4 gg = *(const f32x4*)(gsub + 32 * d + 8 * gq + 4 * hi);
                    w[e].x = pg8::cvt_pk_bf16(o[d][4 * gq] * rstd * gg[0], o[d][4 * gq + 1] * rstd * gg[1]); w[e].y = pg8::cvt_pk_bf16(o[d][4 * gq + 2] * rstd * gg[2], o[d][4 * gq + 3] * rstd * gg[3]); }
                auto rx = __builtin_amdgcn_permlane32_swap(w[0].x, w[1].x, false, false); auto ry = __builtin_amdgcn_permlane32_swap(w[0].y, w[1].y, false, false);
                *(u32x4*)(dst + 32 * d + 16 * pq) = (u32x4){rx[0], ry[0], rx[1], ry[1]}; }
    }
    ATT_WAIT_BAR();
#undef ATT_DMA_K
#undef ATT_DMA_V
}
template <int MODE> __device__ __forceinline__ void attn_phase(LAS unsigned char* lds, const bf16* PROJ, const bf16* KVP, const unsigned* KN, bf16* AB, const float* gsub, const float* lq1, const float* lk1, const float* lq2, const float* lk2, int vcu, int G, int tid, unsigned* aq = nullptr) {
    const int lane = tid & 63;
    const float lam = __expf(wave_sum(lq1[lane] * lk1[lane])) - __expf(wave_sum(lq2[lane] * lk2[lane])) + LAM_INIT;
    auto bound = [&](int bh) { float dq2 = 0.f;
#pragma unroll
        for (int mp = 0; mp < 2; ++mp) { const float kn = __uint_as_float(__hip_atomic_load(KN + bh * 2 + mp, __ATOMIC_RELAXED, __HIP_MEMORY_SCOPE_AGENT)), qn = __uint_as_float(__hip_atomic_load(KN + 64 + bh * 2 + mp, __ATOMIC_RELAXED, __HIP_MEMORY_SCOPE_AGENT));
            dq2 = fmaxf(dq2, 2.f * __builtin_sqrtf(2.f * qn) * __builtin_sqrtf(2.f * kn) * 1.0001f); }
        return dq2; };
    LAS int* slot = (LAS int*)(lds + 131072 + 768);
    for (int v = vcu; v < 256; v += G) {
        const int b = v >> 5, w = v & 31;
        for (int it = 0;; ++it) {
            int h, qb;
            if (aq) {
                if (tid == 0) *slot = (int)__hip_atomic_fetch_add(aq, 1u, __ATOMIC_RELAXED, __HIP_MEMORY_SCOPE_AGENT);
                __syncthreads();
                const int u = __builtin_amdgcn_readfirstlane(*slot);
                if (u >= 256) break;
                h = 3 - (u >> 6); qb = 63 - (u & 63);
            } else { if (it >= 8) break; h = (it & 1) ? 3 - (it >> 1) : (it >> 1); qb = (it & 4) ? 63 - w : w; }
            const int bh = b * 4 + h;
            attn_unit<MODE>(lds, PROJ, KVP, AB, gsub, lam, bh, qb, bound(bh), tid);
        }
    }
}
}

constexpr int NWAVES = 8;
constexpr int RING_OFF = 0, RING_BYTES = 131072;
constexpr int LDSCTL_OFF = RING_BYTES, MISC_OFF = LDSCTL_OFF + 320;
constexpr int LDS_BYTES = 159744;
constexpr size_t CTL_ZERO_BYTES = 1 * MiB;
constexpr int CW_BAR = 4096;
constexpr int CW_AQ = 2048;
constexpr int CW_MIS = 1024;
constexpr int CW_KN = 32768;
constexpr int N_PHASES = 10;
constexpr int HALO_OFF = RING_BYTES + 1024;
constexpr int MAX_LAUNCH = 4;
static_assert((CW_BAR + MAX_LAUNCH * XCD_BAR_WORDS) * 4 <= (int)CTL_ZERO_BYTES, "barrier words inside the memset region");
static_assert(HALO_OFF + 2048 + 2 * 4096 + 16384 <= LDS_BYTES, "halo + conv weight tables + rstd partials inside the LDS allocation");

struct Frame {
    LAS unsigned char* lds; volatile LAS unsigned* MISC; gu32* ctl;
    int tid, lane, wave, vcu, G;
};

__device__ __forceinline__ void p0_transpose_item(const float* W, int K, int N, bf16* WT, const float* rs, int mode, LAS float* scr, int item, int lane) {
    const int nblk = N / 32, kb = item / nblk, nb = item % nblk, k0 = 64 * kb, n0 = 32 * nb, s0 = wt_src_col(n0, mode);
#pragma unroll
    for (int i = 0; i < 8; ++i) { const int kk = 8 * i + (lane >> 3), c4 = (lane & 7) * 4; const float s = rs ? rs[k0 + kk] : 1.f;
        const f32x4 v = *(const f32x4*)(W + (size_t)(k0 + kk) * N + s0 + c4) * s; LAS float* d = scr + kk * 33 + c4; d[0] = v.x; d[1] = v.y; d[2] = v.z; d[3] = v.w; }
    LDS_WAIT(); asm volatile("" ::: "memory");
    const int c = lane & 7;
#pragma unroll
    for (int j = 0; j < 4; ++j) { const int n = (lane >> 3) + 8 * j; const LAS float* s = scr + (8 * c) * 33 + n;
        u32x4 o; o.x = pk2(s[0 * 33], s[1 * 33]); o.y = pk2(s[2 * 33], s[3 * 33]); o.z = pk2(s[4 * 33], s[5 * 33]); o.w = pk2(s[6 * 33], s[7 * 33]);
        *(u32x4*)(WT + (size_t)(n0 + n) * K + k0 + 8 * c) = o; }
    LDS_WAIT(); asm volatile("" ::: "memory");
}
__device__ __forceinline__ void rms_row_to_bf16(const float* xrow, const float* g, bf16* orow, int lane) {
    const f32x4* xr = (const f32x4*)xrow + lane; f32x4 v[4]; float s = 0.f;
#pragma unroll
    for (int j = 0; j < 4; ++j) { v[j] = xr[64 * j]; s += (v[j].x * v[j].x + v[j].y * v[j].y) + (v[j].z * v[j].z + v[j].w * v[j].w); }
    const float rstd = rsqrtf(wave_sum(s) * (1.f / DM) + NORM_EPS);
    u32x2* o = (u32x2*)orow + lane;
#pragma unroll
    for (int j = 0; j < 4; ++j) { const f32x4 gg = ((const f32x4*)g)[lane + 64 * j];
        u32x2 w; w.x = pk2(v[j].x * rstd * gg.x, v[j].y * rstd * gg.y); w.y = pk2(v[j].z * rstd * gg.z, v[j].w * rstd * gg.w); o[64 * j] = w; }
}

struct Args { const float* in[17]; float* out; unsigned char* ws; int ph_lo, ph_hi, li, opt; };

__global__ void __launch_bounds__(NWAVES * 64, 2) mk_fwd(Args args) {
    extern __shared__ __attribute__((aligned(16))) unsigned char lds[];
    Frame F;
    F.lds = (LAS unsigned char*)lds; F.MISC = (volatile LAS unsigned*)(F.lds + MISC_OFF);
    F.tid = threadIdx.x; F.lane = F.tid & 63; F.wave = __builtin_amdgcn_readfirstlane(F.tid >> 6);
    F.G = gridDim.x; { const int bx = blockIdx.x; F.vcu = (F.G % 8 == 0) ? (bx % 8) * (F.G / 8) + bx / 8 : bx; }
    unsigned char* ws = args.ws;
    F.ctl = (gu32*)(ws + WS_CTL);
    const float* x = args.in[0]; const float* g_mix = args.in[1]; const float* w_in = args.in[2];
    const float* w_dp = args.in[8]; const float* w_rp = args.in[9]; const float* w_out = args.in[10];
    const float* g_ffn = args.in[11]; const float* w_up = args.in[12]; const float* conv_w = args.in[13]; const float* conv_b = args.in[14];
    const float* w_down = args.in[15]; const float* g_final = args.in[16];
    float* out = args.out;
    bf16* WIN = (bf16*)(ws + WS_WIN); bf16* WD = (bf16*)(ws + WS_WD); bf16* WR = (bf16*)(ws + WS_WR); bf16* WO = (bf16*)(ws + WS_WO); bf16* WUP = (bf16*)(ws + WS_WUP); bf16* WDN = (bf16*)(ws + WS_WDN);
    bf16* XN = (bf16*)(ws + WS_XN); bf16* PROJ = (bf16*)(ws + WS_PROJ); bf16* AB = (bf16*)(ws + WS_A); bf16* RB = (bf16*)(ws + WS_R);
    bf16* X1B = (bf16*)(ws + WS_X1B); bf16* GB = (bf16*)(ws + WS_G); bf16* UB = (bf16*)(ws + WS_U); float* SSQ1 = (float*)(ws + WS_SSQ1);
    bf16* KVP = (bf16*)(ws + WS_KVP); bf16* MG = XN; bf16* X2B = XN; float* SSQ2 = (float*)(ws + WS_SSQ2); float* GST = (float*)(ws + WS_GST); float* HB = (float*)(ws + WS_HB);
    for (int u = F.tid; u < (LDS_BYTES - LDSCTL_OFF) / 4; u += NWAVES * 64) ((LAS unsigned*)(F.lds + LDSCTL_OFF))[u] = 0u;
    __syncthreads();
    XcdBarrier bar = xcd_barrier_post((unsigned*)(F.ctl + CW_BAR) + args.li * XCD_BAR_WORDS, F.MISC + 8, F.wave);
    const int lo = args.ph_lo, hi = args.ph_hi;
    if (F.tid == 0 && (bar.x != (blockIdx.x & 7u) || F.G != 256)) atomicOr((unsigned*)(F.ctl + CW_MIS + 64 * args.li), 1u);
    bool local_ok = false;
#define IN(k) (lo <= (k) && (k) < hi)
#define SEAM(k) do { if (IN(k) && IN((k) + 1)) { if (local_ok && (k) != 0 && (k) != 4) xcd_barrier_local(bar); else xcd_barrier(bar); } } while (0)

    if (IN(0)) {
        LAS float* scr = (LAS float*)(F.lds + RING_OFF + F.wave * 16384);
        const int gw = F.vcu * NWAVES + F.wave, NGW = F.G * NWAVES;
        constexpr int I_IN = (DM / 64) * (DIN / 32), I_D = (512 / 64) * (DM / 32), I_O = (DM / 64) * (DM / 32), I_UP = (DM / 64) * (FF2 / 32), I_DN = (FF / 64) * (DM / 32);
        constexpr int NITEMS = I_IN + 2 * I_D + I_O + I_UP + I_DN;
        for (int it = gw; it < NITEMS; it += NGW) {
            int r = it;
            if (r < I_IN) { p0_transpose_item(w_in, DM, DIN, WIN, nullptr, 0, scr, r, F.lane); continue; } r -= I_IN;
            if (r < I_D) { p0_transpose_item(w_dp, 512, DM, WD, nullptr, 0, scr, r, F.lane); continue; } r -= I_D;
            if (r < I_D) { p0_transpose_item(w_rp, 512, DM, WR, nullptr, 0, scr, r, F.lane); continue; } r -= I_D;
            if (r < I_O) { p0_transpose_item(w_out, DM, DM, WO, nullptr, 0, scr, r, F.lane); continue; } r -= I_O;
            if (r < I_UP) { p0_transpose_item(w_up, DM, FF2, WUP, g_ffn, 1, scr, r, F.lane); continue; } r -= I_UP;
            p0_transpose_item(w_down, FF, DM, WDN, nullptr, 0, scr, r, F.lane);
        }
        { float* cs = (float*)(ws + WS_CONV);
          for (int i = (int)blockIdx.x * (NWAVES * 64) + F.tid; i < 4 * FF2; i += F.G * (NWAVES * 64)) { const int row = i / FF2, c = i % FF2;
              cs[i] = ((row < 3) ? conv_w[i] : conv_b[c]) * ((c < FF) ? -LOG2E : -1.f / LOG2E); } }
        for (int m = gw; m < M; m += 2 * NGW) {
            const f32x4* xa = (const f32x4*)(x + (size_t)m * DM) + 2 * F.lane; const int m2 = (m + NGW < M) ? m + NGW : m; const f32x4* xb = (const f32x4*)(x + (size_t)m2 * DM) + 2 * F.lane;
            f32x4 va[4], vb[4]; float sa = 0.f, sb = 0.f;
#pragma unroll
            for (int j = 0; j < 2; ++j) { va[2 * j] = xa[128 * j]; va[2 * j + 1] = xa[128 * j + 1]; vb[2 * j] = xb[128 * j]; vb[2 * j + 1] = xb[128 * j + 1]; }
#pragma unroll
            for (int j = 0; j < 4; ++j) { sa += (va[j].x * va[j].x + va[j].y * va[j].y) + (va[j].z * va[j].z + va[j].w * va[j].w); sb += (vb[j].x * vb[j].x + vb[j].y * vb[j].y) + (vb[j].z * vb[j].z + vb[j].w * vb[j].w); }
            const float ra = rsqrtf(wave_sum(sa) * (1.f / DM) + NORM_EPS), rb = rsqrtf(wave_sum(sb) * (1.f / DM) + NORM_EPS);
            u32x4* oa = (u32x4*)(XN + (size_t)m * DM) + F.lane; u32x4* ob = (u32x4*)(XN + (size_t)m2 * DM) + F.lane;
#pragma unroll
            for (int j = 0; j < 2; ++j) { const f32x4 g0 = ((const f32x4*)g_mix)[2 * F.lane + 128 * j], g1 = ((const f32x4*)g_mix)[2 * F.lane + 128 * j + 1];
                u32x4 w; w.x = pk2(va[2 * j].x * ra * g0.x, va[2 * j].y * ra * g0.y); w.y = pk2(va[2 * j].z * ra * g0.z, va[2 * j].w * ra * g0.w);
                w.z = pk2(va[2 * j + 1].x * ra * g1.x, va[2 * j + 1].y * ra * g1.y); w.w = pk2(va[2 * j + 1].z * ra * g1.z, va[2 * j + 1].w * ra * g1.w); oa[64 * j] = w;
                w.x = pk2(vb[2 * j].x * rb * g0.x, vb[2 * j].y * rb * g0.y); w.y = pk2(vb[2 * j].z * rb * g0.z, vb[2 * j].w * rb * g0.w);
                w.z = pk2(vb[2 * j + 1].x * rb * g1.x, vb[2 * j + 1].y * rb * g1.y); w.w = pk2(vb[2 * j + 1].z * rb * g1.z, vb[2 * j + 1].w * rb * g1.w); ob[64 * j] = w; }
        }
    }
    SEAM(0);
    if (lo == 0 && hi > 1) local_ok = __builtin_amdgcn_readfirstlane((int)xb_ld((unsigned*)(F.ctl + CW_MIS + 64 * args.li))) == 0;
    if (IN(1)) {
        pg8::Gemm g{XN, WIN, M, DIN, DM}; pg8::StaticOrder S; S.init(M, DIN, F.G, (int)blockIdx.x);
        pg8::EpiProj E{PROJ, KVP, (unsigned*)(F.ctl + CW_KN)};
        pg8::gemm_phase<pg8::EpiProj, pg8::StaticOrder, true, true>(F.lds + RING_OFF, g, S, E, F.wave);
    }
    SEAM(1);
    if (IN(2)) { if (!(args.opt & 1)) for (int ui = F.vcu; ui < 256; ui += F.G) ret::ret_group_state(F.lds + RING_OFF, PROJ, GST, ui, F.tid); }
    SEAM(2);
    if (IN(3)) { const int tidL = F.wave * 64 + lane_now();
        if (!(args.opt & 1)) for (int ui = F.vcu; ui < 256; ui += F.G) ret::ret_outputs(F.lds + RING_OFF, PROJ, GST, RB, ui ^ 7, tidL);
        if (!(args.opt & 2)) attn::attn_phase<0>(F.lds + RING_OFF, PROJ, KVP, (const unsigned*)(F.ctl + CW_KN), AB, args.in[7], args.in[3], args.in[4], args.in[5], args.in[6], F.vcu, F.G, tidL, (F.G == 256) ? (unsigned*)(F.ctl + CW_AQ + 64 * (8 * args.li + (int)(blockIdx.x & 7))) : nullptr);
#ifdef PROBE_MODE
        if (args.opt & 4) attn::attn_phase<PROBE_MODE>(F.lds + RING_OFF, PROJ, KVP, (const unsigned*)(F.ctl + CW_KN), XN, args.in[7], args.in[3], args.in[4], args.in[5], args.in[6], F.vcu, F.G, tidL);
#endif
    }
    SEAM(3);
    if (IN(4)) {
        pg8::Gemm g{AB, WD, M, DM, 512, RB, WR}; pg8::DualOrder S; S.init(M, DM, F.G, (int)blockIdx.x);
        pg8::EpiMerge2 E{PROJ, MG};
        pg8::gemm_phase<pg8::EpiMerge2, pg8::DualOrder, true, true>(F.lds + RING_OFF, g, S, E, F.wave);
    }
    SEAM(4);
    if (IN(5)) {
        pg8::Gemm g{MG, WO, M, DM, DM}; pg8::StaticOrder S; S.init(M, DM, F.G, (int)blockIdx.x);
        pg8::EpiOutProj E{x, X1B, SSQ1};
        pg8::gemm_phase<pg8::EpiOutProj, pg8::StaticOrder, true, true>(F.lds + RING_OFF, g, S, E, F.wave);
    }
    SEAM(5);
    if (IN(6)) {
        pg8::Gemm g{X1B, WUP, M, FF2, DM}; pg8::StaticOrder S; S.init(M, FF2, F.G, (int)blockIdx.x);
        pg8::EpiUpConv E{SSQ1, GB, HB, (const float*)(ws + WS_CONV), (const float*)(ws + WS_CONV) + 3 * FF2, (LAS float*)(F.lds + HALO_OFF)};
        pg8::gemm_phase<pg8::EpiUpConv, pg8::StaticOrder, true, true>(F.lds + RING_OFF, g, S, E, F.wave);
    }
    SEAM(6);
    if (IN(7)) {
        const bool gp = (F.G == 256);
        const int nw = gp ? 32 : F.G, w = gp ? (int)(blockIdx.x >> 3) : (int)blockIdx.x, pm0 = gp ? (int)(blockIdx.x & 7) * 32 : 0, npm = gp ? 32 : M / 256;
        const int nit = npm * (FF / 4);
        const int tidL = F.wave * 64 + lane_now();
        for (int it = w * (NWAVES * 64) + tidL; it < nit; it += nw * (NWAVES * 64)) {
            const int pm = pm0 + it / (FF / 4), gc = (it % (FF / 4)) * 4;
            if ((pm & 31) == 0) continue;
            const int uc = (gc >> 7) * 256 + (gc & 127);
            const float* h0 = HB + (size_t)(pm - 1) * 4 * FF2, * h1 = HB + (size_t)pm * 4 * FF2;
            const f32x4 gm2 = *(const f32x4*)(h0 + 2 * FF2 + uc), gm1 = *(const f32x4*)(h0 + 3 * FF2 + uc), g0 = *(const f32x4*)(h1 + uc), g1 = *(const f32x4*)(h1 + FF2 + uc);
            const f32x4 um2 = *(const f32x4*)(h0 + 2 * FF2 + uc + 128), um1 = *(const f32x4*)(h0 + 3 * FF2 + uc + 128), u0 = *(const f32x4*)(h1 + uc + 128), u1 = *(const f32x4*)(h1 + FF2 + uc + 128);
            f32x4 wg[3], wu[3];
            const float* cs = (const float*)(ws + WS_CONV);
#pragma unroll
            for (int k = 0; k < 3; ++k) { wg[k] = *(const f32x4*)(cs + k * FF2 + gc); wu[k] = *(const f32x4*)(cs + k * FF2 + FF + gc); }
            const f32x4 bg = *(const f32x4*)(cs + 3 * FF2 + gc), bu = *(const f32x4*)(cs + 3 * FF2 + FF + gc);
            const f32x4 zg0 = bg + wg[2] * g0 + wg[1] * gm1 + wg[0] * gm2, zu0 = bu + wu[2] * u0 + wu[1] * um1 + wu[0] * um2;
            const f32x4 zg1 = bg + wg[2] * g1 + wg[1] * g0 + wg[0] * gm1, zu1 = bu + wu[2] * u1 + wu[1] * u0 + wu[0] * um1;
            f32x4 r0, r1;
#pragma unroll
            for (int i = 0; i < 4; ++i) { r0[i] = (zg0[i] * zu0[i]) * __builtin_amdgcn_rcpf(1.f + __builtin_amdgcn_exp2f(zg0[i])); r1[i] = (zg1[i] * zu1[i]) * __builtin_amdgcn_rcpf(1.f + __builtin_amdgcn_exp2f(zg1[i])); }
            u32x2 w0, w1; w0.x = pg8::cvt_pk_bf16(r0[0], r0[1]); w0.y = pg8::cvt_pk_bf16(r0[2], r0[3]); w1.x = pg8::cvt_pk_bf16(r1[0], r1[1]); w1.y = pg8::cvt_pk_bf16(r1[2], r1[3]);
            *(u32x2*)(GB + (size_t)pm * 256 * FF + gc) = w0; *(u32x2*)(GB + ((size_t)pm * 256 + 1) * FF + gc) = w1;
        }
    }
    SEAM(7);
    if (IN(8)) {
        pg8::Gemm g{GB, WDN, M, DM, FF}; pg8::StaticOrder S; S.init(M, DM, F.G, (int)blockIdx.x);
        pg8::EpiDown E{X1B, X2B, SSQ2};
        pg8::gemm_phase<pg8::EpiDown, pg8::StaticOrder, true, true>(F.lds + RING_OFF, g, S, E, F.wave);
    }
    SEAM(8);
    if (IN(9)) {
        const int laneL = lane_now();
        const bool gp = (F.G == 256);
        const int gw = (gp ? (int)(blockIdx.x >> 3) : F.vcu) * NWAVES + F.wave, NGW = (gp ? 32 : F.G) * NWAVES, m0 = gp ? (int)(blockIdx.x & 7) * 8192 : 0, nm = gp ? 8192 : M;
        for (int mm = gw; mm < nm; mm += 4 * NGW) {
            u32x4 xv[4][2]; float sq[4];
#pragma unroll
            for (int r = 0; r < 4; ++r) { const int m = m0 + ((mm + r * NGW < nm) ? mm + r * NGW : mm); const u32x4* xr = (const u32x4*)(X2B + (size_t)m * DM) + laneL;
                xv[r][0] = xr[0]; xv[r][1] = xr[64]; sq[r] = (laneL < 16) ? SSQ2[(size_t)m * 16 + laneL] : 0.f; }
#pragma unroll
            for (int r = 0; r < 4; ++r) { const int m = m0 + ((mm + r * NGW < nm) ? mm + r * NGW : mm); float q = sq[r];
                q += __shfl_xor(q, 1); q += __shfl_xor(q, 2); q += __shfl_xor(q, 4); q += __shfl_xor(q, 8);
                const float rstd = rsqrtf(__shfl(q, 0) * (1.f / DM) + NORM_EPS);
                f32x4* orow = (f32x4*)(out + (size_t)m * DM) + 2 * laneL;
#pragma unroll
                for (int j = 0; j < 2; ++j) { f32x4 a, b; pg8::unpack8(xv[r][j], a, b);
                    const f32x4 g0 = ((const f32x4*)g_final)[2 * laneL + 128 * j], g1 = ((const f32x4*)g_final)[2 * laneL + 128 * j + 1];
                    orow[128 * j] = a * rstd * g0; orow[128 * j + 1] = b * rstd * g1; } }
        }
    }
#undef IN
#undef SEAM
}

static void launch_mk(Args a, int lo, int hi, int li, int grid, hipStream_t stream, int opt = 0) {
    a.ph_lo = lo; a.ph_hi = hi; a.li = li; a.opt = opt;
    hipLaunchKernelGGL(mk_fwd, dim3(grid), dim3(NWAVES * 64), LDS_BYTES, stream, a);
}
extern "C" void kernel_launch(void* const* d_in, const int* in_sizes, int n_in, void* d_out, int out_size, void* d_ws, size_t ws_size, hipStream_t stream) {
    static int grid = 0;
    if (grid == 0) {
        if (n_in != 17 || out_size != M * DM || ws_size < WS_END) { fprintf(stderr, "kernel_launch: unexpected shapes (n_in %d out %d ws %zu)\n", n_in, out_size, ws_size); grid = -1; return; }
        int dev = 0, cus = 0, per_cu = 0;
        if (hipGetDevice(&dev) != hipSuccess || hipDeviceGetAttribute(&cus, hipDeviceAttributeMultiprocessorCount, dev) != hipSuccess) { grid = -1; return; }
        if (hipFuncSetAttribute((const void*)mk_fwd, hipFuncAttributeMaxDynamicSharedMemorySize, LDS_BYTES) != hipSuccess) { fprintf(stderr, "kernel_launch: hipFuncSetAttribute failed\n"); grid = -1; return; }
        if (hipOccupancyMaxActiveBlocksPerMultiprocessor(&per_cu, (const void*)mk_fwd, NWAVES * 64, LDS_BYTES) != hipSuccess || per_cu < 1) { fprintf(stderr, "kernel_launch: occupancy query says %d\n", per_cu); }
        (void)hipGetLastError();
        grid = cus;
    }
    if (grid < 0) return;
    if (hipMemsetAsync((char*)d_ws + WS_CTL, 0, CTL_ZERO_BYTES, stream) != hipSuccess) return;
    unsigned char* ws = (unsigned char*)d_ws;
    Args a{};
    for (int i = 0; i < 17; ++i) a.in[i] = (const float*)d_in[i];
    a.out = (float*)d_out; a.ws = ws;
    launch_mk(a, 0, N_PHASES, 0, grid, stream);
}
```

```cpp
#include <hip/hip_runtime.h>
#include <cstdio>
#include <cstdint>
#include <cmath>

typedef unsigned short bf16;
typedef short bf16x8 __attribute__((ext_vector_type(8)));
typedef float f32x4 __attribute__((ext_vector_type(4)));
typedef float f32x16 __attribute__((ext_vector_type(16)));
typedef unsigned u32x4 __attribute__((ext_vector_type(4)));
typedef unsigned u32x2 __attribute__((ext_vector_type(2)));

constexpr int BATCH = 8, SEQ = 8192, DM = 1024, M = BATCH * SEQ;
constexpr int NH = 4, HD = 64, DV = 128;
constexpr int DIN = 5120, PP = 4096;
constexpr int FF = 2816, FF2 = 5632;
constexpr int C_Q1 = 0, C_Q2 = 256, C_QR = 512, C_KR = 768, C_VR = 1024, C_GR = 1536, C_GA = 2048, C_GB = 3072;
constexpr float LOG2E = 1.4426950408889634f;
constexpr float C2 = 0.125f * LOG2E;
constexpr float NORM_EPS = 1e-6f, SUBLN_EPS = 1e-5f;
constexpr float LAM_INIT = 0.2f;

constexpr size_t MiB = 1u << 20;
constexpr size_t WS_CTL = 0;
constexpr size_t WS_CONV = 512 * 1024;
constexpr size_t WS_SSQ1 = 2 * MiB;
constexpr size_t WS_SSQ2 = 6 * MiB;
constexpr size_t WS_GST = 10 * MiB;
constexpr size_t WS_WIN = 20 * MiB, WS_WD = 30 * MiB, WS_WR = 31 * MiB, WS_WO = 32 * MiB, WS_WUP = 34 * MiB, WS_WDN = 45 * MiB;
constexpr size_t WS_XN = 64 * MiB;
constexpr size_t WS_PROJ = 192 * MiB;
constexpr size_t WS_KVP = 704 * MiB;
constexpr size_t WS_A = 864 * MiB, WS_R = 928 * MiB;
constexpr size_t WS_X1B = 192 * MiB;
constexpr size_t WS_G = 320 * MiB;
constexpr size_t WS_U = 672 * MiB;
constexpr size_t WS_HB = 672 * MiB;
constexpr size_t WS_END = 1024 * MiB;

__device__ __forceinline__ unsigned f2bf(float f) { unsigned u = __builtin_bit_cast(unsigned, f); return (u + 0x7fffu + ((u >> 16) & 1u)) >> 16; }
__device__ __forceinline__ unsigned pk2(float lo, float hi) { return f2bf(lo) | (f2bf(hi) << 16); }
__device__ __forceinline__ float bf2f(unsigned short b) { return __builtin_bit_cast(float, (unsigned)b << 16); }
__device__ __forceinline__ float bflo(unsigned w) { return __builtin_bit_cast(float, w << 16); }
__device__ __forceinline__ float bfhi(unsigned w) { return __builtin_bit_cast(float, w & 0xffff0000u); }
__device__ __forceinline__ float wave_sum(float v) {
#pragma unroll
    for (int o = 1; o < 64; o <<= 1) v += __shfl_xor(v, o);
    return v;
}
__device__ __forceinline__ float wave_max(float v) {
#pragma unroll
    for (int o = 1; o < 64; o <<= 1) v = fmaxf(v, __shfl_xor(v, o));
    return v;
}
__device__ __forceinline__ float sigmoidf_(float x) { return 1.f / (1.f + __expf(-x)); }
__device__ __forceinline__ float siluf_(float x) { return x / (1.f + __expf(-x)); }
__device__ __forceinline__ float alibi_sl2(int h) { return h == 0 ? 0.36067376022224085f : h == 1 ? 0.09016844005556021f : h == 2 ? 0.022542110013890053f : 0.005635527503472513f; }
__device__ __forceinline__ float ret_lg2(int h) { return h == 0 ? -0.04580368961312479f : h == 1 ? -0.02272007650008353f : h == 2 ? -0.011315313227834146f : -0.005646563141142063f; }

__device__ __forceinline__ int wt_src_col(int n, int mode) {
    if (mode == 0) return n;
    const int t = n >> 8, w = n & 255;
    return (w < 128) ? (t * 128 + w) : (FF + t * 128 + (w - 128));
}
__device__ __forceinline__ int lane_now() { int l; asm volatile("v_mbcnt_lo_u32_b32 %0, -1, 0\n\tv_mbcnt_hi_u32_b32 %0, -1, %0" : "=v"(l)); return l; }
namespace pg8 {
#define PG8_LAS __attribute__((address_space(3)))
typedef unsigned short bf16_t;
typedef short bf16x8 __attribute__((ext_vector_type(8)));
typedef float f32x4 __attribute__((ext_vector_type(4)));
typedef unsigned u32x4 __attribute__((ext_vector_type(4)));
constexpr int BM = 256, BK = 64, HALF = 128, HTB = HALF * BK * 2  , STAGE_BYTES = 8 * HTB, NXCD = 8, WGM = 8;

__host__ __device__ __forceinline__ int lds_byte(int r, int c) { const int st = (r >> 4) * 2 + (c >> 5), rr = r & 15, cc = c & 31, ob = rr * 64 + cc * 2; return st * 1024 + (ob ^ (((ob >> 9) & 1) << 5)); }
__host__ __device__ __forceinline__ void stage_rc(int b, int& R, int& C) { const int st = b / 1024, sb = b % 1024, swz = sb ^ (((sb >> 9) & 1) << 5); R = (st >> 1) * 16 + swz / 64; C = (st & 1) * 32 + (swz % 64) / 2; }
__host__ __device__ __forceinline__ int perm32(int rho) { const int n = rho >> 4, i = rho & 15; return 8 * (i >> 2) + 4 * n + (i & 3); }

struct Unit { int pm, pn, seg; };
struct Gemm { const bf16_t* A; const bf16_t* Bt; int M, N, K; const bf16_t* A2; const bf16_t* Bt2; };

struct StaticOrder {
    int nM, nN, nwg, G, c;
    __host__ __device__ void init(int M, int N, int G_, int c_) { nM = M / BM; nN = N / BM; nwg = nM * nN; G = G_; c = c_; }
    __host__ __device__ bool next(int i, Unit& u) const {
        const long L = (long)i * G + c; if (L >= nwg) return false;
        int wgid = (int)L; { const int q = nwg / NXCD, r = nwg % NXCD, xcd = wgid % NXCD, off = wgid / NXCD; wgid = (xcd < r ? xcd * (q + 1) : r * (q + 1) + (xcd - r) * q) + off; }
        const int nig = WGM * nN, gid = wgid / nig, fm = gid * WGM, gsz = (nM - fm) < WGM ? (nM - fm) : WGM;
        u.pm = fm + ((wgid % nig) % gsz); u.pn = (wgid % nig) / gsz; u.seg = 0; return true;
    }
    __device__ __forceinline__ void a_ready(const Unit&) const {}
    __device__ __forceinline__ void done(const Unit&) const {}
};

struct DualOrder {
    StaticOrder S;
    __host__ __device__ void init(int M, int N, int G_, int c_) { S.init(M, N, G_, c_); }
    __host__ __device__ bool next(int i, Unit& u) const { if (!S.next(i >> 1, u)) return false; u.seg = i & 1; return true; }
    __device__ __forceinline__ void a_ready(const Unit&) const {}
    __device__ __forceinline__ void done(const Unit&) const {}
};

typedef float f32x2 __attribute__((ext_vector_type(2))); typedef __bf16 bf16x2_t __attribute__((ext_vector_type(2)));
__device__ __forceinline__ unsigned cvt_pk_bf16(float lo, float hi) { f32x2 v = {lo, hi}; bf16x2_t b = __builtin_convertvector(v, bf16x2_t); return __builtin_bit_cast(unsigned, b); }
__device__ __forceinline__ float fast_sigmoid(float x) { return __builtin_amdgcn_rcpf(1.f + __builtin_amdgcn_exp2f(-1.4426950408889634f * x)); }
__device__ __forceinline__ u32x4 pack8(const f32x4 a, const f32x4 b) { u32x4 w; w.x = cvt_pk_bf16(a[0], a[1]); w.y = cvt_pk_bf16(a[2], a[3]); w.z = cvt_pk_bf16(b[0], b[1]); w.w = cvt_pk_bf16(b[2], b[3]); return w; }
__device__ __forceinline__ void unpack8(const u32x4 w, f32x4& a, f32x4& b) {
    a[0] = __builtin_bit_cast(float, w.x << 16); a[1] = __builtin_bit_cast(float, w.x & 0xffff0000u); a[2] = __builtin_bit_cast(float, w.y << 16); a[3] = __builtin_bit_cast(float, w.y & 0xffff0000u);
    b[0] = __builtin_bit_cast(float, w.z << 16); b[1] = __builtin_bit_cast(float, w.z & 0xffff0000u); b[2] = __builtin_bit_cast(float, w.w << 16); b[3] = __builtin_bit_cast(float, w.w & 0xffff0000u); }

__device__ __forceinline__ unsigned sig4_u8(const f32x4 v) { unsigned w = 0u;
#pragma unroll
    for (int i = 0; i < 4; ++i) { const float e = __builtin_amdgcn_exp2f(-1.4426950408889634f * v[i]); const unsigned q = (unsigned)(__builtin_amdgcn_rcpf(__builtin_fmaf(e, 1.f / 255.f, 1.f / 255.f)) + 0.5f); w |= q << (8 * i); }
    return w; }
__device__ __forceinline__ f32x4 u8x4_f32(const unsigned w) { return (f32x4){(float)(w & 255u), (float)((w >> 8) & 255u), (float)((w >> 16) & 255u), (float)(w >> 24)} * (1.f / 255.f); }
struct EpiProj {
    static constexpr bool PERM = true, AFTER_DRAIN = false, PERMA = false, PREFETCH = false, DUAL = false;
    bf16_t* P; bf16_t* KV; unsigned* KN;
    __device__ __forceinline__ void operator()(const f32x4 (&acc)[2][2][4][2], const Unit& u, int wr, int wc, int fr, int fq) const {
        const int pn = u.pn, pm = u.pm;
        if (pn >= 2 && pn < 6) {
            const size_t tile0 = ((size_t)(pm >> 5) * 4 * 128 + (size_t)((pm & 31) * 4 + wr)) * 16384;
            if (pn < 4) {
#pragma unroll
                for (int bj = 0; bj < 2; ++bj) { bf16_t* hb = KV + tile0 + (size_t)(2 * bj + (wc >> 1)) * 128 * 16384 + (pn == 3 ? 4096 : 0) + ((wc & 1) * 4 + fq) * 512 + fr * 8;
#pragma unroll
                    for (int ai = 0; ai < 2; ++ai)
#pragma unroll
                        for (int m = 0; m < 4; ++m) *(u32x4*)(hb + (size_t)ai * 2 * 16384 + m * 128) = pack8(acc[ai][bj][m][0], acc[ai][bj][m][1]); }
#pragma unroll
                for (int bj = 0; bj < 2; ++bj) { float hm = 0.f;
#pragma unroll
                    for (int ai = 0; ai < 2; ++ai)
#pragma unroll
                        for (int m = 0; m < 4; ++m) { const f32x4 a = acc[ai][bj][m][0], b = acc[ai][bj][m][1];
                            float q = (a[0] * a[0] + a[1] * a[1]) + (a[2] * a[2] + a[3] * a[3]) + (b[0] * b[0] + b[1] * b[1]) + (b[2] * b[2] + b[3] * b[3]);
                            q += __shfl_xor(q, 16); q += __shfl_xor(q, 32); hm = fmaxf(hm, q); }
                    hm = fmaxf(hm, __shfl_xor(hm, 1)); hm = fmaxf(hm, __shfl_xor(hm, 2)); hm = fmaxf(hm, __shfl_xor(hm, 4)); hm = fmaxf(hm, __shfl_xor(hm, 8));
                    if (fr == 0 && fq == 0) atomicMax(KN + ((pm >> 5) * 4 + 2 * bj + (wc >> 1)) * 2 + (pn - 2), __float_as_uint(hm * 1.01f)); }
            } else {
#pragma unroll
                for (int bj = 0; bj < 2; ++bj) { const int head = (pn - 4) * 2 + bj; const float sl = alibi_sl2(head);
                    bf16_t* hb = KV + tile0 + (size_t)head * 128 * 16384 + 8192 + wc * 2048 + fr * 32 + fq * 8;
#pragma unroll
                    for (int m = 0; m < 4; ++m) { const float sc = __builtin_amdgcn_exp2f(sl * (float)((fr + 16 * m) - 63));
#pragma unroll
                        for (int ai = 0; ai < 2; ++ai) *(u32x4*)(hb + (size_t)ai * 2 * 16384 + m * 512) = pack8(acc[ai][bj][m][0] * sc, acc[ai][bj][m][1] * sc); } }
            }
        } else {
            const int cpn = (pn < 2) ? pn : pn - 4;
            bf16_t* base = P + (size_t)(pm * BM + wr * 64 + fr) * PP + cpn * BM + wc * 32 + 8 * fq;
            if (pn >= 12) {
                unsigned char* gq = (unsigned char*)(P + (size_t)(pm * BM + wr * 64 + fr) * PP + C_GA) + (pn - 12) * 256 + wc * 64 + fq * 16;
#pragma unroll
                for (int ai = 0; ai < 2; ++ai)
#pragma unroll
                    for (int m = 0; m < 4; ++m) { u32x4 w; w.x = sig4_u8(acc[ai][0][m][0]); w.y = sig4_u8(acc[ai][0][m][1]); w.z = sig4_u8(acc[ai][1][m][0]); w.w = sig4_u8(acc[ai][1][m][1]);
                        *(u32x4*)(gq + (size_t)(ai * HALF + m * 16) * (PP * 2)) = w; }
            } else if (pn >= 10) {
#pragma unroll
                for (int ai = 0; ai < 2; ++ai)
#pragma unroll
                    for (int m = 0; m < 4; ++m)
#pragma unroll
                        for (int bj = 0; bj < 2; ++bj) { f32x4 a = acc[ai][bj][m][0], b = acc[ai][bj][m][1];
#pragma unroll
                            for (int i = 0; i < 4; ++i) { a[i] *= fast_sigmoid(a[i]); b[i] *= fast_sigmoid(b[i]); }
                            *(u32x4*)(base + (size_t)(ai * HALF + m * 16) * PP + bj * HALF) = pack8(a, b); }
            } else {
            const float sc = (pn < 2) ? C2 : (pn == 7) ? 0.125f : 1.f;
#pragma unroll
            for (int ai = 0; ai < 2; ++ai)
#pragma unroll
                for (int m = 0; m < 4; ++m)
#pragma unroll
                    for (int bj = 0; bj < 2; ++bj) *(u32x4*)(base + (size_t)(ai * HALF + m * 16) * PP + bj * HALF) = pack8(acc[ai][bj][m][0] * sc, acc[ai][bj][m][1] * sc);
            if (pn < 2) {
#pragma unroll
                for (int bj = 0; bj < 2; ++bj) { float hm = 0.f;
#pragma unroll
                    for (int ai = 0; ai < 2; ++ai)
#pragma unroll
                        for (int m = 0; m < 4; ++m) { const f32x4 a = acc[ai][bj][m][0], b = acc[ai][bj][m][1];
                            float q = (a[0] * a[0] + a[1] * a[1]) + (a[2] * a[2] + a[3] * a[3]) + (b[0] * b[0] + b[1] * b[1]) + (b[2] * b[2] + b[3] * b[3]);
                            q += __shfl_xor(q, 16); q += __shfl_xor(q, 32); hm = fmaxf(hm, q); }
                    hm = fmaxf(hm, __shfl_xor(hm, 1)); hm = fmaxf(hm, __shfl_xor(hm, 2)); hm = fmaxf(hm, __shfl_xor(hm, 4)); hm = fmaxf(hm, __shfl_xor(hm, 8));
                    if (fr == 0 && fq == 0) atomicMax(KN + 64 + ((pm >> 5) * 4 + 2 * bj + (wc >> 1)) * 2 + pn, __float_as_uint(hm * (C2 * C2) * 1.01f)); }
            }
            }
        }
    }
};
struct EpiMerge2 {
    static constexpr bool PERM = true, AFTER_DRAIN = false, PERMA = false, PREFETCH = false, DUAL = true;
    const bf16_t* P; bf16_t* MG;
    static __device__ __forceinline__ f32x4 u8f(const unsigned w) { return (f32x4){(float)(w & 255u), (float)((w >> 8) & 255u), (float)((w >> 16) & 255u), (float)(w >> 24)}; }
    static __device__ __forceinline__ f32x4 max1(const f32x4 v) { return (f32x4){fmaxf(v[0], 1.f), fmaxf(v[1], 1.f), fmaxf(v[2], 1.f), fmaxf(v[3], 1.f)}; }
    __device__ __forceinline__ void mid(f32x4 (&acc)[2][2][4][2], const Unit& u, int wr, int wc, int fr, int fq) const {
        const unsigned char* gq = (const unsigned char*)(P + (size_t)(u.pm * BM + wr * 64 + fr) * PP + C_GA) + u.pn * 256 + wc * 64 + fq * 16;
#pragma unroll
        for (int ai = 0; ai < 2; ++ai)
#pragma unroll
            for (int m = 0; m < 4; ++m) { const u32x4 wa = *(const u32x4*)(gq + (size_t)(ai * HALF + m * 16) * (PP * 2)), wq = *(const u32x4*)(gq + 1024 + (size_t)(ai * HALF + m * 16) * (PP * 2));
#pragma unroll
                for (int bj = 0; bj < 2; ++bj)
#pragma unroll
                    for (int n = 0; n < 2; ++n) { const unsigned da = bj ? (n ? wa.w : wa.z) : (n ? wa.y : wa.x), dr = bj ? (n ? wq.w : wq.z) : (n ? wq.y : wq.x);
                        const f32x4 qa = u8f(da), qr = max1(u8f(dr));
#pragma unroll
                        for (int i = 0; i < 4; ++i) acc[ai][bj][m][n][i] *= qa[i] * __builtin_amdgcn_rcpf(qr[i]); } }
    }
    __device__ __forceinline__ void operator()(const f32x4 (&acc)[2][2][4][2], const Unit& u, int wr, int wc, int fr, int fq) const {
        const int row0 = u.pm * BM + wr * 64 + fr, col0 = u.pn * BM + wc * 32 + 8 * fq;
        const unsigned char* gq = (const unsigned char*)(P + (size_t)row0 * PP + C_GA) + 1024 + u.pn * 256 + wc * 64 + fq * 16;
#pragma unroll
        for (int ai = 0; ai < 2; ++ai)
#pragma unroll
            for (int m = 0; m < 4; ++m) { const int row = row0 + ai * HALF + m * 16;
                const u32x4 wq = *(const u32x4*)(gq + (size_t)(ai * HALF + m * 16) * (PP * 2));
#pragma unroll
                for (int bj = 0; bj < 2; ++bj) { const f32x4 s0 = max1(u8f(bj ? wq.z : wq.x)) * (1.f / 255.f), s1 = max1(u8f(bj ? wq.w : wq.y)) * (1.f / 255.f);
                    *(u32x4*)(MG + (size_t)row * DM + col0 + bj * HALF) = pack8(acc[ai][bj][m][0] * s0, acc[ai][bj][m][1] * s1); } }
    }
};
__device__ __forceinline__ void store_ssq(float* SSQ, float a, float b, int row0, int slot, int fq) {
    const int ra = row0 + (fq >> 1) * HALF + (fq & 1) * 32;
    SSQ[(size_t)ra * 16 + slot] = a; SSQ[(size_t)(ra + 16) * 16 + slot] = b;
}
struct EpiOutProj {
    static constexpr bool PERM = true, AFTER_DRAIN = false, PERMA = false, PREFETCH = false, DUAL = false;
    const float* X; bf16_t* X1B; float* SSQ;
    __device__ __forceinline__ void operator()(const f32x4 (&acc)[2][2][4][2], const Unit& u, int wr, int wc, int fr, int fq) const {
        const int row0 = u.pm * BM + wr * 64 + fr, col0 = u.pn * BM + wc * 32 + 8 * fq;
        float sa = 0.f, sb = 0.f;
#pragma unroll
        for (int ai = 0; ai < 2; ++ai)
#pragma unroll
            for (int m = 0; m < 4; ++m) { const int row = row0 + ai * HALF + m * 16; float s = 0.f;
#pragma unroll
                for (int bj = 0; bj < 2; ++bj) { const size_t off = (size_t)row * DM + col0 + bj * HALF;
                    const f32x4 v0 = *(const f32x4*)(X + off) + acc[ai][bj][m][0], v1 = *(const f32x4*)(X + off + 4) + acc[ai][bj][m][1];
                    *(u32x4*)(X1B + off) = pack8(v0, v1);
                    s += (v0[0] * v0[0] + v0[1] * v0[1]) + (v0[2] * v0[2] + v0[3] * v0[3]) + (v1[0] * v1[0] + v1[1] * v1[1]) + (v1[2] * v1[2] + v1[3] * v1[3]); }
                s += __shfl_xor(s, 16); s += __shfl_xor(s, 32); if (((ai * 4 + m) >> 1) == fq) { if (m & 1) sb = s; else sa = s; } }
        store_ssq(SSQ, sa, sb, row0, u.pn * 4 + wc, fq);
    }
};
__device__ __forceinline__ float dpp_shr1(float x) { return __builtin_bit_cast(float, __builtin_amdgcn_update_dpp(0, __builtin_bit_cast(int, x), 0x111, 0xf, 0xf, true)); }
__device__ __forceinline__ f32x4 row_shr1(const f32x4 v) {
    const float a = v[0], b = v[1], c = v[2], d = v[3];
    return (f32x4){dpp_shr1(a), dpp_shr1(b), dpp_shr1(c), dpp_shr1(d)};
}
struct EpiUpConv {
    static constexpr bool PERM = true, AFTER_DRAIN = false, PERMA = true, PREFETCH = true, DUAL = false;
    const float* SSQ; bf16_t* G; float* HB; const float* cw; const float* cb; PG8_LAS float* halo;
    __device__ __forceinline__ void prefetch(const Unit& u, int ui, int wid, int lane) const {
        const int fr = lane & 15, fq = lane >> 4;
#pragma unroll
        for (int i = 0; i < 2; ++i) { const int k = 2 * wid + i;
            __builtin_amdgcn_global_load_lds((const unsigned*)(SSQ + (size_t)(u.pm * BM + (k >> 3) * 128 + fr * 8 + (k & 7)) * 16 + 4 * fq), (PG8_LAS unsigned*)(halo + 2560 + k * 256), 16, 0, 0); }
        const int w = wid & 3, row = 2 * w + (lane >> 5), c = (lane & 31) * 4, gcb = u.pn * HALF;
        const float* src = (row < 6) ? cw + (row >> 1) * FF2 + (row & 1) * FF + gcb + c : cb + (row & 1) * FF + gcb + c;
        __builtin_amdgcn_global_load_lds((const unsigned*)src, (PG8_LAS unsigned*)(halo + 512 + (ui & 1) * 1024 + w * 256), 16, 0, 0);
    }
    __device__ __forceinline__ void operator()(f32x4 (&acc)[2][2][4][2], const Unit& u, int wr, int wc, int fr, int fq, int ui) const {
        const int pn = u.pn, pm = u.pm, tok0 = pm * BM + wr * 128 + fr * 8, cl = wc * 32 + 8 * fq;
        const bool seq_start = (pm & 31) == 0;
        PG8_LAS float* wt = halo + 512 + (ui & 1) * 1024;
#pragma unroll
        for (int ai = 0; ai < 2; ++ai)
#pragma unroll
            for (int m = 0; m < 4; ++m) { const f32x4 a = *(const PG8_LAS f32x4*)(halo + 2560 + ((wr * 8 + 4 * ai + m) * 64 + fq * 16 + fr) * 4);
                float sq = (a[0] + a[1]) + (a[2] + a[3]); sq += __shfl_xor(sq, 16); sq += __shfl_xor(sq, 32);
                const float r = rsqrtf(sq * (1.f / DM) + NORM_EPS);
#pragma unroll
                for (int bj = 0; bj < 2; ++bj)
#pragma unroll
                    for (int n = 0; n < 2; ++n) acc[ai][bj][m][n] = acc[ai][bj][m][n] * r; }
        if (fr == 15) {
#pragma unroll
            for (int bj = 0; bj < 2; ++bj)
#pragma unroll
                for (int n = 0; n < 2; ++n)
#pragma unroll
                    for (int q = 0; q < 2; ++q) { const f32x4 v = acc[1][bj][2 + q][n];
                        if (wr == 0) *(PG8_LAS f32x4*)(halo + q * 256 + bj * HALF + cl + 4 * n) = v;
                        else *(f32x4*)(HB + ((size_t)pm * 4 + 2 + q) * FF2 + pn * BM + bj * HALF + cl + 4 * n) = v; }
        }
        if (fr == 0 && wr == 0) {
#pragma unroll
            for (int bj = 0; bj < 2; ++bj)
#pragma unroll
                for (int n = 0; n < 2; ++n)
#pragma unroll
                    for (int q = 0; q < 2; ++q) *(f32x4*)(HB + ((size_t)pm * 4 + q) * FF2 + pn * BM + bj * HALF + cl + 4 * n) = acc[0][bj][q][n];
        }
        asm volatile("s_waitcnt lgkmcnt(0)\n\ts_barrier" ::: "memory");
        const int gc = pn * HALF + cl;
        const float hk = (wr == 1 && fr == 0) ? 1.f : 0.f;
#pragma unroll
        for (int jh = 0; jh < 2; ++jh) {
            u32x2 gpk[4];
#pragma unroll
            for (int n = 0; n < 2; ++n) {
                f32x4 g6 = {}, g7 = {}, u6 = {}, u7 = {};
                if (jh == 0) {
                    g6 = row_shr1(acc[1][0][2][n]); g7 = row_shr1(acc[1][0][3][n]); u6 = row_shr1(acc[1][1][2][n]); u7 = row_shr1(acc[1][1][3][n]);
                    g6 = g6 + *(const PG8_LAS f32x4*)(halo + cl + 4 * n) * hk; g7 = g7 + *(const PG8_LAS f32x4*)(halo + 256 + cl + 4 * n) * hk;
                    u6 = u6 + *(const PG8_LAS f32x4*)(halo + HALF + cl + 4 * n) * hk; u7 = u7 + *(const PG8_LAS f32x4*)(halo + 256 + HALF + cl + 4 * n) * hk;
                }
                const f32x4 wg0 = *(const PG8_LAS f32x4*)(wt + 0 * 128 + cl + 4 * n), wg1 = *(const PG8_LAS f32x4*)(wt + 2 * 128 + cl + 4 * n), wg2 = *(const PG8_LAS f32x4*)(wt + 4 * 128 + cl + 4 * n), bg = *(const PG8_LAS f32x4*)(wt + 6 * 128 + cl + 4 * n);
                const f32x4 wu0 = *(const PG8_LAS f32x4*)(wt + 1 * 128 + cl + 4 * n), wu1 = *(const PG8_LAS f32x4*)(wt + 3 * 128 + cl + 4 * n), wu2 = *(const PG8_LAS f32x4*)(wt + 5 * 128 + cl + 4 * n), bu = *(const PG8_LAS f32x4*)(wt + 7 * 128 + cl + 4 * n);
#pragma unroll
                for (int jj = 0; jj < 4; ++jj) { const int j = 4 * jh + jj;
                    const f32x4 vg = acc[j >> 2][0][j & 3][n], vu = acc[j >> 2][1][j & 3][n];
                    const int j1 = (j >= 1) ? j - 1 : 0, j2 = (j >= 2) ? j - 2 : 0;
                    const f32x4 pg1 = (j >= 1) ? acc[j1 >> 2][0][j1 & 3][n] : g7, pg2 = (j >= 2) ? acc[j2 >> 2][0][j2 & 3][n] : (j == 1 ? g7 : g6);
                    const f32x4 pu1 = (j >= 1) ? acc[j1 >> 2][1][j1 & 3][n] : u7, pu2 = (j >= 2) ? acc[j2 >> 2][1][j2 & 3][n] : (j == 1 ? u7 : u6);
                    f32x4 zg = bg + wg2 * vg + wg1 * pg1 + wg0 * pg2; asm volatile("" : "+v"(zg));
                    f32x4 zu = bu + wu2 * vu + wu1 * pu1 + wu0 * pu2; asm volatile("" : "+v"(zu));
                    f32x4 r;
#pragma unroll
                    for (int i = 0; i < 4; ++i) r[i] = (zg[i] * zu[i]) * __builtin_amdgcn_rcpf(1.f + __builtin_amdgcn_exp2f(zg[i]));
                    u32x2 w; w.x = cvt_pk_bf16(r[0], r[1]); w.y = cvt_pk_bf16(r[2], r[3]);
                    const bool skip = (wr == 0) && (fr == 0) && (j < 2) && !seq_start;
                    if (n == 0) { gpk[jj] = w; asm volatile("" : "+v"(gpk[jj].x), "+v"(gpk[jj].y)); }
                    else if (!skip) *(u32x4*)(G + (size_t)(tok0 + j) * FF + gc) = (u32x4){gpk[jj].x, gpk[jj].y, w.x, w.y};
                }
                __builtin_amdgcn_sched_barrier(0);
            }
        }
    }
};
struct EpiDown {
    static constexpr bool PERM = true, AFTER_DRAIN = false, PERMA = false, PREFETCH = false, DUAL = false;
    const bf16_t* X1B; bf16_t* X2B; float* SSQ;
    __device__ __forceinline__ void operator()(const f32x4 (&acc)[2][2][4][2], const Unit& u, int wr, int wc, int fr, int fq) const {
        const int row0 = u.pm * BM + wr * 64 + fr, col0 = u.pn * BM + wc * 32 + 8 * fq;
        float sa = 0.f, sb = 0.f;
#pragma unroll
        for (int ai = 0; ai < 2; ++ai)
#pragma unroll
            for (int m = 0; m < 4; ++m) { const int row = row0 + ai * HALF + m * 16; float s = 0.f;
#pragma unroll
                for (int bj = 0; bj < 2; ++bj) { const size_t off = (size_t)row * DM + col0 + bj * HALF;
                    f32x4 v0, v1; unpack8(*(const u32x4*)(X1B + off), v0, v1); v0 = v0 + acc[ai][bj][m][0]; v1 = v1 + acc[ai][bj][m][1];
                    *(u32x4*)(X2B + off) = pack8(v0, v1);
                    s += (v0[0] * v0[0] + v0[1] * v0[1]) + (v0[2] * v0[2] + v0[3] * v0[3]) + (v1[0] * v1[0] + v1[1] * v1[1]) + (v1[2] * v1[2] + v1[3] * v1[3]); }
                s += __shfl_xor(s, 16); s += __shfl_xor(s, 32); if (((ai * 4 + m) >> 1) == fq) { if (m & 1) sb = s; else sa = s; } }
        store_ssq(SSQ, sa, sb, row0, u.pn * 4 + wc, fq);
    }
};
template <class Epi, class Sched, bool ALIGN_EPI = false, bool SP2 = false>
__device__ __forceinline__ void gemm_phase(PG8_LAS unsigned char* lds, const Gemm g, const Sched& S, const Epi& E, const int wid) {
    const int lane = lane_now(), tid = wid * 64 + lane, wr = wid >> 2, wc = wid & 3, fr = lane & 15, fq = lane >> 4;
    const int K = g.K, nt = K / BK;
    unsigned voffA[2], voffB[2];
#pragma unroll
    for (int i = 0; i < 2; ++i) { int R, C; stage_rc(tid * 16 + i * 8192, R, C); const int Rb = Epi::PERM ? ((R & ~31) + perm32(R & 31)) : R;
        const int Ra = Epi::PERMA ? (128 * ((R >> 6) & 1) + 8 * (R & 15) + ((R >> 4) & 3)) : R;
        voffA[i] = (unsigned)(Ra * K + C) * 2u; voffB[i] = (unsigned)(Rb * K + C) * 2u; }
    const size_t kstep = (size_t)(BK * 2);
    const size_t hstep = (size_t)HALF * K * 2;
    const size_t tstep = 2 * hstep;
    const size_t hstepA = Epi::PERMA ? (size_t)4 * K * 2 : hstep;
    const unsigned ldsw = (unsigned)wid * 1024u;
    const int aoff = lds_byte(wr * 64 + fr, fq * 8), boff = lds_byte(wc * 32 + fr, fq * 8);
#define PG8_SA(b, h) (((b) * 2 + (h)) * HTB)
#define PG8_SB(b, h) ((4 + (b) * 2 + (h)) * HTB)
#define PG8_STAGE(bufoff, gbase, voff) do { _Pragma("unroll") for (int _i = 0; _i < 2; ++_i) \
        __builtin_amdgcn_global_load_lds((const unsigned*)((const char*)(gbase) + (voff)[_i]), (PG8_LAS unsigned*)(lds + (bufoff) + ldsw + _i * 8192), 16, 0, 0); } while (0)
#define PG8_LDA(dst, b, h) do { _Pragma("unroll") for (int m = 0; m < 4; ++m) _Pragma("unroll") for (int k = 0; k < 2; ++k) dst[m][k] = *(const PG8_LAS bf16x8*)(lds + PG8_SA(b, h) + aoff + m * 2048 + k * 1024); } while (0)
#define PG8_LDB(dst, b, h) do { _Pragma("unroll") for (int n = 0; n < 2; ++n) _Pragma("unroll") for (int k = 0; k < 2; ++k) dst[n][k] = *(const PG8_LAS bf16x8*)(lds + PG8_SB(b, h) + boff + n * 2048 + k * 1024); } while (0)
#define PG8_MMA(ai, bj, At, Bt) do { __builtin_amdgcn_s_setprio(1); _Pragma("unroll") for (int m = 0; m < 4; ++m) _Pragma("unroll") for (int n = 0; n < 2; ++n) _Pragma("unroll") for (int k = 0; k < 2; ++k) \
        acc[ai][bj][m][n] = __builtin_amdgcn_mfma_f32_16x16x32_bf16(Bt[n][k], At[m][k], acc[ai][bj][m][n], 0, 0, 0); __builtin_amdgcn_s_setprio(0); } while (0)
#define PG8_WAIT_V(n) asm volatile("s_waitcnt vmcnt(" #n ")" ::: "memory")
#define PG8_WAIT_L(n) asm volatile("s_waitcnt lgkmcnt(" #n ")" ::: "memory")
#define PG8_BAR __builtin_amdgcn_s_barrier()
#define PG8_SCHED __builtin_amdgcn_sched_barrier(0)
    Unit cur, nxt; int ui = 0;
    if (!S.next(0, cur)) return;
    f32x4 acc[2][2][4][2];
#pragma unroll
    for (int a = 0; a < 2; ++a)
#pragma unroll
        for (int b = 0; b < 2; ++b)
#pragma unroll
            for (int m = 0; m < 4; ++m)
#pragma unroll
                for (int n = 0; n < 2; ++n) acc[a][b][m][n] = (f32x4){0.f, 0.f, 0.f, 0.f};
    bf16x8 At[4][2], B0[2][2], B1[2][2];
    const char* cA = (const char*)((Epi::DUAL && cur.seg) ? g.A2 : g.A) + (size_t)cur.pm * tstep; const char* cB = (const char*)((Epi::DUAL && cur.seg) ? g.Bt2 : g.Bt) + (size_t)cur.pn * tstep;
    S.a_ready(cur);
    if constexpr (Epi::PREFETCH) E.prefetch(cur, 0, wid, lane);
    if constexpr (SP2) {
        PG8_STAGE(PG8_SB(0, 0), cB, voffB); PG8_STAGE(PG8_SB(0, 1), cB + hstep, voffB); PG8_STAGE(PG8_SA(0, 0), cA, voffA); PG8_STAGE(PG8_SA(0, 1), cA + hstepA, voffA);
        if (wr == 1) PG8_BAR;
        PG8_WAIT_V(2); PG8_BAR;
        PG8_STAGE(PG8_SB(1, 0), cB + kstep, voffB); PG8_STAGE(PG8_SA(1, 0), cA + kstep, voffA); PG8_STAGE(PG8_SB(1, 1), cB + hstep + kstep, voffB);
        PG8_WAIT_V(6); PG8_BAR;
    } else {
        PG8_STAGE(PG8_SB(0, 0), cB, voffB); PG8_STAGE(PG8_SA(0, 0), cA, voffA); PG8_STAGE(PG8_SB(0, 1), cB + hstep, voffB); PG8_STAGE(PG8_SA(0, 1), cA + hstepA, voffA);
        if (wr == 1) PG8_BAR;
        PG8_WAIT_V(4); PG8_BAR;
        PG8_STAGE(PG8_SB(1, 0), cB + kstep, voffB); PG8_STAGE(PG8_SA(1, 0), cA + kstep, voffA); PG8_STAGE(PG8_SB(1, 1), cB + hstep + kstep, voffB);
        PG8_WAIT_V(6); PG8_BAR;
    }
    for (;;) {
        const bool has_next = S.next(ui + 1, nxt);
        const char* nA = has_next ? (const char*)((Epi::DUAL && nxt.seg) ? g.A2 : g.A) + (size_t)nxt.pm * tstep : cA; const char* nB = has_next ? (const char*)((Epi::DUAL && nxt.seg) ? g.Bt2 : g.Bt) + (size_t)nxt.pn * tstep : cB;
        for (int t = 0; t < nt; t += 2) {
            const bool last = (t == nt - 2);
            const char* a1 = cA + (size_t)(t + 1) * kstep;
            const char* a2 = last ? nA : cA + (size_t)(t + 2) * kstep; const char* b2 = last ? nB : cB + (size_t)(t + 2) * kstep;
            const char* a3 = a2 + kstep; const char* b3 = b2 + kstep;
            if (last && has_next) S.a_ready(nxt);
            if constexpr (SP2) {
            PG8_LDB(B0, 0, 0); PG8_LDB(B1, 0, 1); PG8_SCHED; PG8_LDA(At, 0, 0); PG8_STAGE(PG8_SA(1, 1), a1 + hstepA, voffA);
            PG8_WAIT_V(8); PG8_WAIT_L(0); PG8_BAR; PG8_MMA(0, 0, At, B0); PG8_MMA(0, 1, At, B1); PG8_BAR; PG8_SCHED;
            PG8_LDA(At, 0, 1); PG8_STAGE(PG8_SB(0, 0), b2, voffB); PG8_STAGE(PG8_SB(0, 1), b2 + hstep, voffB); PG8_STAGE(PG8_SA(0, 0), a2, voffA);
            PG8_WAIT_V(8); PG8_WAIT_L(0); PG8_BAR; PG8_MMA(1, 0, At, B0); PG8_MMA(1, 1, At, B1); PG8_BAR; PG8_SCHED;
            PG8_LDB(B0, 1, 0); PG8_LDB(B1, 1, 1); PG8_SCHED; PG8_LDA(At, 1, 0); PG8_STAGE(PG8_SA(0, 1), a2 + hstepA, voffA);
            PG8_WAIT_V(8); PG8_WAIT_L(0); PG8_BAR; PG8_MMA(0, 0, At, B0); PG8_MMA(0, 1, At, B1); PG8_BAR; PG8_SCHED;
            PG8_LDA(At, 1, 1); PG8_STAGE(PG8_SB(1, 0), b3, voffB); PG8_STAGE(PG8_SB(1, 1), b3 + hstep, voffB); PG8_STAGE(PG8_SA(1, 0), a3, voffA);
            PG8_WAIT_V(8); PG8_WAIT_L(0); PG8_BAR; PG8_MMA(1, 0, At, B0); PG8_MMA(1, 1, At, B1); PG8_BAR; PG8_SCHED;
            } else {
            PG8_LDB(B0, 0, 0); PG8_SCHED; PG8_LDA(At, 0, 0); PG8_STAGE(PG8_SA(1, 1), a1 + hstepA, voffA);
            PG8_WAIT_L(8); PG8_BAR; PG8_WAIT_L(0); PG8_MMA(0, 0, At, B0); PG8_BAR; PG8_SCHED;
            PG8_LDB(B1, 0, 1); PG8_STAGE(PG8_SB(0, 0), b2, voffB);
            PG8_BAR; PG8_WAIT_L(0); PG8_MMA(0, 1, At, B1); PG8_BAR;
            PG8_LDA(At, 0, 1); PG8_STAGE(PG8_SA(0, 0), a2, voffA);
            PG8_BAR; PG8_WAIT_L(0); PG8_MMA(1, 0, At, B0); PG8_BAR; PG8_SCHED;
            PG8_STAGE(PG8_SB(0, 1), b2 + hstep, voffB);
            PG8_WAIT_V(6); PG8_BAR; PG8_MMA(1, 1, At, B1); PG8_BAR;
            PG8_LDB(B0, 1, 0); PG8_SCHED; PG8_LDA(At, 1, 0); PG8_STAGE(PG8_SA(0, 1), a2 + hstepA, voffA);
            PG8_WAIT_L(8); PG8_BAR; PG8_WAIT_L(0); PG8_MMA(0, 0, At, B0); PG8_BAR; PG8_SCHED;
            PG8_LDB(B1, 1, 1); PG8_STAGE(PG8_SB(1, 0), b3, voffB);
            PG8_BAR; PG8_WAIT_L(0); PG8_MMA(0, 1, At, B1); PG8_BAR;
            PG8_LDA(At, 1, 1); PG8_STAGE(PG8_SA(1, 0), a3, voffA);
            PG8_BAR; PG8_WAIT_L(0); PG8_MMA(1, 0, At, B0); PG8_BAR; PG8_SCHED;
            PG8_STAGE(PG8_SB(1, 1), b3 + hstep, voffB);
            PG8_WAIT_V(6); PG8_BAR; PG8_MMA(1, 1, At, B1); PG8_BAR;
            }
        }
        if constexpr (ALIGN_EPI) { if (wr == 0) PG8_BAR; }
        if constexpr (!Epi::AFTER_DRAIN) { if constexpr (Epi::PREFETCH) E(acc, cur, wr, wc, fr, fq, ui); else if constexpr (Epi::DUAL) { if (cur.seg == 0) E.mid(acc, cur, wr, wc, fr, fq); else E(acc, cur, wr, wc, fr, fq); } else E(acc, cur, wr, wc, fr, fq); S.done(cur); }
        if (!has_next) break;
        if (!(Epi::DUAL && cur.seg == 0))
#pragma unroll
        for (int a = 0; a < 2; ++a)
#pragma unroll
            for (int b = 0; b < 2; ++b)
#pragma unroll
                for (int m = 0; m < 4; ++m)
#pragma unroll
                    for (int n = 0; n < 2; ++n) acc[a][b][m][n] = (f32x4){0.f, 0.f, 0.f, 0.f};
        cur = nxt; cA = nA; cB = nB; ++ui;
        if constexpr (Epi::PREFETCH) E.prefetch(cur, ui, wid, lane);
        if constexpr (ALIGN_EPI) { if (wr == 1) PG8_BAR; }
    }
    PG8_WAIT_V(0);
    if constexpr (!ALIGN_EPI) { if (wr == 0) PG8_BAR; }
    PG8_BAR;
    if constexpr (Epi::AFTER_DRAIN) { E.fused(acc, cur, wr, wc, fr, fq, lds, wid, lane); S.done(cur); }
#undef PG8_SA
#undef PG8_SB
#undef PG8_STAGE
#undef PG8_LDA
#undef PG8_LDB
#undef PG8_MMA
#undef PG8_WAIT_V
#undef PG8_WAIT_L
#undef PG8_BAR
#undef PG8_SCHED
}
}

#define GAS __attribute__((address_space(1)))
#define LAS __attribute__((address_space(3)))
typedef GAS unsigned gu32;
typedef GAS unsigned long long gu64;
#define RLX_AGENT __ATOMIC_RELAXED, __HIP_MEMORY_SCOPE_AGENT
#define LDS_WAIT() asm volatile("s_waitcnt lgkmcnt(0)" ::: "memory")
#define VM_WAIT() asm volatile("s_waitcnt vmcnt(0)" ::: "memory")
#define XB_TMO      128
#define XB_XCNT(j)  (256  + 64 * (j))
#define XB_XSUB(j)  (1280 + 64 * (j))
#define XB_XGEN(j)  (2304 + 64 * (j))
#define XB_TOP      3328
#define XB_TOPGEN   3392
#define XB_LSUB(j)  (3456 + 64 * (j))
#define XB_LGEN(j)  (4480 + 64 * (j))
#define XCD_BAR_WORDS 5504
#define XB_SPIN_CAP (1u << 18)

__device__ __forceinline__ unsigned xb_ld(unsigned* p)              { return __hip_atomic_load(p, __ATOMIC_RELAXED, __HIP_MEMORY_SCOPE_AGENT); }
__device__ __forceinline__ unsigned xb_add(unsigned* p, unsigned v) { return __hip_atomic_fetch_add(p, v, __ATOMIC_RELAXED, __HIP_MEMORY_SCOPE_AGENT); }
__device__ __forceinline__ unsigned xb_xcc_id() { return (unsigned)__builtin_amdgcn_s_getreg((3 << 11) | 20) & 0xFu; }
#define XB_SPIN(cond, bar) do { unsigned _sp = 0; while (cond) { __builtin_amdgcn_s_sleep(1); \
    if ((++_sp & 255u) == 0u) { if (xb_ld(&(bar)[XB_TMO])) break; if (_sp > XB_SPIN_CAP) { atomicAdd(&(bar)[XB_TMO], 1u); break; } } } } while (0)

struct XcdBarrier {
    unsigned* bar; unsigned x; int wv;
    volatile LAS unsigned* st;
};

__device__ __forceinline__ XcdBarrier xcd_barrier_post(unsigned* bar, volatile LAS unsigned* st, int wv) {
    XcdBarrier b; b.bar = bar; b.x = xb_xcc_id(); b.st = st; b.wv = wv;
    if (wv == 0 && lane_now() == 0) (void)xb_add(&bar[XB_XCNT(b.x)], 1u);
    return b;
}
__device__ __forceinline__ void xcd_barrier_complete(unsigned* bar, unsigned x, unsigned& nloc, unsigned& nx) {
    const unsigned G = gridDim.x * gridDim.y * gridDim.z;
    unsigned sum, cnt, mine, sp = 0u;
    for (;;) {
        sum = 0u; cnt = 0u; mine = 0u;
#pragma unroll
        for (unsigned j = 0; j < 16; ++j) { const unsigned c = xb_ld(&bar[XB_XCNT(j)]); sum += c; cnt += (c > 0u) ? 1u : 0u; mine = (j == x) ? c : mine; }
        if (sum == G) break;
        __builtin_amdgcn_s_sleep(1);
        if ((++sp & 255u) == 0u) { if (xb_ld(&bar[XB_TMO])) break; if (sp > XB_SPIN_CAP) { atomicAdd(&bar[XB_TMO], 1u); break; } }
    }
    nloc = mine > 0u ? mine : 1u; nx = cnt > 0u ? cnt : 1u;
}

__device__ __forceinline__ void xcd_barrier(const XcdBarrier& b) {
    asm volatile("s_waitcnt vmcnt(0)" ::: "memory");
    __syncthreads();
    if (b.wv == 0 && lane_now() == 0) {
        unsigned* bar = b.bar;
        __builtin_amdgcn_s_waitcnt(0);
        unsigned nloc = b.st[0], nx = b.st[1];
        if (nloc == 0u) { xcd_barrier_complete(bar, b.x, nloc, nx); b.st[0] = nloc; b.st[1] = nx; }
        const unsigned old = xb_add(&bar[XB_XSUB(b.x)], 1u);
        const unsigned gen = old / nloc;
        if (old + 1u == (gen + 1u) * nloc) {
            __builtin_amdgcn_fence(__ATOMIC_RELEASE, "agent");
            asm volatile("s_waitcnt vmcnt(0)" ::: "memory");
            const unsigned og = xb_add(&bar[XB_TOP], 1u);
            const unsigned tg = og / nx;
            if (og + 1u == (tg + 1u) * nx) xb_add(&bar[XB_TOPGEN], 1u);
            else XB_SPIN(xb_ld(&bar[XB_TOPGEN]) == tg, bar);
            __builtin_amdgcn_fence(__ATOMIC_ACQUIRE, "agent");
            xb_add(&bar[XB_XGEN(b.x)], 1u);
            asm volatile("s_waitcnt vmcnt(0)" ::: "memory");
        } else {
            XB_SPIN(xb_ld(&bar[XB_XGEN(b.x)]) == gen, bar);
            __builtin_amdgcn_fence(__ATOMIC_ACQUIRE, "agent");
            asm volatile("s_waitcnt vmcnt(0)" ::: "memory");
        }
    }
    __syncthreads();
}
__device__ __forceinline__ void xcd_barrier_local(const XcdBarrier& b) {
    asm volatile("s_waitcnt vmcnt(0)" ::: "memory");
    __syncthreads();
    if (b.wv == 0 && lane_now() == 0) {
        unsigned* bar = b.bar;
        __builtin_amdgcn_s_waitcnt(0);
        const unsigned nloc = b.st[0];
        const unsigned old = xb_add(&bar[XB_LSUB(b.x)], 1u);
        const unsigned gen = old / nloc;
        if (old + 1u == (gen + 1u) * nloc) xb_add(&bar[XB_LGEN(b.x)], 1u);
        else XB_SPIN(xb_ld(&bar[XB_LGEN(b.x)]) == gen, bar);
        __builtin_amdgcn_fence(__ATOMIC_ACQUIRE, "agent");
        asm volatile("s_waitcnt vmcnt(0)" ::: "memory");
    }
    __syncthreads();
}

namespace ret {
typedef short s16x4 __attribute__((ext_vector_type(4)));
typedef short v4i16_t __attribute__((ext_vector_type(4)));
typedef LAS const unsigned char* lptr;
constexpr int QS_STRIDE = 144, KD_STRIDE = 192, VS_STRIDE = 320, OUT_STRIDE = 528;
constexpr int OFF_QS = 0, OFF_ST = 18432, OFF_KS = 36864, OFF_KD = 55296, OFF_VS = 79872, OFF_END = 120832, OFF_OUT = OFF_KS, OFF_SSQ = OFF_END;
static_assert(OFF_OUT + 128 * OUT_STRIDE <= OFF_END && OFF_SSQ + 1024 <= 131072, "retention LDS map");
__device__ __forceinline__ s16x4 vtr(lptr p) { return __builtin_bit_cast(s16x4, __builtin_amdgcn_ds_read_tr16_b64_v4i16((LAS v4i16_t*)p)); }
__device__ __forceinline__ bf16x8 cat8(const s16x4 lo, const s16x4 hi) { return (bf16x8){lo[0], lo[1], lo[2], lo[3], hi[0], hi[1], hi[2], hi[3]}; }

__device__ __forceinline__ void stage_chunk(LAS unsigned char* lds, const bf16* rowbase, int h, float lg, int tid, bool with_qk) {
#pragma unroll
    for (int i = 0; i < 2; ++i) { const int it = tid + 512 * i, row = it >> 3, ch = it & 7;
        const u32x4 k = *(const u32x4*)(rowbase + (size_t)row * PP + C_KR + h * HD + ch * 8);
        f32x4 a, b; pg8::unpack8(k, a, b); const float d = __builtin_amdgcn_exp2f(lg * (float)(127 - row));
        *(LAS u32x4*)(lds + OFF_KD + row * KD_STRIDE + ch * 16) = pg8::pack8(a * d, b * d);
        if (with_qk) { *(LAS u32x4*)(lds + OFF_KS + row * QS_STRIDE + ch * 16) = k;
            *(LAS u32x4*)(lds + OFF_QS + row * QS_STRIDE + ch * 16) = *(const u32x4*)(rowbase + (size_t)row * PP + C_QR + h * HD + ch * 8); } }
#pragma unroll
    for (int i = 0; i < 4; ++i) { const int it = tid + 512 * i, row = it >> 4, ch = it & 15;
        *(LAS u32x4*)(lds + OFF_VS + row * VS_STRIDE + ch * 16) = *(const u32x4*)(rowbase + (size_t)row * PP + C_VR + h * DV + ch * 8); }
}
__device__ __forceinline__ void state_update(f32x16& st, lptr lds, int dkb, int dvb, float gC, int lane) {
    const int hi = lane >> 5, g = (lane >> 4) & 1, qq = (lane & 15) >> 2, pp = lane & 3;
    lptr ka = lds + OFF_KD + (8 * hi + qq) * KD_STRIDE + (32 * dkb + 16 * g + 4 * pp) * 2;
    lptr va = lds + OFF_VS + (8 * hi + qq) * VS_STRIDE + (32 * dvb + 16 * g + 4 * pp) * 2;
#pragma unroll
    for (int r = 0; r < 16; ++r) st[r] *= gC;
#pragma unroll
    for (int ks = 0; ks < 8; ++ks) {
        const bf16x8 a = cat8(vtr(ka + ks * 16 * KD_STRIDE), vtr(ka + (ks * 16 + 4) * KD_STRIDE));
        const bf16x8 b = cat8(vtr(va + ks * 16 * VS_STRIDE), vtr(va + (ks * 16 + 4) * VS_STRIDE));
        st = __builtin_amdgcn_mfma_f32_32x32x16_bf16(a, b, st, 0, 0, 0);
    }
}

__device__ __forceinline__ void ret_group_state(LAS unsigned char* lds, const bf16* PROJ, float* GST, int ui, int tid) {
    const int lane = tid & 63, wave = __builtin_amdgcn_readfirstlane(tid >> 6), hi = lane >> 5;
    const int bh = ui >> 3, s = ui & 7, h = bh & 3, b = bh >> 2, dkb = wave & 1, dvb = wave >> 1;
    const float lg = ret_lg2(h), gC = __builtin_amdgcn_exp2f(lg * 128.f);
    f32x16 st = {};
    const bf16* rb0 = PROJ + ((size_t)b * SEQ + (size_t)(8 * s) * 128) * PP;
    const size_t koff0 = (size_t)(tid >> 3) * PP + C_KR + h * HD + (tid & 7) * 8, voff0 = (size_t)(tid >> 4) * PP + C_VR + h * DV + (tid & 15) * 8;
    u32x4 kk[3][2], vv[3][4];
#pragma unroll
    for (int c = 0; c < 3; ++c) { const bf16* rb = rb0 + (size_t)c * 128 * PP;
#pragma unroll
        for (int i = 0; i < 2; ++i) kk[c][i] = *(const u32x4*)(rb + koff0 + (size_t)(64 * i) * PP);
#pragma unroll
        for (int i = 0; i < 4; ++i) vv[c][i] = *(const u32x4*)(rb + voff0 + (size_t)(32 * i) * PP); }
#pragma unroll
    for (int c = 0; c < 8; ++c) { const int q = c % 3;
        __syncthreads();
#pragma unroll
        for (int i = 0; i < 2; ++i) { const int row = (tid >> 3) + 64 * i, ch = tid & 7;
            f32x4 a, bq; pg8::unpack8(kk[q][i], a, bq); const float d = __builtin_amdgcn_exp2f(lg * (float)(127 - row));
            *(LAS u32x4*)(lds + OFF_KD + row * KD_STRIDE + ch * 16) = pg8::pack8(a * d, bq * d); }
#pragma unroll
        for (int i = 0; i < 4; ++i) { const int row = (tid >> 4) + 32 * i, ch = tid & 15; *(LAS u32x4*)(lds + OFF_VS + row * VS_STRIDE + ch * 16) = vv[q][i]; }
        if (c + 3 < 8) { const bf16* rb = rb0 + (size_t)(c + 3) * 128 * PP;
#pragma unroll
            for (int i = 0; i < 2; ++i) kk[q][i] = *(const u32x4*)(rb + koff0 + (size_t)(64 * i) * PP);
#pragma unroll
            for (int i = 0; i < 4; ++i) vv[q][i] = *(const u32x4*)(rb + voff0 + (size_t)(32 * i) * PP); }
        __syncthreads();
        state_update(st, (lptr)lds, dkb, dvb, gC, lane);
    }
    f32x4* gq = (f32x4*)(GST + (size_t)ui * (HD * DV)) + wave * 256 + lane;
#pragma unroll
    for (int q = 0; q < 4; ++q) gq[q * 64] = (f32x4){st[4 * q], st[4 * q + 1], st[4 * q + 2], st[4 * q + 3]};
    __syncthreads();
}

__device__ __forceinline__ void ret_outputs(LAS unsigned char* lds, const bf16* PROJ, const float* GST, bf16* RB, int ui, int tid) {
    const int lane = tid & 63, wave = __builtin_amdgcn_readfirstlane(tid >> 6), hi = lane >> 5, l31 = lane & 31;
    const int g = (lane >> 4) & 1, qq = (lane & 15) >> 2, pp = lane & 3;
    const int bh = ui >> 3, s = ui & 7, h = bh & 3, b = bh >> 2, dkb = wave & 1, dvb = wave >> 1;
    const int qblk = wave & 3, dvh = wave >> 2;
    const float lg = ret_lg2(h), gC = __builtin_amdgcn_exp2f(lg * 128.f);
    f32x16 st = {};
    for (int sp = 0; sp < s; ++sp) {
        const float w = __builtin_amdgcn_exp2f(lg * 1024.f * (float)(s - 1 - sp));
        const f32x4* gq = (const f32x4*)(GST + (size_t)(bh * 8 + sp) * (HD * DV)) + wave * 256 + lane;
#pragma unroll
        for (int q = 0; q < 4; ++q) { const f32x4 v = gq[q * 64];
#pragma unroll
            for (int i = 0; i < 4; ++i) st[4 * q + i] += w * v[i]; }
    }
    const float qdec = __builtin_amdgcn_exp2f(lg * (float)(32 * qblk + l31 + 1));
    const bf16* rb0 = PROJ + ((size_t)b * SEQ + (size_t)(8 * s) * 128) * PP;
    const size_t qoff0 = (size_t)(tid >> 3) * PP + h * HD + (tid & 7) * 8, voff0 = (size_t)(tid >> 4) * PP + C_VR + h * DV + (tid & 15) * 8;
    u32x4 kk[2], qv[2], vv[4];
#pragma unroll
    for (int i = 0; i < 2; ++i) { kk[i] = *(const u32x4*)(rb0 + qoff0 + C_KR + (size_t)(64 * i) * PP); qv[i] = *(const u32x4*)(rb0 + qoff0 + C_QR + (size_t)(64 * i) * PP); }
#pragma unroll
    for (int i = 0; i < 4; ++i) vv[i] = *(const u32x4*)(rb0 + voff0 + (size_t)(32 * i) * PP);
    for (int c = 0; c < 8; ++c) {
        const size_t row0 = (size_t)b * SEQ + (size_t)(8 * s + c) * 128;
        __syncthreads();
#pragma unroll
        for (int gq = 0; gq < 4; ++gq) { u32x2 w; w.x = pg8::cvt_pk_bf16(st[4 * gq], st[4 * gq + 1]); w.y = pg8::cvt_pk_bf16(st[4 * gq + 2], st[4 * gq + 3]);
            *(LAS u32x2*)(lds + OFF_ST + (32 * dvb + l31) * QS_STRIDE + (32 * dkb + 8 * gq + 4 * hi) * 2) = w; }
#pragma unroll
        for (int i = 0; i < 2; ++i) { const int row = (tid >> 3) + 64 * i, ch = tid & 7;
            f32x4 a, bq; pg8::unpack8(kk[i], a, bq); const float d = __builtin_amdgcn_exp2f(lg * (float)(127 - row));
            *(LAS u32x4*)(lds + OFF_KD + row * KD_STRIDE + ch * 16) = pg8::pack8(a * d, bq * d);
            *(LAS u32x4*)(lds + OFF_KS + row * QS_STRIDE + ch * 16) = kk[i]; *(LAS u32x4*)(lds + OFF_QS + row * QS_STRIDE + ch * 16) = qv[i]; }
#pragma unroll
        for (int i = 0; i < 4; ++i) { const int row = (tid >> 4) + 32 * i, ch = tid & 15; *(LAS u32x4*)(lds + OFF_VS + row * VS_STRIDE + ch * 16) = vv[i]; }
        if (c + 1 < 8) { const bf16* rb = rb0 + (size_t)(c + 1) * 128 * PP;
#pragma unroll
            for (int i = 0; i < 2; ++i) { kk[i] = *(const u32x4*)(rb + qoff0 + C_KR + (size_t)(64 * i) * PP); qv[i] = *(const u32x4*)(rb + qoff0 + C_QR + (size_t)(64 * i) * PP); }
#pragma unroll
            for (int i = 0; i < 4; ++i) vv[i] = *(const u32x4*)(rb + voff0 + (size_t)(32 * i) * PP); }
        __syncthreads();
        bf16x8 qf[4];
#pragma unroll
        for (int d0 = 0; d0 < 4; ++d0) qf[d0] = *(const LAS bf16x8*)(lds + OFF_QS + (32 * qblk + l31) * QS_STRIDE + (16 * d0 + 8 * hi) * 2);
        f32x16 o[2];
#pragma unroll
        for (int d = 0; d < 2; ++d) { o[d] = f32x16{};
#pragma unroll
            for (int d0 = 0; d0 < 4; ++d0) { const bf16x8 a = *(const LAS bf16x8*)(lds + OFF_ST + (32 * (2 * dvh + d) + l31) * QS_STRIDE + (16 * d0 + 8 * hi) * 2);
                o[d] = __builtin_amdgcn_mfma_f32_32x32x16_bf16(a, qf[d0], o[d], 0, 0, 0); }
#pragma unroll
            for (int r = 0; r < 16; ++r) o[d][r] *= qdec; }
        for (int kb = 0; kb <= qblk; ++kb) {
            f32x16 sT = {};
#pragma unroll
            for (int d0 = 0; d0 < 4; ++d0) { const bf16x8 a = *(const LAS bf16x8*)(lds + OFF_KS + (32 * kb + l31) * QS_STRIDE + (16 * d0 + 8 * hi) * 2);
                sT = __builtin_amdgcn_mfma_f32_32x32x16_bf16(a, qf[d0], sT, 0, 0, 0); }
            const int dq = 32 * (qblk - kb) + l31;
#pragma unroll
            for (int r = 0; r < 16; ++r) { const int dist = dq - ((r & 3) + 8 * (r >> 2) + 4 * hi); sT[r] = (dist >= 0) ? sT[r] * __builtin_amdgcn_exp2f(lg * (float)dist) : 0.f; }
            u32x4 pw[2];
#pragma unroll
            for (int sx = 0; sx < 2; ++sx) { pw[sx].x = pg8::cvt_pk_bf16(sT[8 * sx], sT[8 * sx + 1]); pw[sx].y = pg8::cvt_pk_bf16(sT[8 * sx + 2], sT[8 * sx + 3]);
                pw[sx].z = pg8::cvt_pk_bf16(sT[8 * sx + 4], sT[8 * sx + 5]); pw[sx].w = pg8::cvt_pk_bf16(sT[8 * sx + 6], sT[8 * sx + 7]); }
#pragma unroll
            for (int d = 0; d < 2; ++d)
#pragma unroll
                for (int sx = 0; sx < 2; ++sx) { lptr vp = (lptr)lds + OFF_VS + (32 * kb + 16 * sx + 4 * hi + qq) * VS_STRIDE + (32 * (2 * dvh + d) + 16 * g + 4 * pp) * 2;
                    const bf16x8 a = cat8(vtr(vp), vtr(vp + 8 * VS_STRIDE));
                    o[d] = __builtin_amdgcn_mfma_f32_32x32x16_bf16(a, __builtin_bit_cast(bf16x8, pw[sx]), o[d], 0, 0, 0); }
        }
        state_update(st, (lptr)lds, dkb, dvb, gC, lane);
        float ss = 0.f;
#pragma unroll
        for (int d = 0; d < 2; ++d)
#pragma unroll
            for (int r = 0; r < 16; ++r) ss += o[d][r] * o[d][r];
        ss += __shfl_xor(ss, 32);
        __syncthreads();
#pragma unroll
        for (int d = 0; d < 2; ++d)
#pragma unroll
            for (int gq = 0; gq < 4; ++gq) *(LAS f32x4*)(lds + OFF_OUT + (32 * qblk + l31) * OUT_STRIDE + (32 * (2 * dvh + d) + 8 * gq + 4 * hi) * 4) = (f32x4){o[d][4 * gq], o[d][4 * gq + 1], o[d][4 * gq + 2], o[d][4 * gq + 3]};
        if (hi == 0) *(LAS float*)(lds + OFF_SSQ + (dvh * 128 + 32 * qblk + l31) * 4) = ss;
        __syncthreads();
        { const int row = tid >> 2, seg = tid & 3;
          const float rstd = rsqrtf((*(const LAS float*)(lds + OFF_SSQ + row * 4) + *(const LAS float*)(lds + OFF_SSQ + (128 + row) * 4)) * (1.f / DV) + SUBLN_EPS);
          const bf16* gsrc = PROJ + (row0 + row) * PP + C_GR + h * DV + seg * 32; bf16* dst = RB + (row0 + row) * 512 + h * DV + seg * 32;
#pragma unroll
          for (int cc = 0; cc < 4; ++cc) { const f32x4 v0 = *(const LAS f32x4*)(lds + OFF_OUT + row * OUT_STRIDE + (seg * 32 + cc * 8) * 4), v1 = *(const LAS f32x4*)(lds + OFF_OUT + row * OUT_STRIDE + (seg * 32 + cc * 8 + 4) * 4);
              f32x4 g0, g1; pg8::unpack8(*(const u32x4*)(gsrc + cc * 8), g0, g1); f32x4 r0, r1;
#pragma unroll
              for (int i = 0; i < 4; ++i) { r0[i] = v0[i] * rstd * g0[i]; r1[i] = v1[i] * rstd * g1[i]; }
              *(u32x4*)(dst + cc * 8) = pg8::pack8(r0, r1); } }
    }
    __syncthreads();
}
}

namespace attn {
typedef short s16x4 __attribute__((ext_vector_type(4)));
typedef short v4i16_t __attribute__((ext_vector_type(4)));
typedef LAS const unsigned char* lptr;
constexpr int KSLOT = 16384, L_K2 = 8192, L_V = 65536, VSLOT = 16384;
#ifndef ATT_SKIP
#define ATT_SKIP 1
#endif
#ifndef ATT_THR
#define ATT_THR 60.0f
#endif
__device__ __forceinline__ void glds16s(const void* sbase, unsigned voff, unsigned lds_dst) { unsigned keep;
    asm volatile("s_mov_b32 %0, m0\n\ts_mov_b32 m0, %3\n\ts_nop 0\n\tglobal_load_lds_dwordx4 %1, %2\n\ts_mov_b32 m0, %0" : "=&s"(keep) : "v"(voff), "s"(sbase), "s"(lds_dst) : "memory"); }
__device__ __forceinline__ void glds16(const void* gsrc, unsigned lds_dst) { unsigned keep;
    asm volatile("s_mov_b32 %0, m0\n\ts_mov_b32 m0, %2\n\ts_nop 0\n\tglobal_load_lds_dwordx4 %1, off\n\ts_mov_b32 m0, %0" : "=&s"(keep) : "v"(gsrc), "s"(lds_dst) : "memory"); }
__device__ __forceinline__ s16x4 vtr(lptr p) { return __builtin_bit_cast(s16x4, __builtin_amdgcn_ds_read_tr16_b64_v4i16((LAS v4i16_t*)p)); }
__device__ __forceinline__ bf16x8 cat8(const s16x4 lo, const s16x4 hi) { return (bf16x8){lo[0], lo[1], lo[2], lo[3], hi[0], hi[1], hi[2], hi[3]}; }
#define ATT_WAIT_BAR() asm volatile("s_waitcnt vmcnt(0) lgkmcnt(0)\n\ts_barrier" ::: "memory")
#define ATT_WAIT_BAR4() asm volatile("s_waitcnt vmcnt(4) lgkmcnt(0)\n\ts_barrier" ::: "memory")

#define ATT_SB() __builtin_amdgcn_sched_barrier(0)
__device__ __forceinline__ float max3f(float a, float b, float c) { float r; asm("v_max3_f32 %0, %1, %2, %3" : "=v"(r) : "v"(a), "v"(b), "v"(c)); return r; }
__device__ __forceinline__ bf16x8 vfrag(lptr vp, int ks, int d) { const lptr va = vp + d * 4096 + (32 * (ks >> 1) + 16 * (ks & 1)) * 64; return cat8(vtr(va), vtr(va + 8 * 64)); }
__device__ __forceinline__ void vload4(bf16x8 (&buf)[8], int half, lptr vp, int ks) {
#pragma unroll
    for (int d = 0; d < 4; ++d) buf[4 * half + d] = vfrag(vp, ks, d);
}
__device__ __forceinline__ void pv_step(f32x16 (&o)[4], const u32x4& pwk, const bf16x8 (&buf)[8], int half) {
    const bf16x8 pb = __builtin_bit_cast(bf16x8, pwk);
#pragma unroll
    for (int d = 0; d < 4; ++d) o[d] = __builtin_amdgcn_mfma_f32_32x32x16_bf16(buf[4 * half + d], pb, o[d], 0, 0, 0);
}
__device__ __forceinline__ void kload8(bf16x8 (&kf)[8], lptr kp) {
#pragma unroll
    for (int d0 = 0; d0 < 4; ++d0) { kf[2 * d0] = *(const LAS bf16x8*)(kp + d0 * 2048); kf[2 * d0 + 1] = *(const LAS bf16x8*)(kp + d0 * 2048 + 512); }
}
__device__ __forceinline__ void kload4(bf16x8 (&kf)[8], lptr kp, int half) {
#pragma unroll
    for (int d0 = 2 * half; d0 < 2 * half + 2; ++d0) { kf[2 * d0] = *(const LAS bf16x8*)(kp + d0 * 2048); kf[2 * d0 + 1] = *(const LAS bf16x8*)(kp + d0 * 2048 + 512); }
}
template <int MODE> __device__ __forceinline__ void qk_scores(const bf16x8 (&kf)[8], const bf16x8 (&qr)[4], f32x16 (&o)[4], f32x16& p0, f32x16& p1, float& cinit, float shift, bool band, int kb, int qrel, lptr vp, bf16x8 (&tmp)[8]) {
#pragma unroll
    for (int r = 0; r < 16; ++r) { p0[r] = cinit; p1[r] = cinit; }
#pragma unroll
    for (int d0 = 0; d0 < 4; ++d0) {
        p0 = __builtin_amdgcn_mfma_f32_32x32x16_bf16(kf[2 * d0], qr[d0], p0, 0, 0, 0);
        p1 = __builtin_amdgcn_mfma_f32_32x32x16_bf16(kf[2 * d0 + 1], qr[d0], p1, 0, 0, 0);
    }
    ATT_SB();
    vload4(tmp, 0, vp, 0); vload4(tmp, 1, vp, 1);
    ATT_SB();
}
template <int MODE> __device__ __forceinline__ void softmax_head(f32x16 (&o)[4], float& lsum, f32x16& p0, f32x16& p1, float& cinit, float shift, bool band, int kb, int qrel) {
    if (!(MODE & 2)) {
    if (band) {
#pragma unroll
        for (int r = 0; r < 16; ++r) { const int kv = kb + (r & 3) + 8 * (r >> 2); if (kv > qrel) p0[r] = -INFINITY; if (kv + 32 > qrel) p1[r] = -INFINITY; }
    }
    ATT_SB(); asm volatile("s_nop 7\n\ts_nop 7"); ATT_SB();
    float rm = max3f(p0[0], p0[1], p1[0]), rb = max3f(p0[2], p0[3], p1[1]);
    rm = max3f(rm, p1[2], p1[3]);
#pragma unroll
    for (int r = 4; r < 16; r += 4) { rm = max3f(rm, p0[r], p0[r + 1]); rb = max3f(rb, p0[r + 2], p0[r + 3]); rm = max3f(rm, p1[r], p1[r + 1]); rb = max3f(rb, p1[r + 2], p1[r + 3]); }
    rm = max3f(rm, rb, rb);
    { auto rr = __builtin_amdgcn_permlane32_swap(__float_as_uint(rm), __float_as_uint(rm), false, false); rm = fmaxf(__uint_as_float(rr[0]), __uint_as_float(rr[1])); }
    if (__any(rm > ATT_THR)) {
        const float dl = fmaxf(rm, 0.f), f = __builtin_amdgcn_exp2f(-dl);
        cinit -= dl;
#pragma unroll
        for (int r = 0; r < 16; ++r) { p0[r] -= dl; p1[r] -= dl; }
        lsum *= f;
#pragma unroll
        for (int d = 0; d < 4; ++d)
#pragma unroll
            for (int r = 0; r < 16; ++r) o[d][r] *= f;
    }
    }
    cinit += shift;
}
struct AW { float b1, b2, b3, a8, c1, c2, c3; };
template <int MODE> __device__ __forceinline__ u32x4 exp_pack(const f32x16& p, int s, float& lsum, float cks, const AW& aw) {
    float e[8];
#pragma unroll
    for (int j = 0; j < 8; ++j) e[j] = (MODE & 2) ? p[8 * s + j] : __builtin_amdgcn_exp2f(p[8 * s + j]);
    const float g0 = __builtin_fmaf(aw.b3, e[3], __builtin_fmaf(aw.b2, e[2], __builtin_fmaf(aw.b1, e[1], e[0])));
    const float g1 = __builtin_fmaf(aw.b3, e[7], __builtin_fmaf(aw.b2, e[6], __builtin_fmaf(aw.b1, e[5], e[4])));
    lsum = __builtin_fmaf(cks, __builtin_fmaf(aw.a8, g1, g0), lsum);
    u32x4 w; w.x = pg8::cvt_pk_bf16(e[0], e[1]); w.y = pg8::cvt_pk_bf16(e[2], e[3]); w.z = pg8::cvt_pk_bf16(e[4], e[5]); w.w = pg8::cvt_pk_bf16(e[6], e[7]);
    return w;
}
__device__ __forceinline__ void qk_half(const bf16x8 (&kf)[8], const bf16x8 (&qr)[4], f32x16& p0, f32x16& p1, int half) {
    if (half == 0) {
        p0 = __builtin_amdgcn_mfma_f32_32x32x16_bf16(kf[0], qr[0], f32x16{}, 0, 0, 0); p1 = __builtin_amdgcn_mfma_f32_32x32x16_bf16(kf[1], qr[0], f32x16{}, 0, 0, 0);
        p0 = __builtin_amdgcn_mfma_f32_32x32x16_bf16(kf[2], qr[1], p0, 0, 0, 0); p1 = __builtin_amdgcn_mfma_f32_32x32x16_bf16(kf[3], qr[1], p1, 0, 0, 0);
    } else {
        p0 = __builtin_amdgcn_mfma_f32_32x32x16_bf16(kf[4], qr[2], p0, 0, 0, 0); p1 = __builtin_amdgcn_mfma_f32_32x32x16_bf16(kf[5], qr[2], p1, 0, 0, 0);
        p0 = __builtin_amdgcn_mfma_f32_32x32x16_bf16(kf[6], qr[3], p0, 0, 0, 0); p1 = __builtin_amdgcn_mfma_f32_32x32x16_bf16(kf[7], qr[3], p1, 0, 0, 0);
    }
}
__device__ __forceinline__ void softmax_head2(f32x16 (&o)[4], float& lsum, f32x16& p0, f32x16& p1, float& c, bool band, int kb, int qrel) {
    if (band) {
#pragma unroll
        for (int r = 0; r < 16; ++r) { const int kv = kb + (r & 3) + 8 * (r >> 2); if (kv > qrel) p0[r] = -INFINITY; if (kv + 32 > qrel) p1[r] = -INFINITY; }
    }
    ATT_SB();
    float rm = max3f(p0[0], p0[1], p1[0]), rb = max3f(p0[2], p0[3], p1[1]);
    rm = max3f(rm, p1[2], p1[3]);
#pragma unroll
    for (int r = 4; r < 16; r += 4) { rm = max3f(rm, p0[r], p0[r + 1]); rb = max3f(rb, p0[r + 2], p0[r + 3]); rm = max3f(rm, p1[r], p1[r + 1]); rb = max3f(rb, p1[r + 2], p1[r + 3]); }
    rm = max3f(rm, rb, rb) + c;
    { auto rr = __builtin_amdgcn_permlane32_swap(__float_as_uint(rm), __float_as_uint(rm), false, false); rm = fmaxf(__uint_as_float(rr[0]), __uint_as_float(rr[1])); }
    if (__any(rm > ATT_THR)) {
        const float dl = fmaxf(rm, 0.f), f = __builtin_amdgcn_exp2f(-dl);
        c -= dl; lsum *= f;
#pragma unroll
        for (int d = 0; d < 4; ++d)
#pragma unroll
            for (int r = 0; r < 16; ++r) o[d][r] *= f;
    }
}
__device__ __forceinline__ u32x4 exp_pack2(const f32x16& p, int s, float c, float& lsum, float cks, const AW& aw) {
    float e[8];
#pragma unroll
    for (int j = 0; j < 8; ++j) e[j] = __builtin_amdgcn_exp2f(p[8 * s + j] + c);
    const float g0 = __builtin_fmaf(aw.b3, e[3], __builtin_fmaf(aw.b2, e[2], __builtin_fmaf(aw.b1, e[1], e[0])));
    const float g1 = __builtin_fmaf(aw.b3, e[7], __builtin_fmaf(aw.b2, e[6], __builtin_fmaf(aw.b1, e[5], e[4])));
    lsum = __builtin_fmaf(cks, __builtin_fmaf(aw.a8, g1, g0), lsum);
    u32x4 w; w.x = pg8::cvt_pk_bf16(e[0], e[1]); w.y = pg8::cvt_pk_bf16(e[2], e[3]); w.z = pg8::cvt_pk_bf16(e[4], e[5]); w.w = pg8::cvt_pk_bf16(e[6], e[7]);
    return w;
}
struct ESl { float g0, g1; };
__device__ __forceinline__ void exp_slice(ESl& x, u32x4& w, const f32x16& p, int s, int d, float c, const AW& aw) {
    const float a = __builtin_amdgcn_exp2f(p[8 * s + 2 * d] + c), b = __builtin_amdgcn_exp2f(p[8 * s + 2 * d + 1] + c);
    const unsigned pk = pg8::cvt_pk_bf16(a, b);
    if (d == 0) { w.x = pk; x.g0 = __builtin_fmaf(aw.b1, b, a); } else if (d == 1) { w.y = pk; x.g0 = __builtin_fmaf(aw.b3, b, __builtin_fmaf(aw.b2, a, x.g0)); }
    else if (d == 2) { w.z = pk; x.g1 = __builtin_fmaf(aw.b1, b, a); } else { w.w = pk; x.g1 = __builtin_fmaf(aw.b3, b, __builtin_fmaf(aw.b2, a, x.g1)); }
}
#define ATT_PIN1(v) asm volatile("" : "+v"(v))
__device__ __forceinline__ void pv_exp_step(f32x16 (&o)[4], const u32x4& pwk, bf16x8 (&buf)[8], int half, lptr vp, int vks, u32x4& wn, const f32x16& pnx, int s, float c, float& lsum, float cks, const AW& aw) {
    const bf16x8 pb = __builtin_bit_cast(bf16x8, pwk); ESl x;
#pragma unroll
    for (int d = 0; d < 4; ++d) {
        o[d] = __builtin_amdgcn_mfma_f32_32x32x16_bf16(buf[4 * half + d], pb, o[d], 0, 0, 0);
        exp_slice(x, wn, pnx, s, d, c, aw);
        if (vks >= 0) buf[4 * half + d] = vfrag(vp, vks, d);
        if (d == 3) lsum = __builtin_fmaf(cks, __builtin_fmaf(aw.a8, x.g1, x.g0), lsum);
        if (d == 0) ATT_PIN1(wn.x); else if (d == 1) ATT_PIN1(wn.y); else if (d == 2) ATT_PIN1(wn.z); else { ATT_PIN1(wn.w); ATT_PIN1(lsum); }
        ATT_SB();
    }
}
__device__ __forceinline__ void qk_exp_half(const bf16x8 (&kf)[8], const bf16x8 (&qr)[4], f32x16& p0, f32x16& p1, bool nxt, u32x4& wn, const f32x16& pcur, float c, float& lsum, const AW& aw) {
    ESl x;
#pragma unroll
    for (int d = 0; d < 4; ++d) {
        if (nxt) { if (d == 0) p0 = __builtin_amdgcn_mfma_f32_32x32x16_bf16(kf[4], qr[2], p0, 0, 0, 0); else if (d == 1) p1 = __builtin_amdgcn_mfma_f32_32x32x16_bf16(kf[5], qr[2], p1, 0, 0, 0);
                   else if (d == 2) p0 = __builtin_amdgcn_mfma_f32_32x32x16_bf16(kf[6], qr[3], p0, 0, 0, 0); else p1 = __builtin_amdgcn_mfma_f32_32x32x16_bf16(kf[7], qr[3], p1, 0, 0, 0); }
        exp_slice(x, wn, pcur, 0, d, c, aw);
        if (d == 3) lsum = __builtin_fmaf(1.f, __builtin_fmaf(aw.a8, x.g1, x.g0), lsum);
        if (d == 0) ATT_PIN1(wn.x); else if (d == 1) ATT_PIN1(wn.y); else if (d == 2) ATT_PIN1(wn.z); else { ATT_PIN1(wn.w); ATT_PIN1(lsum); }
        ATT_SB();
    }
}
template <int MODE> __device__ __forceinline__ void attn_unit(LAS unsigned char* lds, const bf16* PROJ, const bf16* KVP, bf16* AB, const float* gsub, float lam, int bh, int qb, float dq2, int tid) {
    const int lane = tid & 63, r32 = lane & 31, hi = lane >> 5, g = (lane >> 4) & 1, qq = (lane & 15) >> 2, pp = lane & 3;
    const int wid = __builtin_amdgcn_readfirstlane(tid >> 6), map = wid >> 2, qblk = wid & 3;
    const int b = bh >> 2, h = bh & 3, q0 = qb * 128;
    const size_t rowbase = (size_t)b * SEQ;
    const float sl2 = alibi_sl2(h);
    const unsigned lds0 = (unsigned)(uintptr_t)lds;
    const char* kvw = (const char*)(KVP + (size_t)bh * 128 * 16384) + wid * 1024;
    const unsigned lane16 = (unsigned)lane * 16u;
#define ATT_DMA_K(t, kslot) do { const char* _g = kvw + (size_t)(t) * 32768; const unsigned _k = lds0 + (kslot) * KSLOT + wid * 1024; \
        glds16s(_g, lane16, (unsigned)__builtin_amdgcn_readfirstlane(_k)); glds16s(_g + 8192, lane16, (unsigned)__builtin_amdgcn_readfirstlane(_k + L_K2)); } while (0)
#define ATT_DMA_V(t, vslot) do { const char* _g = kvw + (size_t)(t) * 32768 + 16384; const unsigned _v = lds0 + L_V + (vslot) * VSLOT + wid * 1024; \
        glds16s(_g, lane16, (unsigned)__builtin_amdgcn_readfirstlane(_v)); glds16s(_g + 8192, lane16, (unsigned)__builtin_amdgcn_readfirstlane(_v + 8192)); } while (0)
    const int NT = 2 * (qb + 1);
    int t0 = 0;
#if ATT_SKIP
    { const float dneed = (152.f + dq2) / sl2;
      const int tq = (int)__builtin_floorf(((float)q0 - dneed - 63.f) * (1.f / 64.f)) + 1;
      t0 = __builtin_amdgcn_readfirstlane(tq > 0 ? tq : 0); }
#endif
    ATT_DMA_K(t0, 0); ATT_DMA_V(t0, 0); ATT_DMA_K(t0 + 1, 1); ATT_DMA_V(t0 + 1, 1);
    if (t0 + 2 < NT) { ATT_DMA_K(t0 + 2, 2); ATT_DMA_V(t0 + 2, 2); }
    const bf16* Qw = PROJ + (rowbase + q0 + 32 * qblk + r32) * PP + (map ? C_Q2 : C_Q1) + h * HD;
    bf16x8 qr[4];
#pragma unroll
    for (int d0 = 0; d0 < 4; ++d0) qr[d0] = *(const bf16x8*)(Qw + d0 * 16 + hi * 8);
    auto uni = [](float x) { return __builtin_bit_cast(float, __builtin_amdgcn_readfirstlane(__builtin_bit_cast(int, x))); };
    const AW aw = {uni(__builtin_amdgcn_exp2f(sl2)), uni(__builtin_amdgcn_exp2f(2.f * sl2)), uni(__builtin_amdgcn_exp2f(3.f * sl2)), uni(__builtin_amdgcn_exp2f(8.f * sl2)),
                   uni(__builtin_amdgcn_exp2f(16.f * sl2)), uni(__builtin_amdgcn_exp2f(32.f * sl2)), uni(__builtin_amdgcn_exp2f(48.f * sl2))};
    const float whi = __builtin_amdgcn_exp2f(sl2 * (float)(4 * hi - 63));
    float lsum = 0.f;
    f32x16 o[4];
#pragma unroll
    for (int d = 0; d < 4; ++d) o[d] = f32x16{};
    float cinit = sl2 * 63.f;
    const float shift = 64.f * sl2;
    const int qrel = 32 * qblk + r32;
    const lptr ldsc = (lptr)lds;
    const lptr vp0 = ldsc + L_V + (4 * hi + qq) * 64 + (16 * g + 4 * pp) * 2;
    const lptr kp0 = ldsc + (map ? L_K2 : 0) + hi * 1024 + r32 * 16;
    u32x4 pw[4];
#pragma unroll
    for (int i = 0; i < 4; ++i) pw[i] = (u32x4){0u, 0u, 0u, 0u};
    bf16x8 hold[8], tmp[8];
    int sl_cur = 0;
    asm volatile("" : "+v"(qr[0]), "+v"(qr[1]), "+v"(qr[2]), "+v"(qr[3]));
    ATT_WAIT_BAR();
    f32x16 pA0, pA1, pB0, pB1;
    kload8(hold, kp0);
    qk_half(hold, qr, pA0, pA1, 0); qk_half(hold, qr, pA0, pA1, 1);
    auto step = [&](int t, f32x16& pc0, f32x16& pc1, f32x16& pn0, f32x16& pn1) __attribute__((always_inline)) {
        if (t > t0) { if (t + 2 < NT) ATT_WAIT_BAR4(); else ATT_WAIT_BAR(); }
        const bool nxt = (t + 1 < NT), band = (t >= NT - 2); const int kb = 64 * (t - (NT - 2)) + 4 * hi;
        const lptr vp = vp0 + sl_cur * VSLOT;
        if (nxt) kload4(hold, kp0 + ((sl_cur + 1) & 3) * KSLOT, 0);
        vload4(tmp, 0, vp, 0); vload4(tmp, 1, vp, 1);
        ATT_SB();
        if (nxt) qk_half(hold, qr, pn0, pn1, 0);
        if (nxt) kload4(hold, kp0 + ((sl_cur + 1) & 3) * KSLOT, 1);
        ATT_SB();
        softmax_head2(o, lsum, pc0, pc1, cinit, band, kb, qrel);
        ATT_SB();
        if (t + 3 < NT) { ATT_DMA_K(t + 3, (sl_cur + 3) & 3); ATT_DMA_V(t + 3, (sl_cur + 3) & 3); }
        ATT_SB();
        { u32x4 wa, wb;
        qk_exp_half(hold, qr, pn0, pn1, nxt, wa, pc0, cinit, lsum, aw);
        pv_exp_step(o, wa, tmp, 0, vp, 2, wb, pc0, 1, cinit, lsum, aw.c1, aw);
        pv_exp_step(o, wb, tmp, 1, vp, 3, wa, pc1, 0, cinit, lsum, aw.c2, aw);
        pv_exp_step(o, wa, tmp, 0, vp, -1, wb, pc1, 1, cinit, lsum, aw.c3, aw);
        pv_step(o, wb, tmp, 1); ATT_SB(); }
        cinit += shift;
        sl_cur = (sl_cur + 1) & 3;
    };
    for (int t = t0; t < NT; t += 2) { step(t, pA0, pA1, pB0, pB1); if (t + 1 < NT) step(t + 1, pB0, pB1, pA0, pA1); }
    float rl;
    { const float lw = lsum * whi; auto rr = __builtin_amdgcn_permlane32_swap(__float_as_uint(lw), __float_as_uint(lw), false, false); rl = __builtin_amdgcn_rcpf(__uint_as_float(rr[0]) + __uint_as_float(rr[1])); }
    ATT_WAIT_BAR();
    LAS float* xch = (LAS float*)(lds + qblk * 16384) + lane;
    if (map == 1) {
#pragma unroll
        for (int d = 0; d < 4; ++d)
#pragma unroll
            for (int r = 0; r < 16; ++r) xch[(d * 16 + r) * 64] = o[d][r] * rl;
    }
    ATT_WAIT_BAR();
    if (map == 0) {
        float ss = 0.f;
#pragma unroll
        for (int d = 0; d < 4; ++d)
#pragma unroll
            for (int r = 0; r < 16; ++r) { const float a = o[d][r] * rl - lam * xch[(d * 16 + r) * 64]; o[d][r] = a; ss += a * a; }
        ss += __shfl_xor(ss, 32);
        const float rstd = rsqrtf(ss * (1.f / DV) + SUBLN_EPS) * (1.f - LAM_INIT);
        bf16* dst = AB + (rowbase + q0 + 32 * qblk + r32) * 512 + h * DV + 8 * hi;
#pragma unroll
        for (int d = 0; d < 4; ++d)
#pragma unroll
            for (int pq = 0; pq < 2; ++pq) { u32x2 w[2];
#pragma unroll
                for (int e = 0; e < 2; ++e) { const int gq = 2 * pq + e; const f32x4 gg = *(const f32x4*)(gsub + 32 * d + 8 * gq + 4 * hi);
                    w[e].x = pg8::cvt_pk_bf16(o[d][4 * gq] * rstd * gg[0], o[d][4 * gq + 1] * rstd * gg[1]); w[e].y = pg8::cvt_pk_bf16(o[d][4 * gq + 2] * rstd * gg[2], o[d][4 * gq + 3] * rstd * gg[3]); }
                auto rx = __builtin_amdgcn_permlane32_swap(w[0].x, w[1].x, false, false); auto ry = __builtin_amdgcn_permlane32_swap(w[0].y, w[1].y, false, false);
                *(u32x4*)(dst + 32 * d + 16 * pq) = (u32x4){rx[0], ry[0], rx[1], ry[1]}; }
    }
    ATT_WAIT_BAR();
#undef ATT_DMA_K
#undef ATT_DMA_V
}
template <int MODE> __device__ __forceinline__ void attn_phase(LAS unsigned char* lds, const bf16* PROJ, const bf16* KVP, const unsigned* KN, bf16* AB, const float* gsub, const float* lq1, const float* lk1, const float* lq2, const float* lk2, int vcu, int G, int tid, unsigned* aq = nullptr) {
    const int lane = tid & 63;
    const float lam = __expf(wave_sum(lq1[lane] * lk1[lane])) - __expf(wave_sum(lq2[lane] * lk2[lane])) + LAM_INIT;
    auto bound = [&](int bh) { float dq2 = 0.f;
#pragma unroll
        for (int mp = 0; mp < 2; ++mp) { const float kn = __uint_as_float(__hip_atomic_load(KN + bh * 2 + mp, __ATOMIC_RELAXED, __HIP_MEMORY_SCOPE_AGENT)), qn = __uint_as_float(__hip_atomic_load(KN + 64 + bh * 2 + mp, __ATOMIC_RELAXED, __HIP_MEMORY_SCOPE_AGENT));
            dq2 = fmaxf(dq2, 2.f * __builtin_sqrtf(2.f * qn) * __builtin_sqrtf(2.f * kn) * 1.0001f); }
        return dq2; };
    LAS int* slot = (LAS int*)(lds + 131072 + 768);
    for (int v = vcu; v < 256; v += G) {
        const int b = v >> 5, w = v & 31;
        for (int it = 0;; ++it) {
            int h, qb;
            if (aq) {
                if (tid == 0) *slot = (int)__hip_atomic_fetch_add(aq, 1u, __ATOMIC_RELAXED, __HIP_MEMORY_SCOPE_AGENT);
                __syncthreads();
                const int u = __builtin_amdgcn_readfirstlane(*slot);
                if (u >= 256) break;
                h = 3 - (u >> 6); qb = 63 - (u & 63);
            } else { if (it >= 8) break; h = (it & 1) ? 3 - (it >> 1) : (it >> 1); qb = (it & 4) ? 63 - w : w; }
            const int bh = b * 4 + h;
            attn_unit<MODE>(lds, PROJ, KVP, AB, gsub, lam, bh, qb, bound(bh), tid);
        }
    }
}
}

constexpr int NWAVES = 8;
constexpr int RING_OFF = 0, RING_BYTES = 131072;
constexpr int LDSCTL_OFF = RING_BYTES, MISC_OFF = LDSCTL_OFF + 320;
constexpr int LDS_BYTES = 159744;
constexpr size_t CTL_ZERO_BYTES = 1 * MiB;
constexpr int CW_BAR = 4096;
constexpr int CW_AQ = 2048;
constexpr int CW_MIS = 1024;
constexpr int CW_KN = 32768;
constexpr int N_PHASES = 10;
constexpr int HALO_OFF = RING_BYTES + 1024;
constexpr int MAX_LAUNCH = 4;
static_assert((CW_BAR + MAX_LAUNCH * XCD_BAR_WORDS) * 4 <= (int)CTL_ZERO_BYTES, "barrier words inside the memset region");
static_assert(HALO_OFF + 2048 + 2 * 4096 + 16384 <= LDS_BYTES, "halo + conv weight tables + rstd partials inside the LDS allocation");

struct Frame {
    LAS unsigned char* lds; volatile LAS unsigned* MISC; gu32* ctl;
    int tid, lane, wave, vcu, G;
};

__device__ __forceinline__ void p0_transpose_item(const float* W, int K, int N, bf16* WT, const float* rs, int mode, LAS float* scr, int item, int lane) {
    const int nblk = N / 32, kb = item / nblk, nb = item % nblk, k0 = 64 * kb, n0 = 32 * nb, s0 = wt_src_col(n0, mode);
#pragma unroll
    for (int i = 0; i < 8; ++i) { const int kk = 8 * i + (lane >> 3), c4 = (lane & 7) * 4; const float s = rs ? rs[k0 + kk] : 1.f;
        const f32x4 v = *(const f32x4*)(W + (size_t)(k0 + kk) * N + s0 + c4) * s; LAS float* d = scr + kk * 33 + c4; d[0] = v.x; d[1] = v.y; d[2] = v.z; d[3] = v.w; }
    LDS_WAIT(); asm volatile("" ::: "memory");
    const int c = lane & 7;
#pragma unroll
    for (int j = 0; j < 4; ++j) { const int n = (lane >> 3) + 8 * j; const LAS float* s = scr + (8 * c) * 33 + n;
        u32x4 o; o.x = pk2(s[0 * 33], s[1 * 33]); o.y = pk2(s[2 * 33], s[3 * 33]); o.z = pk2(s[4 * 33], s[5 * 33]); o.w = pk2(s[6 * 33], s[7 * 33]);
        *(u32x4*)(WT + (size_t)(n0 + n) * K + k0 + 8 * c) = o; }
    LDS_WAIT(); asm volatile("" ::: "memory");
}
__device__ __forceinline__ void rms_row_to_bf16(const float* xrow, const float* g, bf16* orow, int lane) {
    const f32x4* xr = (const f32x4*)xrow + lane; f32x4 v[4]; float s = 0.f;
#pragma unroll
    for (int j = 0; j < 4; ++j) { v[j] = xr[64 * j]; s += (v[j].x * v[j].x + v[j].y * v[j].y) + (v[j].z * v[j].z + v[j].w * v[j].w); }
    const float rstd = rsqrtf(wave_sum(s) * (1.f / DM) + NORM_EPS);
    u32x2* o = (u32x2*)orow + lane;
#pragma unroll
    for (int j = 0; j < 4; ++j) { const f32x4 gg = ((const f32x4*)g)[lane + 64 * j];
        u32x2 w; w.x = pk2(v[j].x * rstd * gg.x, v[j].y * rstd * gg.y); w.y = pk2(v[j].z * rstd * gg.z, v[j].w * rstd * gg.w); o[64 * j] = w; }
}

struct Args { const float* in[17]; float* out; unsigned char* ws; int ph_lo, ph_hi, li, opt; };

__global__ void __launch_bounds__(NWAVES * 64, 2) mk_fwd(Args args) {
    extern __shared__ __attribute__((aligned(16))) unsigned char lds[];
    Frame F;
    F.lds = (LAS unsigned char*)lds; F.MISC = (volatile LAS unsigned*)(F.lds + MISC_OFF);
    F.tid = threadIdx.x; F.lane = F.tid & 63; F.wave = __builtin_amdgcn_readfirstlane(F.tid >> 6);
    F.G = gridDim.x; { const int bx = blockIdx.x; F.vcu = (F.G % 8 == 0) ? (bx % 8) * (F.G / 8) + bx / 8 : bx; }
    unsigned char* ws = args.ws;
    F.ctl = (gu32*)(ws + WS_CTL);
    const float* x = args.in[0]; const float* g_mix = args.in[1]; const float* w_in = args.in[2];
    const float* w_dp = args.in[8]; const float* w_rp = args.in[9]; const float* w_out = args.in[10];
    const float* g_ffn = args.in[11]; const float* w_up = args.in[12]; const float* conv_w = args.in[13]; const float* conv_b = args.in[14];
    const float* w_down = args.in[15]; const float* g_final = args.in[16];
    float* out = args.out;
    bf16* WIN = (bf16*)(ws + WS_WIN); bf16* WD = (bf16*)(ws + WS_WD); bf16* WR = (bf16*)(ws + WS_WR); bf16* WO = (bf16*)(ws + WS_WO); bf16* WUP = (bf16*)(ws + WS_WUP); bf16* WDN = (bf16*)(ws + WS_WDN);
    bf16* XN = (bf16*)(ws + WS_XN); bf16* PROJ = (bf16*)(ws + WS_PROJ); bf16* AB = (bf16*)(ws + WS_A); bf16* RB = (bf16*)(ws + WS_R);
    bf16* X1B = (bf16*)(ws + WS_X1B); bf16* GB = (bf16*)(ws + WS_G); bf16* UB = (bf16*)(ws + WS_U); float* SSQ1 = (float*)(ws + WS_SSQ1);
    bf16* KVP = (bf16*)(ws + WS_KVP); bf16* MG = XN; bf16* X2B = XN; float* SSQ2 = (float*)(ws + WS_SSQ2); float* GST = (float*)(ws + WS_GST); float* HB = (float*)(ws + WS_HB);
    for (int u = F.tid; u < (LDS_BYTES - LDSCTL_OFF) / 4; u += NWAVES * 64) ((LAS unsigned*)(F.lds + LDSCTL_OFF))[u] = 0u;
    __syncthreads();
    XcdBarrier bar = xcd_barrier_post((unsigned*)(F.ctl + CW_BAR) + args.li * XCD_BAR_WORDS, F.MISC + 8, F.wave);
    const int lo = args.ph_lo, hi = args.ph_hi;
    if (F.tid == 0 && (bar.x != (blockIdx.x & 7u) || F.G != 256)) atomicOr((unsigned*)(F.ctl + CW_MIS + 64 * args.li), 1u);
    bool local_ok = false;
#define IN(k) (lo <= (k) && (k) < hi)
#define SEAM(k) do { if (IN(k) && IN((k) + 1)) { if (local_ok && (k) != 0 && (k) != 4) xcd_barrier_local(bar); else xcd_barrier(bar); } } while (0)

    if (IN(0)) {
        LAS float* scr = (LAS float*)(F.lds + RING_OFF + F.wave * 16384);
        const int gw = F.vcu * NWAVES + F.wave, NGW = F.G * NWAVES;
        constexpr int I_IN = (DM / 64) * (DIN / 32), I_D = (512 / 64) * (DM / 32), I_O = (DM / 64) * (DM / 32), I_UP = (DM / 64) * (FF2 / 32), I_DN = (FF / 64) * (DM / 32);
        constexpr int NITEMS = I_IN + 2 * I_D + I_O + I_UP + I_DN;
        for (int it = gw; it < NITEMS; it += NGW) {
            int r = it;
            if (r < I_IN) { p0_transpose_item(w_in, DM, DIN, WIN, nullptr, 0, scr, r, F.lane); continue; } r -= I_IN;
            if (r < I_D) { p0_transpose_item(w_dp, 512, DM, WD, nullptr, 0, scr, r, F.lane); continue; } r -= I_D;
            if (r < I_D) { p0_transpose_item(w_rp, 512, DM, WR, nullptr, 0, scr, r, F.lane); continue; } r -= I_D;
            if (r < I_O) { p0_transpose_item(w_out, DM, DM, WO, nullptr, 0, scr, r, F.lane); continue; } r -= I_O;
            if (r < I_UP) { p0_transpose_item(w_up, DM, FF2, WUP, g_ffn, 1, scr, r, F.lane); continue; } r -= I_UP;
            p0_transpose_item(w_down, FF, DM, WDN, nullptr, 0, scr, r, F.lane);
        }
        { float* cs = (float*)(ws + WS_CONV);
          for (int i = (int)blockIdx.x * (NWAVES * 64) + F.tid; i < 4 * FF2; i += F.G * (NWAVES * 64)) { const int row = i / FF2, c = i % FF2;
              cs[i] = ((row < 3) ? conv_w[i] : conv_b[c]) * ((c < FF) ? -LOG2E : -1.f / LOG2E); } }
        for (int m = gw; m < M; m += 2 * NGW) {
            const f32x4* xa = (const f32x4*)(x + (size_t)m * DM) + 2 * F.lane; const int m2 = (m + NGW < M) ? m + NGW : m; const f32x4* xb = (const f32x4*)(x + (size_t)m2 * DM) + 2 * F.lane;
            f32x4 va[4], vb[4]; float sa = 0.f, sb = 0.f;
#pragma unroll
            for (int j = 0; j < 2; ++j) { va[2 * j] = xa[128 * j]; va[2 * j + 1] = xa[128 * j + 1]; vb[2 * j] = xb[128 * j]; vb[2 * j + 1] = xb[128 * j + 1]; }
#pragma unroll
            for (int j = 0; j < 4; ++j) { sa += (va[j].x * va[j].x + va[j].y * va[j].y) + (va[j].z * va[j].z + va[j].w * va[j].w); sb += (vb[j].x * vb[j].x + vb[j].y * vb[j].y) + (vb[j].z * vb[j].z + vb[j].w * vb[j].w); }
            const float ra = rsqrtf(wave_sum(sa) * (1.f / DM) + NORM_EPS), rb = rsqrtf(wave_sum(sb) * (1.f / DM) + NORM_EPS);
            u32x4* oa = (u32x4*)(XN + (size_t)m * DM) + F.lane; u32x4* ob = (u32x4*)(XN + (size_t)m2 * DM) + F.lane;
#pragma unroll
            for (int j = 0; j < 2; ++j) { const f32x4 g0 = ((const f32x4*)g_mix)[2 * F.lane + 128 * j], g1 = ((const f32x4*)g_mix)[2 * F.lane + 128 * j + 1];
                u32x4 w; w.x = pk2(va[2 * j].x * ra * g0.x, va[2 * j].y * ra * g0.y); w.y = pk2(va[2 * j].z * ra * g0.z, va[2 * j].w * ra * g0.w);
                w.z = pk2(va[2 * j + 1].x * ra * g1.x, va[2 * j + 1].y * ra * g1.y); w.w = pk2(va[2 * j + 1].z * ra * g1.z, va[2 * j + 1].w * ra * g1.w); oa[64 * j] = w;
                w.x = pk2(vb[2 * j].x * rb * g0.x, vb[2 * j].y * rb * g0.y); w.y = pk2(vb[2 * j].z * rb * g0.z, vb[2 * j].w * rb * g0.w);
                w.z = pk2(vb[2 * j + 1].x * rb * g1.x, vb[2 * j + 1].y * rb * g1.y); w.w = pk2(vb[2 * j + 1].z * rb * g1.z, vb[2 * j + 1].w * rb * g1.w); ob[64 * j] = w; }
        }
    }
    SEAM(0);
    if (lo == 0 && hi > 1) local_ok = __builtin_amdgcn_readfirstlane((int)xb_ld((unsigned*)(F.ctl + CW_MIS + 64 * args.li))) == 0;
    if (IN(1)) {
        pg8::Gemm g{XN, WIN, M, DIN, DM}; pg8::StaticOrder S; S.init(M, DIN, F.G, (int)blockIdx.x);
        pg8::EpiProj E{PROJ, KVP, (unsigned*)(F.ctl + CW_KN)};
        pg8::gemm_phase<pg8::EpiProj, pg8::StaticOrder, true, true>(F.lds + RING_OFF, g, S, E, F.wave);
    }
    SEAM(1);
    if (IN(2)) { if (!(args.opt & 1)) for (int ui = F.vcu; ui < 256; ui += F.G) ret::ret_group_state(F.lds + RING_OFF, PROJ, GST, ui, F.tid); }
    SEAM(2);
    if (IN(3)) { const int tidL = F.wave * 64 + lane_now();
        if (!(args.opt & 1)) for (int ui = F.vcu; ui < 256; ui += F.G) ret::ret_outputs(F.lds + RING_OFF, PROJ, GST, RB, ui ^ 7, tidL);
        if (!(args.opt & 2)) attn::attn_phase<0>(F.lds + RING_OFF, PROJ, KVP, (const unsigned*)(F.ctl + CW_KN), AB, args.in[7], args.in[3], args.in[4], args.in[5], args.in[6], F.vcu, F.G, tidL, (F.G == 256) ? (unsigned*)(F.ctl + CW_AQ + 64 * (8 * args.li + (int)(blockIdx.x & 7))) : nullptr);
#ifdef PROBE_MODE
        if (args.opt & 4) attn::attn_phase<PROBE_MODE>(F.lds + RING_OFF, PROJ, KVP, (const unsigned*)(F.ctl + CW_KN), XN, args.in[7], args.in[3], args.in[4], args.in[5], args.in[6], F.vcu, F.G, tidL);
#endif
    }
    SEAM(3);
    if (IN(4)) {
        pg8::Gemm g{AB, WD, M, DM, 512, RB, WR}; pg8::DualOrder S; S.init(M, DM, F.G, (int)blockIdx.x);
        pg8::EpiMerge2 E{PROJ, MG};
        pg8::gemm_phase<pg8::EpiMerge2, pg8::DualOrder, true, true>(F.lds + RING_OFF, g, S, E, F.wave);
    }
    SEAM(4);
    if (IN(5)) {
        pg8::Gemm g{MG, WO, M, DM, DM}; pg8::StaticOrder S; S.init(M, DM, F.G, (int)blockIdx.x);
        pg8::EpiOutProj E{x, X1B, SSQ1};
        pg8::gemm_phase<pg8::EpiOutProj, pg8::StaticOrder, true, true>(F.lds + RING_OFF, g, S, E, F.wave);
    }
    SEAM(5);
    if (IN(6)) {
        pg8::Gemm g{X1B, WUP, M, FF2, DM}; pg8::StaticOrder S; S.init(M, FF2, F.G, (int)blockIdx.x);
        pg8::EpiUpConv E{SSQ1, GB, HB, (const float*)(ws + WS_CONV), (const float*)(ws + WS_CONV) + 3 * FF2, (LAS float*)(F.lds + HALO_OFF)};
        pg8::gemm_phase<pg8::EpiUpConv, pg8::StaticOrder, true, true>(F.lds + RING_OFF, g, S, E, F.wave);
    }
    SEAM(6);
    if (IN(7)) {
        const bool gp = (F.G == 256);
        const int nw = gp ? 32 : F.G, w = gp ? (int)(blockIdx.x >> 3) : (int)blockIdx.x, pm0 = gp ? (int)(blockIdx.x & 7) * 32 : 0, npm = gp ? 32 : M / 256;
        const int nit = npm * (FF / 4);
        const int tidL = F.wave * 64 + lane_now();
        for (int it = w * (NWAVES * 64) + tidL; it < nit; it += nw * (NWAVES * 64)) {
            const int pm = pm0 + it / (FF / 4), gc = (it % (FF / 4)) * 4;
            if ((pm & 31) == 0) continue;
            const int uc = (gc >> 7) * 256 + (gc & 127);
            const float* h0 = HB + (size_t)(pm - 1) * 4 * FF2, * h1 = HB + (size_t)pm * 4 * FF2;
            const f32x4 gm2 = *(const f32x4*)(h0 + 2 * FF2 + uc), gm1 = *(const f32x4*)(h0 + 3 * FF2 + uc), g0 = *(const f32x4*)(h1 + uc), g1 = *(const f32x4*)(h1 + FF2 + uc);
            const f32x4 um2 = *(const f32x4*)(h0 + 2 * FF2 + uc + 128), um1 = *(const f32x4*)(h0 + 3 * FF2 + uc + 128), u0 = *(const f32x4*)(h1 + uc + 128), u1 = *(const f32x4*)(h1 + FF2 + uc + 128);
            f32x4 wg[3], wu[3];
            const float* cs = (const float*)(ws + WS_CONV);
#pragma unroll
            for (int k = 0; k < 3; ++k) { wg[k] = *(const f32x4*)(cs + k * FF2 + gc); wu[k] = *(const f32x4*)(cs + k * FF2 + FF + gc); }
            const f32x4 bg = *(const f32x4*)(cs + 3 * FF2 + gc), bu = *(const f32x4*)(cs + 3 * FF2 + FF + gc);
            const f32x4 zg0 = bg + wg[2] * g0 + wg[1] * gm1 + wg[0] * gm2, zu0 = bu + wu[2] * u0 + wu[1] * um1 + wu[0] * um2;
            const f32x4 zg1 = bg + wg[2] * g1 + wg[1] * g0 + wg[0] * gm1, zu1 = bu + wu[2] * u1 + wu[1] * u0 + wu[0] * um1;
            f32x4 r0, r1;
#pragma unroll
            for (int i = 0; i < 4; ++i) { r0[i] = (zg0[i] * zu0[i]) * __builtin_amdgcn_rcpf(1.f + __builtin_amdgcn_exp2f(zg0[i])); r1[i] = (zg1[i] * zu1[i]) * __builtin_amdgcn_rcpf(1.f + __builtin_amdgcn_exp2f(zg1[i])); }
            u32x2 w0, w1; w0.x = pg8::cvt_pk_bf16(r0[0], r0[1]); w0.y = pg8::cvt_pk_bf16(r0[2], r0[3]); w1.x = pg8::cvt_pk_bf16(r1[0], r1[1]); w1.y = pg8::cvt_pk_bf16(r1[2], r1[3]);
            *(u32x2*)(GB + (size_t)pm * 256 * FF + gc) = w0; *(u32x2*)(GB + ((size_t)pm * 256 + 1) * FF + gc) = w1;
        }
    }
    SEAM(7);
    if (IN(8)) {
        pg8::Gemm g{GB, WDN, M, DM, FF}; pg8::StaticOrder S; S.init(M, DM, F.G, (int)blockIdx.x);
        pg8::EpiDown E{X1B, X2B, SSQ2};
        pg8::gemm_phase<pg8::EpiDown, pg8::StaticOrder, true, true>(F.lds + RING_OFF, g, S, E, F.wave);
    }
    SEAM(8);
    if (IN(9)) {
        const int laneL = lane_now();
        const bool gp = (F.G == 256);
        const int gw = (gp ? (int)(blockIdx.x >> 3) : F.vcu) * NWAVES + F.wave, NGW = (gp ? 32 : F.G) * NWAVES, m0 = gp ? (int)(blockIdx.x & 7) * 8192 : 0, nm = gp ? 8192 : M;
        for (int mm = gw; mm < nm; mm += 4 * NGW) {
            u32x4 xv[4][2];
#pragma unroll
            for (int r = 0; r < 4; ++r) { const int m = m0 + ((mm + r * NGW < nm) ? mm + r * NGW : mm); const u32x4* xr = (const u32x4*)(X2B + (size_t)m * DM) + laneL;
                xv[r][0] = xr[0]; xv[r][1] = xr[64]; }
            float q4; { const int rr = laneL >> 4, mr = m0 + ((mm + rr * NGW < nm) ? mm + rr * NGW : mm); q4 = SSQ2[(size_t)mr * 16 + (laneL & 15)]; }
            q4 += __shfl_xor(q4, 1); q4 += __shfl_xor(q4, 2); q4 += __shfl_xor(q4, 4); q4 += __shfl_xor(q4, 8);
#pragma unroll
            for (int r = 0; r < 4; ++r) { const int m = m0 + ((mm + r * NGW < nm) ? mm + r * NGW : mm);
                const float rstd = rsqrtf(__shfl(q4, 16 * r) * (1.f / DM) + NORM_EPS);
                f32x4* orow = (f32x4*)(out + (size_t)m * DM) + 2 * laneL;
#pragma unroll
                for (int j = 0; j < 2; ++j) { f32x4 a, b; pg8::unpack8(xv[r][j], a, b);
                    const f32x4 g0 = ((const f32x4*)g_final)[2 * laneL + 128 * j], g1 = ((const f32x4*)g_final)[2 * laneL + 128 * j + 1];
                    orow[128 * j] = a * rstd * g0; orow[128 * j + 1] = b * rstd * g1; } }
        }
    }
#undef IN
#undef SEAM
}

static void launch_mk(Args a, int lo, int hi, int li, int grid, hipStream_t stream, int opt = 0) {
    a.ph_lo = lo; a.ph_hi = hi; a.li = li; a.opt = opt;
    hipLaunchKernelGGL(mk_fwd, dim3(grid), dim3(NWAVES * 64), LDS_BYTES, stream, a);
}
extern "C" void kernel_launch(void* const* d_in, const int* in_sizes, int n_in, void* d_out, int out_size, void* d_ws, size_t ws_size, hipStream_t stream) {
    static int grid = 0;
    if (grid == 0) {
        if (n_in != 17 || out_size != M * DM || ws_size < WS_END) { fprintf(stderr, "kernel_launch: unexpected shapes (n_in %d out %d ws %zu)\n", n_in, out_size, ws_size); grid = -1; return; }
        int dev = 0, cus = 0, per_cu = 0;
        if (hipGetDevice(&dev) != hipSuccess || hipDeviceGetAttribute(&cus, hipDeviceAttributeMultiprocessorCount, dev) != hipSuccess) { grid = -1; return; }
        if (hipFuncSetAttribute((const void*)mk_fwd, hipFuncAttributeMaxDynamicSharedMemorySize, LDS_BYTES) != hipSuccess) { fprintf(stderr, "kernel_launch: hipFuncSetAttribute failed\n"); grid = -1; return; }
        if (hipOccupancyMaxActiveBlocksPerMultiprocessor(&per_cu, (const void*)mk_fwd, NWAVES * 64, LDS_BYTES) != hipSuccess || per_cu < 1) { fprintf(stderr, "kernel_launch: occupancy query says %d\n", per_cu); }
        (void)hipGetLastError();
        grid = cus;
    }
    if (grid < 0) return;
    if (hipMemsetAsync((char*)d_ws + WS_CTL, 0, CTL_ZERO_BYTES, stream) != hipSuccess) return;
    unsigned char* ws = (unsigned char*)d_ws;
    Args a{};
    for (int i = 0; i < 17; ++i) a.in[i] = (const float*)d_in[i];
    a.out = (float*)d_out; a.ws = ws;
    launch_mk(a, 0, N_PHASES, 0, grid, stream);
}
```

```cpp
#include <hip/hip_runtime.h>
#include <cstdio>
#include <cstdint>
#include <cmath>

typedef unsigned short bf16;
typedef short bf16x8 __attribute__((ext_vector_type(8)));
typedef float f32x4 __attribute__((ext_vector_type(4)));
typedef float f32x16 __attribute__((ext_vector_type(16)));
typedef unsigned u32x4 __attribute__((ext_vector_type(4)));
typedef unsigned u32x2 __attribute__((ext_vector_type(2)));

constexpr int BATCH = 8, SEQ = 8192, DM = 1024, M = BATCH * SEQ;
constexpr int NH = 4, HD = 64, DV = 128;
constexpr int DIN = 5120, PP = 4096;
constexpr int FF = 2816, FF2 = 5632;
constexpr int C_Q1 = 0, C_Q2 = 256, C_QR = 512, C_KR = 768, C_VR = 1024, C_GR = 1536, C_GA = 2048, C_GB = 3072;
constexpr float LOG2E = 1.4426950408889634f;
constexpr float C2 = 0.125f * LOG2E;
constexpr float NORM_EPS = 1e-6f, SUBLN_EPS = 1e-5f;
constexpr float LAM_INIT = 0.2f;

constexpr size_t MiB = 1u << 20;
constexpr size_t WS_CTL = 0;
constexpr size_t WS_CONV = 512 * 1024;
constexpr size_t WS_SSQ1 = 2 * MiB;
constexpr size_t WS_SSQ2 = 6 * MiB;
constexpr size_t WS_GST = 10 * MiB;
constexpr size_t WS_WIN = 20 * MiB, WS_WD = 30 * MiB, WS_WR = 31 * MiB, WS_WO = 32 * MiB, WS_WUP = 34 * MiB, WS_WDN = 45 * MiB;
constexpr size_t WS_XN = 64 * MiB;
constexpr size_t WS_PROJ = 192 * MiB;
constexpr size_t WS_KVP = 704 * MiB;
constexpr size_t WS_A = 864 * MiB, WS_R = 928 * MiB;
constexpr size_t WS_X1B = 192 * MiB;
constexpr size_t WS_G = 320 * MiB;
constexpr size_t WS_U = 672 * MiB;
constexpr size_t WS_HB = 672 * MiB;
constexpr size_t WS_END = 1024 * MiB;

__device__ __forceinline__ unsigned f2bf(float f) { unsigned u = __builtin_bit_cast(unsigned, f); return (u + 0x7fffu + ((u >> 16) & 1u)) >> 16; }
typedef float pk_f32x2 __attribute__((ext_vector_type(2))); typedef __bf16 pk_bf16x2 __attribute__((ext_vector_type(2)));
__device__ __forceinline__ unsigned pk2(float lo, float hi) { pk_f32x2 v = {lo, hi}; pk_bf16x2 b = __builtin_convertvector(v, pk_bf16x2); return __builtin_bit_cast(unsigned, b); }
__device__ __forceinline__ float bf2f(unsigned short b) { return __builtin_bit_cast(float, (unsigned)b << 16); }
__device__ __forceinline__ float bflo(unsigned w) { return __builtin_bit_cast(float, w << 16); }
__device__ __forceinline__ float bfhi(unsigned w) { return __builtin_bit_cast(float, w & 0xffff0000u); }
__device__ __forceinline__ float wave_sum(float v) {
#pragma unroll
    for (int o = 1; o < 64; o <<= 1) v += __shfl_xor(v, o);
    return v;
}
__device__ __forceinline__ float wave_max(float v) {
#pragma unroll
    for (int o = 1; o < 64; o <<= 1) v = fmaxf(v, __shfl_xor(v, o));
    return v;
}
__device__ __forceinline__ float sigmoidf_(float x) { return 1.f / (1.f + __expf(-x)); }
__device__ __forceinline__ float siluf_(float x) { return x / (1.f + __expf(-x)); }
__device__ __forceinline__ float alibi_sl2(int h) { return h == 0 ? 0.36067376022224085f : h == 1 ? 0.09016844005556021f : h == 2 ? 0.022542110013890053f : 0.005635527503472513f; }
__device__ __forceinline__ float ret_lg2(int h) { return h == 0 ? -0.04580368961312479f : h == 1 ? -0.02272007650008353f : h == 2 ? -0.011315313227834146f : -0.005646563141142063f; }

__device__ __forceinline__ int wt_src_col(int n, int mode) {
    if (mode == 0) return n;
    const int t = n >> 8, w = n & 255;
    return (w < 128) ? (t * 128 + w) : (FF + t * 128 + (w - 128));
}
__device__ __forceinline__ int lane_now() { int l; asm volatile("v_mbcnt_lo_u32_b32 %0, -1, 0\n\tv_mbcnt_hi_u32_b32 %0, -1, %0" : "=v"(l)); return l; }
namespace pg8 {
#define PG8_LAS __attribute__((address_space(3)))
typedef unsigned short bf16_t;
typedef short bf16x8 __attribute__((ext_vector_type(8)));
typedef float f32x4 __attribute__((ext_vector_type(4)));
typedef unsigned u32x4 __attribute__((ext_vector_type(4)));
constexpr int BM = 256, BK = 64, HALF = 128, HTB = HALF * BK * 2  , STAGE_BYTES = 8 * HTB, NXCD = 8, WGM = 8;

__host__ __device__ __forceinline__ int lds_byte(int r, int c) { const int st = (r >> 4) * 2 + (c >> 5), rr = r & 15, cc = c & 31, ob = rr * 64 + cc * 2; return st * 1024 + (ob ^ (((ob >> 9) & 1) << 5)); }
__host__ __device__ __forceinline__ void stage_rc(int b, int& R, int& C) { const int st = b / 1024, sb = b % 1024, swz = sb ^ (((sb >> 9) & 1) << 5); R = (st >> 1) * 16 + swz / 64; C = (st & 1) * 32 + (swz % 64) / 2; }
__host__ __device__ __forceinline__ int perm32(int rho) { const int n = rho >> 4, i = rho & 15; return 8 * (i >> 2) + 4 * n + (i & 3); }

struct Unit { int pm, pn, seg; };
struct Gemm { const bf16_t* A; const bf16_t* Bt; int M, N, K; const bf16_t* A2; const bf16_t* Bt2; };

struct StaticOrder {
    int nM, nN, nwg, G, c;
    __host__ __device__ void init(int M, int N, int G_, int c_) { nM = M / BM; nN = N / BM; nwg = nM * nN; G = G_; c = c_; }
    __host__ __device__ bool next(int i, Unit& u) const {
        const long L = (long)i * G + c; if (L >= nwg) return false;
        int wgid = (int)L; { const int q = nwg / NXCD, r = nwg % NXCD, xcd = wgid % NXCD, off = wgid / NXCD; wgid = (xcd < r ? xcd * (q + 1) : r * (q + 1) + (xcd - r) * q) + off; }
        const int nig = WGM * nN, gid = wgid / nig, fm = gid * WGM, gsz = (nM - fm) < WGM ? (nM - fm) : WGM;
        u.pm = fm + ((wgid % nig) % gsz); u.pn = (wgid % nig) / gsz; u.seg = 0; return true;
    }
    __device__ __forceinline__ void a_ready(const Unit&) const {}
    __device__ __forceinline__ void done(const Unit&) const {}
};

struct DualOrder {
    StaticOrder S;
    __host__ __device__ void init(int M, int N, int G_, int c_) { S.init(M, N, G_, c_); }
    __host__ __device__ bool next(int i, Unit& u) const { if (!S.next(i >> 1, u)) return false; u.seg = i & 1; return true; }
    __device__ __forceinline__ void a_ready(const Unit&) const {}
    __device__ __forceinline__ void done(const Unit&) const {}
};

typedef float f32x2 __attribute__((ext_vector_type(2))); typedef __bf16 bf16x2_t __attribute__((ext_vector_type(2)));
__device__ __forceinline__ unsigned cvt_pk_bf16(float lo, float hi) { f32x2 v = {lo, hi}; bf16x2_t b = __builtin_convertvector(v, bf16x2_t); return __builtin_bit_cast(unsigned, b); }
__device__ __forceinline__ float fast_sigmoid(float x) { return __builtin_amdgcn_rcpf(1.f + __builtin_amdgcn_exp2f(-1.4426950408889634f * x)); }
__device__ __forceinline__ u32x4 pack8(const f32x4 a, const f32x4 b) { u32x4 w; w.x = cvt_pk_bf16(a[0], a[1]); w.y = cvt_pk_bf16(a[2], a[3]); w.z = cvt_pk_bf16(b[0], b[1]); w.w = cvt_pk_bf16(b[2], b[3]); return w; }
__device__ __forceinline__ void unpack8(const u32x4 w, f32x4& a, f32x4& b) {
    a[0] = __builtin_bit_cast(float, w.x << 16); a[1] = __builtin_bit_cast(float, w.x & 0xffff0000u); a[2] = __builtin_bit_cast(float, w.y << 16); a[3] = __builtin_bit_cast(float, w.y & 0xffff0000u);
    b[0] = __builtin_bit_cast(float, w.z << 16); b[1] = __builtin_bit_cast(float, w.z & 0xffff0000u); b[2] = __builtin_bit_cast(float, w.w << 16); b[3] = __builtin_bit_cast(float, w.w & 0xffff0000u); }

__device__ __forceinline__ unsigned sig4_u8(const f32x4 v) { unsigned w = 0u;
#pragma unroll
    for (int i = 0; i < 4; ++i) { const float e = __builtin_amdgcn_exp2f(-1.4426950408889634f * v[i]); const unsigned q = (unsigned)(__builtin_amdgcn_rcpf(__builtin_fmaf(e, 1.f / 255.f, 1.f / 255.f)) + 0.5f); w |= q << (8 * i); }
    return w; }
__device__ __forceinline__ f32x4 u8x4_f32(const unsigned w) { return (f32x4){(float)(w & 255u), (float)((w >> 8) & 255u), (float)((w >> 16) & 255u), (float)(w >> 24)} * (1.f / 255.f); }
#define NT_ST(ptr, val) __builtin_nontemporal_store((val), (ptr))
#define NT_LD(ptr) __builtin_nontemporal_load(ptr)
struct EpiProj {
    static constexpr bool PERM = true, AFTER_DRAIN = false, PERMA = false, PREFETCH = false, DUAL = false;
    bf16_t* P; bf16_t* KV; unsigned* KN;
    __device__ __forceinline__ void operator()(const f32x4 (&acc)[2][2][4][2], const Unit& u, int wr, int wc, int fr, int fq) const {
        const int pn = u.pn, pm = u.pm;
        if (pn >= 2 && pn < 6) {
            const size_t tile0 = ((size_t)(pm >> 5) * 4 * 128 + (size_t)((pm & 31) * 4 + wr)) * 16384;
            if (pn < 4) {
#pragma unroll
                for (int bj = 0; bj < 2; ++bj) { bf16_t* hb = KV + tile0 + (size_t)(2 * bj + (wc >> 1)) * 128 * 16384 + (pn == 3 ? 4096 : 0) + ((wc & 1) * 4 + fq) * 512 + fr * 8;
#pragma unroll
                    for (int ai = 0; ai < 2; ++ai)
#pragma unroll
                        for (int m = 0; m < 4; ++m) *(u32x4*)(hb + (size_t)ai * 2 * 16384 + m * 128) = pack8(acc[ai][bj][m][0], acc[ai][bj][m][1]); }
#pragma unroll
                for (int bj = 0; bj < 2; ++bj) { float hm = 0.f;
#pragma unroll
                    for (int ai = 0; ai < 2; ++ai)
#pragma unroll
                        for (int m = 0; m < 4; ++m) { const f32x4 a = acc[ai][bj][m][0], b = acc[ai][bj][m][1];
                            float q = (a[0] * a[0] + a[1] * a[1]) + (a[2] * a[2] + a[3] * a[3]) + (b[0] * b[0] + b[1] * b[1]) + (b[2] * b[2] + b[3] * b[3]);
                            q += __shfl_xor(q, 16); q += __shfl_xor(q, 32); hm = fmaxf(hm, q); }
                    hm = fmaxf(hm, __shfl_xor(hm, 1)); hm = fmaxf(hm, __shfl_xor(hm, 2)); hm = fmaxf(hm, __shfl_xor(hm, 4)); hm = fmaxf(hm, __shfl_xor(hm, 8));
                    if (fr == 0 && fq == 0) atomicMax(KN + ((pm >> 5) * 4 + 2 * bj + (wc >> 1)) * 2 + (pn - 2), __float_as_uint(hm * 1.01f)); }
            } else {
#pragma unroll
                for (int bj = 0; bj < 2; ++bj) { const int head = (pn - 4) * 2 + bj; const float sl = alibi_sl2(head);
                    bf16_t* hb = KV + tile0 + (size_t)head * 128 * 16384 + 8192 + wc * 2048 + fr * 32 + fq * 8;
#pragma unroll
                    for (int m = 0; m < 4; ++m) { const float sc = __builtin_amdgcn_exp2f(sl * (float)((fr + 16 * m) - 63));
#pragma unroll
                        for (int ai = 0; ai < 2; ++ai) *(u32x4*)(hb + (size_t)ai * 2 * 16384 + m * 512) = pack8(acc[ai][bj][m][0] * sc, acc[ai][bj][m][1] * sc); } }
            }
        } else {
            const int cpn = (pn < 2) ? pn : pn - 4;
            bf16_t* base = P + (size_t)(pm * BM + wr * 64 + fr) * PP + cpn * BM + wc * 32 + 8 * fq;
            if (pn >= 12) {
                unsigned char* gq = (unsigned char*)(P + (size_t)(pm * BM + wr * 64 + fr) * PP + C_GA) + (pn - 12) * 256 + wc * 64 + fq * 16;
#pragma unroll
                for (int ai = 0; ai < 2; ++ai)
#pragma unroll
                    for (int m = 0; m < 4; ++m) { u32x4 w; w.x = sig4_u8(acc[ai][0][m][0]); w.y = sig4_u8(acc[ai][0][m][1]); w.z = sig4_u8(acc[ai][1][m][0]); w.w = sig4_u8(acc[ai][1][m][1]);
                        NT_ST((u32x4*)(gq + (size_t)(ai * HALF + m * 16) * (PP * 2)), w); }
            } else if (pn >= 10) {
#pragma unroll
                for (int ai = 0; ai < 2; ++ai)
#pragma unroll
                    for (int m = 0; m < 4; ++m)
#pragma unroll
                        for (int bj = 0; bj < 2; ++bj) { f32x4 a = acc[ai][bj][m][0], b = acc[ai][bj][m][1];
#pragma unroll
                            for (int i = 0; i < 4; ++i) { a[i] *= fast_sigmoid(a[i]); b[i] *= fast_sigmoid(b[i]); }
                            NT_ST((u32x4*)(base + (size_t)(ai * HALF + m * 16) * PP + bj * HALF), pack8(a, b)); }
            } else {
            const float sc = (pn < 2) ? C2 : (pn == 7) ? 0.125f : 1.f;
#pragma unroll
            for (int ai = 0; ai < 2; ++ai)
#pragma unroll
                for (int m = 0; m < 4; ++m)
#pragma unroll
                    for (int bj = 0; bj < 2; ++bj) NT_ST((u32x4*)(base + (size_t)(ai * HALF + m * 16) * PP + bj * HALF), pack8(acc[ai][bj][m][0] * sc, acc[ai][bj][m][1] * sc));
            if (pn < 2) {
#pragma unroll
                for (int bj = 0; bj < 2; ++bj) { float hm = 0.f;
#pragma unroll
                    for (int ai = 0; ai < 2; ++ai)
#pragma unroll
                        for (int m = 0; m < 4; ++m) { const f32x4 a = acc[ai][bj][m][0], b = acc[ai][bj][m][1];
                            float q = (a[0] * a[0] + a[1] * a[1]) + (a[2] * a[2] + a[3] * a[3]) + (b[0] * b[0] + b[1] * b[1]) + (b[2] * b[2] + b[3] * b[3]);
                            q += __shfl_xor(q, 16); q += __shfl_xor(q, 32); hm = fmaxf(hm, q); }
                    hm = fmaxf(hm, __shfl_xor(hm, 1)); hm = fmaxf(hm, __shfl_xor(hm, 2)); hm = fmaxf(hm, __shfl_xor(hm, 4)); hm = fmaxf(hm, __shfl_xor(hm, 8));
                    if (fr == 0 && fq == 0) atomicMax(KN + 64 + ((pm >> 5) * 4 + 2 * bj + (wc >> 1)) * 2 + pn, __float_as_uint(hm * (C2 * C2) * 1.01f)); }
            }
            }
        }
    }
};
struct EpiMerge2 {
    static constexpr bool PERM = true, AFTER_DRAIN = false, PERMA = false, PREFETCH = false, DUAL = true;
    const bf16_t* P; bf16_t* MG;
    mutable u32x4 keep[8];
    static __device__ __forceinline__ f32x4 u8f(const unsigned w) { return (f32x4){(float)(w & 255u), (float)((w >> 8) & 255u), (float)((w >> 16) & 255u), (float)(w >> 24)}; }
    static __device__ __forceinline__ f32x4 max1(const f32x4 v) { return (f32x4){fmaxf(v[0], 1.f), fmaxf(v[1], 1.f), fmaxf(v[2], 1.f), fmaxf(v[3], 1.f)}; }
    __device__ __forceinline__ void mid(f32x4 (&acc)[2][2][4][2], const Unit& u, int wr, int wc, int fr, int fq) const {
        const unsigned char* gq = (const unsigned char*)(P + (size_t)(u.pm * BM + wr * 64 + fr) * PP + C_GA) + u.pn * 256 + wc * 64 + fq * 16;
#pragma unroll
        for (int ai = 0; ai < 2; ++ai)
#pragma unroll
            for (int m = 0; m < 4; ++m) { const u32x4 wa = NT_LD((const u32x4*)(gq + (size_t)(ai * HALF + m * 16) * (PP * 2))), wq = NT_LD((const u32x4*)(gq + 1024 + (size_t)(ai * HALF + m * 16) * (PP * 2)));
                keep[ai * 4 + m] = wq;
#pragma unroll
                for (int bj = 0; bj < 2; ++bj)
#pragma unroll
                    for (int n = 0; n < 2; ++n) { const unsigned da = bj ? (n ? wa.w : wa.z) : (n ? wa.y : wa.x), dr = bj ? (n ? wq.w : wq.z) : (n ? wq.y : wq.x);
                        const f32x4 qa = u8f(da), qr = max1(u8f(dr));
#pragma unroll
                        for (int i = 0; i < 4; ++i) acc[ai][bj][m][n][i] *= qa[i] * __builtin_amdgcn_rcpf(qr[i]); } }
    }
    __device__ __forceinline__ void operator()(const f32x4 (&acc)[2][2][4][2], const Unit& u, int wr, int wc, int fr, int fq) const {
        const int row0 = u.pm * BM + wr * 64 + fr, col0 = u.pn * BM + wc * 32 + 8 * fq;
        const unsigned char* gq = (const unsigned char*)(P + (size_t)row0 * PP + C_GA) + 1024 + u.pn * 256 + wc * 64 + fq * 16;
#pragma unroll
        for (int ai = 0; ai < 2; ++ai)
#pragma unroll
            for (int m = 0; m < 4; ++m) { const int row = row0 + ai * HALF + m * 16;
                const u32x4 wq = keep[ai * 4 + m];
#pragma unroll
                for (int bj = 0; bj < 2; ++bj) { const f32x4 s0 = max1(u8f(bj ? wq.z : wq.x)) * (1.f / 255.f), s1 = max1(u8f(bj ? wq.w : wq.y)) * (1.f / 255.f);
                    *(u32x4*)(MG + (size_t)row * DM + col0 + bj * HALF) = pack8(acc[ai][bj][m][0] * s0, acc[ai][bj][m][1] * s1); } }
    }
};
__device__ __forceinline__ void store_ssq(float* SSQ, float a, float b, int row0, int slot, int fq) {
    const int ra = row0 + (fq >> 1) * HALF + (fq & 1) * 32;
    SSQ[(size_t)ra * 16 + slot] = a; SSQ[(size_t)(ra + 16) * 16 + slot] = b;
}
struct EpiOutProj {
    static constexpr bool PERM = true, AFTER_DRAIN = false, PERMA = false, PREFETCH = false, DUAL = false;
    const float* X; bf16_t* X1B; float* SSQ;
    __device__ __forceinline__ void operator()(const f32x4 (&acc)[2][2][4][2], const Unit& u, int wr, int wc, int fr, int fq) const {
        const int row0 = u.pm * BM + wr * 64 + fr, col0 = u.pn * BM + wc * 32 + 8 * fq;
        float sa = 0.f, sb = 0.f;
#pragma unroll
        for (int ai = 0; ai < 2; ++ai)
#pragma unroll
            for (int m = 0; m < 4; ++m) { const int row = row0 + ai * HALF + m * 16; float s = 0.f;
#pragma unroll
                for (int bj = 0; bj < 2; ++bj) { const size_t off = (size_t)row * DM + col0 + bj * HALF;
                    const f32x4 v0 = NT_LD((const f32x4*)(X + off)) + acc[ai][bj][m][0], v1 = NT_LD((const f32x4*)(X + off + 4)) + acc[ai][bj][m][1];
                    *(u32x4*)(X1B + off) = pack8(v0, v1);
                    s += (v0[0] * v0[0] + v0[1] * v0[1]) + (v0[2] * v0[2] + v0[3] * v0[3]) + (v1[0] * v1[0] + v1[1] * v1[1]) + (v1[2] * v1[2] + v1[3] * v1[3]); }
                s += __shfl_xor(s, 16); s += __shfl_xor(s, 32); if (((ai * 4 + m) >> 1) == fq) { if (m & 1) sb = s; else sa = s; } }
        store_ssq(SSQ, sa, sb, row0, u.pn * 4 + wc, fq);
    }
};
__device__ __forceinline__ float dpp_shr1(float x) { return __builtin_bit_cast(float, __builtin_amdgcn_update_dpp(0, __builtin_bit_cast(int, x), 0x111, 0xf, 0xf, true)); }
__device__ __forceinline__ f32x4 row_shr1(const f32x4 v) {
    const float a = v[0], b = v[1], c = v[2], d = v[3];
    return (f32x4){dpp_shr1(a), dpp_shr1(b), dpp_shr1(c), dpp_shr1(d)};
}
struct EpiUpConv {
    static constexpr bool PERM = true, AFTER_DRAIN = false, PERMA = true, PREFETCH = true, DUAL = false;
    const float* SSQ; bf16_t* G; float* HB; const float* cw; const float* cb; PG8_LAS float* halo;
    __device__ __forceinline__ void prefetch(const Unit& u, int ui, int wid, int lane) const {
        const int fr = lane & 15, fq = lane >> 4;
#pragma unroll
        for (int i = 0; i < 2; ++i) { const int k = 2 * wid + i;
            __builtin_amdgcn_global_load_lds((const unsigned*)(SSQ + (size_t)(u.pm * BM + (k >> 3) * 128 + fr * 8 + (k & 7)) * 16 + 4 * fq), (PG8_LAS unsigned*)(halo + 2560 + k * 256), 16, 0, 0); }
        const int w = wid & 3, row = 2 * w + (lane >> 5), c = (lane & 31) * 4, gcb = u.pn * HALF;
        const float* src = (row < 6) ? cw + (row >> 1) * FF2 + (row & 1) * FF + gcb + c : cb + (row & 1) * FF + gcb + c;
        __builtin_amdgcn_global_load_lds((const unsigned*)src, (PG8_LAS unsigned*)(halo + 512 + (ui & 1) * 1024 + w * 256), 16, 0, 0);
    }
    __device__ __forceinline__ void operator()(f32x4 (&acc)[2][2][4][2], const Unit& u, int wr, int wc, int fr, int fq, int ui) const {
        const int pn = u.pn, pm = u.pm, tok0 = pm * BM + wr * 128 + fr * 8, cl = wc * 32 + 8 * fq;
        const bool seq_start = (pm & 31) == 0;
        PG8_LAS float* wt = halo + 512 + (ui & 1) * 1024;
#pragma unroll
        for (int ai = 0; ai < 2; ++ai)
#pragma unroll
            for (int m = 0; m < 4; ++m) { const f32x4 a = *(const PG8_LAS f32x4*)(halo + 2560 + ((wr * 8 + 4 * ai + m) * 64 + fq * 16 + fr) * 4);
                float sq = (a[0] + a[1]) + (a[2] + a[3]); sq += __shfl_xor(sq, 16); sq += __shfl_xor(sq, 32);
                const float r = rsqrtf(sq * (1.f / DM) + NORM_EPS);
#pragma unroll
                for (int bj = 0; bj < 2; ++bj)
#pragma unroll
                    for (int n = 0; n < 2; ++n) acc[ai][bj][m][n] = acc[ai][bj][m][n] * r; }
        PG8_LAS float* hb = halo + 6656;
        if (fr == 15) {
#pragma unroll
            for (int bj = 0; bj < 2; ++bj)
#pragma unroll
                for (int n = 0; n < 2; ++n)
#pragma unroll
                    for (int q = 0; q < 2; ++q) { const f32x4 v = acc[1][bj][2 + q][n];
                        if (wr == 0) *(PG8_LAS f32x4*)(halo + q * 256 + bj * HALF + cl + 4 * n) = v;
                        else *(PG8_LAS f32x4*)(hb + (2 + q) * 256 + bj * HALF + cl + 4 * n) = v; }
        }
        if (fr == 0 && wr == 0) {
#pragma unroll
            for (int bj = 0; bj < 2; ++bj)
#pragma unroll
                for (int n = 0; n < 2; ++n)
#pragma unroll
                    for (int q = 0; q < 2; ++q) *(PG8_LAS f32x4*)(hb + q * 256 + bj * HALF + cl + 4 * n) = acc[0][bj][q][n];
        }
        asm volatile("s_waitcnt lgkmcnt(0)\n\ts_barrier" ::: "memory");
        if (wr == 0) { const int l4 = 4 * (fq * 16 + fr); *(f32x4*)(HB + ((size_t)pm * 4 + wc) * FF2 + pn * BM + l4) = *(const PG8_LAS f32x4*)(hb + wc * 256 + l4); }
        const int gc = pn * HALF + cl;
        const float hk = (wr == 1 && fr == 0) ? 1.f : 0.f;
#pragma unroll
        for (int jh = 0; jh < 2; ++jh) {
            u32x2 gpk[4];
#pragma unroll
            for (int n = 0; n < 2; ++n) {
                f32x4 g6 = {}, g7 = {}, u6 = {}, u7 = {};
                if (jh == 0) {
                    g6 = row_shr1(acc[1][0][2][n]); g7 = row_shr1(acc[1][0][3][n]); u6 = row_shr1(acc[1][1][2][n]); u7 = row_shr1(acc[1][1][3][n]);
                    g6 = g6 + *(const PG8_LAS f32x4*)(halo + cl + 4 * n) * hk; g7 = g7 + *(const PG8_LAS f32x4*)(halo + 256 + cl + 4 * n) * hk;
                    u6 = u6 + *(const PG8_LAS f32x4*)(halo + HALF + cl + 4 * n) * hk; u7 = u7 + *(const PG8_LAS f32x4*)(halo + 256 + HALF + cl + 4 * n) * hk;
                }
                const f32x4 wg0 = *(const PG8_LAS f32x4*)(wt + 0 * 128 + cl + 4 * n), wg1 = *(const PG8_LAS f32x4*)(wt + 2 * 128 + cl + 4 * n), wg2 = *(const PG8_LAS f32x4*)(wt + 4 * 128 + cl + 4 * n), bg = *(const PG8_LAS f32x4*)(wt + 6 * 128 + cl + 4 * n);
                const f32x4 wu0 = *(const PG8_LAS f32x4*)(wt + 1 * 128 + cl + 4 * n), wu1 = *(const PG8_LAS f32x4*)(wt + 3 * 128 + cl + 4 * n), wu2 = *(const PG8_LAS f32x4*)(wt + 5 * 128 + cl + 4 * n), bu = *(const PG8_LAS f32x4*)(wt + 7 * 128 + cl + 4 * n);
#pragma unroll
                for (int jj = 0; jj < 4; ++jj) { const int j = 4 * jh + jj;
                    const f32x4 vg = acc[j >> 2][0][j & 3][n], vu = acc[j >> 2][1][j & 3][n];
                    const int j1 = (j >= 1) ? j - 1 : 0, j2 = (j >= 2) ? j - 2 : 0;
                    const f32x4 pg1 = (j >= 1) ? acc[j1 >> 2][0][j1 & 3][n] : g7, pg2 = (j >= 2) ? acc[j2 >> 2][0][j2 & 3][n] : (j == 1 ? g7 : g6);
                    const f32x4 pu1 = (j >= 1) ? acc[j1 >> 2][1][j1 & 3][n] : u7, pu2 = (j >= 2) ? acc[j2 >> 2][1][j2 & 3][n] : (j == 1 ? u7 : u6);
                    f32x4 zg = bg + wg2 * vg + wg1 * pg1 + wg0 * pg2; asm volatile("" : "+v"(zg));
                    f32x4 zu = bu + wu2 * vu + wu1 * pu1 + wu0 * pu2; asm volatile("" : "+v"(zu));
                    f32x4 r;
#pragma unroll
                    for (int i = 0; i < 4; ++i) r[i] = (zg[i] * zu[i]) * __builtin_amdgcn_rcpf(1.f + __builtin_amdgcn_exp2f(zg[i]));
                    u32x2 w; w.x = cvt_pk_bf16(r[0], r[1]); w.y = cvt_pk_bf16(r[2], r[3]);
                    const bool skip = (wr == 0) && (fr == 0) && (j < 2) && !seq_start;
                    if (n == 0) { gpk[jj] = w; asm volatile("" : "+v"(gpk[jj].x), "+v"(gpk[jj].y)); }
                    else if (!skip) NT_ST((u32x4*)(G + (size_t)(tok0 + j) * FF + gc), ((u32x4){gpk[jj].x, gpk[jj].y, w.x, w.y}));
                }
                __builtin_amdgcn_sched_barrier(0);
            }
        }
    }
};
struct EpiDown {
    static constexpr bool PERM = true, AFTER_DRAIN = false, PERMA = false, PREFETCH = false, DUAL = false;
    const bf16_t* X1B; bf16_t* X2B; float* SSQ;
    __device__ __forceinline__ void operator()(const f32x4 (&acc)[2][2][4][2], const Unit& u, int wr, int wc, int fr, int fq) const {
        const int row0 = u.pm * BM + wr * 64 + fr, col0 = u.pn * BM + wc * 32 + 8 * fq;
        float sa = 0.f, sb = 0.f;
#pragma unroll
        for (int ai = 0; ai < 2; ++ai)
#pragma unroll
            for (int m = 0; m < 4; ++m) { const int row = row0 + ai * HALF + m * 16; float s = 0.f;
#pragma unroll
                for (int bj = 0; bj < 2; ++bj) { const size_t off = (size_t)row * DM + col0 + bj * HALF;
                    f32x4 v0, v1; unpack8(NT_LD((const u32x4*)(X1B + off)), v0, v1); v0 = v0 + acc[ai][bj][m][0]; v1 = v1 + acc[ai][bj][m][1];
                    *(u32x4*)(X2B + off) = pack8(v0, v1);
                    s += (v0[0] * v0[0] + v0[1] * v0[1]) + (v0[2] * v0[2] + v0[3] * v0[3]) + (v1[0] * v1[0] + v1[1] * v1[1]) + (v1[2] * v1[2] + v1[3] * v1[3]); }
                s += __shfl_xor(s, 16); s += __shfl_xor(s, 32); if (((ai * 4 + m) >> 1) == fq) { if (m & 1) sb = s; else sa = s; } }
        store_ssq(SSQ, sa, sb, row0, u.pn * 4 + wc, fq);
    }
};
template <class Epi, class Sched, bool ALIGN_EPI = false, bool SP2 = false>
__device__ __forceinline__ void gemm_phase(PG8_LAS unsigned char* lds, const Gemm g, const Sched& S, const Epi& E, const int wid) {
    const int lane = lane_now(), tid = wid * 64 + lane, wr = wid >> 2, wc = wid & 3, fr = lane & 15, fq = lane >> 4;
    const int K = g.K, nt = K / BK;
    unsigned voffA[2], voffB[2];
#pragma unroll
    for (int i = 0; i < 2; ++i) { int R, C; stage_rc(tid * 16 + i * 8192, R, C); const int Rb = Epi::PERM ? ((R & ~31) + perm32(R & 31)) : R;
        const int Ra = Epi::PERMA ? (128 * ((R >> 6) & 1) + 8 * (R & 15) + ((R >> 4) & 3)) : R;
        voffA[i] = (unsigned)(Ra * K + C) * 2u; voffB[i] = (unsigned)(Rb * K + C) * 2u; }
    const size_t kstep = (size_t)(BK * 2);
    const size_t hstep = (size_t)HALF * K * 2;
    const size_t tstep = 2 * hstep;
    const size_t hstepA = Epi::PERMA ? (size_t)4 * K * 2 : hstep;
    const unsigned ldsw = (unsigned)wid * 1024u;
    const int aoff = lds_byte(wr * 64 + fr, fq * 8), boff = lds_byte(wc * 32 + fr, fq * 8);
#define PG8_SA(b, h) (((b) * 2 + (h)) * HTB)
#define PG8_SB(b, h) ((4 + (b) * 2 + (h)) * HTB)
#define PG8_STAGE(bufoff, gbase, voff) do { _Pragma("unroll") for (int _i = 0; _i < 2; ++_i) \
        __builtin_amdgcn_global_load_lds((const unsigned*)((const char*)(gbase) + (voff)[_i]), (PG8_LAS unsigned*)(lds + (bufoff) + ldsw + _i * 8192), 16, 0, 0); } while (0)
#define PG8_LDA(dst, b, h) do { _Pragma("unroll") for (int m = 0; m < 4; ++m) _Pragma("unroll") for (int k = 0; k < 2; ++k) dst[m][k] = *(const PG8_LAS bf16x8*)(lds + PG8_SA(b, h) + aoff + m * 2048 + k * 1024); } while (0)
#define PG8_LDB(dst, b, h) do { _Pragma("unroll") for (int n = 0; n < 2; ++n) _Pragma("unroll") for (int k = 0; k < 2; ++k) dst[n][k] = *(const PG8_LAS bf16x8*)(lds + PG8_SB(b, h) + boff + n * 2048 + k * 1024); } while (0)
#define PG8_MMA(ai, bj, At, Bt) do { __builtin_amdgcn_s_setprio(1); _Pragma("unroll") for (int m = 0; m < 4; ++m) _Pragma("unroll") for (int n = 0; n < 2; ++n) _Pragma("unroll") for (int k = 0; k < 2; ++k) \
        acc[ai][bj][m][n] = __builtin_amdgcn_mfma_f32_16x16x32_bf16(Bt[n][k], At[m][k], acc[ai][bj][m][n], 0, 0, 0); __builtin_amdgcn_s_setprio(0); } while (0)
#define PG8_WAIT_V(n) asm volatile("s_waitcnt vmcnt(" #n ")" ::: "memory")
#define PG8_WAIT_L(n) asm volatile("s_waitcnt lgkmcnt(" #n ")" ::: "memory")
#define PG8_BAR __builtin_amdgcn_s_barrier()
#define PG8_SCHED __builtin_amdgcn_sched_barrier(0)
    Unit cur, nxt; int ui = 0;
    if (!S.next(0, cur)) return;
    f32x4 acc[2][2][4][2];
#pragma unroll
    for (int a = 0; a < 2; ++a)
#pragma unroll
        for (int b = 0; b < 2; ++b)
#pragma unroll
            for (int m = 0; m < 4; ++m)
#pragma unroll
                for (int n = 0; n < 2; ++n) acc[a][b][m][n] = (f32x4){0.f, 0.f, 0.f, 0.f};
    bf16x8 At[4][2], B0[2][2], B1[2][2];
    const char* cA = (const char*)((Epi::DUAL && cur.seg) ? g.A2 : g.A) + (size_t)cur.pm * tstep; const char* cB = (const char*)((Epi::DUAL && cur.seg) ? g.Bt2 : g.Bt) + (size_t)cur.pn * tstep;
    S.a_ready(cur);
    if constexpr (Epi::PREFETCH) E.prefetch(cur, 0, wid, lane);
    if constexpr (SP2) {
        PG8_STAGE(PG8_SB(0, 0), cB, voffB); PG8_STAGE(PG8_SB(0, 1), cB + hstep, voffB); PG8_STAGE(PG8_SA(0, 0), cA, voffA); PG8_STAGE(PG8_SA(0, 1), cA + hstepA, voffA);
        if (wr == 1) PG8_BAR;
        PG8_WAIT_V(2); PG8_BAR;
        PG8_STAGE(PG8_SB(1, 0), cB + kstep, voffB); PG8_STAGE(PG8_SA(1, 0), cA + kstep, voffA); PG8_STAGE(PG8_SB(1, 1), cB + hstep + kstep, voffB);
        PG8_WAIT_V(6); PG8_BAR;
    } else {
        PG8_STAGE(PG8_SB(0, 0), cB, voffB); PG8_STAGE(PG8_SA(0, 0), cA, voffA); PG8_STAGE(PG8_SB(0, 1), cB + hstep, voffB); PG8_STAGE(PG8_SA(0, 1), cA + hstepA, voffA);
        if (wr == 1) PG8_BAR;
        PG8_WAIT_V(4); PG8_BAR;
        PG8_STAGE(PG8_SB(1, 0), cB + kstep, voffB); PG8_STAGE(PG8_SA(1, 0), cA + kstep, voffA); PG8_STAGE(PG8_SB(1, 1), cB + hstep + kstep, voffB);
        PG8_WAIT_V(6); PG8_BAR;
    }
    for (;;) {
        const bool has_next = S.next(ui + 1, nxt);
        const char* nA = has_next ? (const char*)((Epi::DUAL && nxt.seg) ? g.A2 : g.A) + (size_t)nxt.pm * tstep : cA; const char* nB = has_next ? (const char*)((Epi::DUAL && nxt.seg) ? g.Bt2 : g.Bt) + (size_t)nxt.pn * tstep : cB;
        for (int t = 0; t < nt; t += 2) {
            const bool last = (t == nt - 2);
            const char* a1 = cA + (size_t)(t + 1) * kstep;
            const char* a2 = last ? nA : cA + (size_t)(t + 2) * kstep; const char* b2 = last ? nB : cB + (size_t)(t + 2) * kstep;
            const char* a3 = a2 + kstep; const char* b3 = b2 + kstep;
            if (last && has_next) S.a_ready(nxt);
            if constexpr (SP2) {
            PG8_LDB(B0, 0, 0); PG8_LDB(B1, 0, 1); PG8_SCHED; PG8_LDA(At, 0, 0); PG8_STAGE(PG8_SA(1, 1), a1 + hstepA, voffA);
            PG8_WAIT_V(8); PG8_WAIT_L(0); PG8_BAR; PG8_MMA(0, 0, At, B0); PG8_MMA(0, 1, At, B1); PG8_BAR; PG8_SCHED;
            PG8_LDA(At, 0, 1); PG8_STAGE(PG8_SB(0, 0), b2, voffB); PG8_STAGE(PG8_SB(0, 1), b2 + hstep, voffB); PG8_STAGE(PG8_SA(0, 0), a2, voffA);
            PG8_WAIT_V(8); PG8_WAIT_L(0); PG8_BAR; PG8_MMA(1, 0, At, B0); PG8_MMA(1, 1, At, B1); PG8_BAR; PG8_SCHED;
            PG8_LDB(B0, 1, 0); PG8_LDB(B1, 1, 1); PG8_SCHED; PG8_LDA(At, 1, 0); PG8_STAGE(PG8_SA(0, 1), a2 + hstepA, voffA);
            PG8_WAIT_V(8); PG8_WAIT_L(0); PG8_BAR; PG8_MMA(0, 0, At, B0); PG8_MMA(0, 1, At, B1); PG8_BAR; PG8_SCHED;
            PG8_LDA(At, 1, 1); PG8_STAGE(PG8_SB(1, 0), b3, voffB); PG8_STAGE(PG8_SB(1, 1), b3 + hstep, voffB); PG8_STAGE(PG8_SA(1, 0), a3, voffA);
            PG8_WAIT_V(8); PG8_WAIT_L(0); PG8_BAR; PG8_MMA(1, 0, At, B0); PG8_MMA(1, 1, At, B1); PG8_BAR; PG8_SCHED;
            } else {
            PG8_LDB(B0, 0, 0); PG8_SCHED; PG8_LDA(At, 0, 0); PG8_STAGE(PG8_SA(1, 1), a1 + hstepA, voffA);
            PG8_WAIT_L(8); PG8_BAR; PG8_WAIT_L(0); PG8_MMA(0, 0, At, B0); PG8_BAR; PG8_SCHED;
            PG8_LDB(B1, 0, 1); PG8_STAGE(PG8_SB(0, 0), b2, voffB);
            PG8_BAR; PG8_WAIT_L(0); PG8_MMA(0, 1, At, B1); PG8_BAR;
            PG8_LDA(At, 0, 1); PG8_STAGE(PG8_SA(0, 0), a2, voffA);
            PG8_BAR; PG8_WAIT_L(0); PG8_MMA(1, 0, At, B0); PG8_BAR; PG8_SCHED;
            PG8_STAGE(PG8_SB(0, 1), b2 + hstep, voffB);
            PG8_WAIT_V(6); PG8_BAR; PG8_MMA(1, 1, At, B1); PG8_BAR;
            PG8_LDB(B0, 1, 0); PG8_SCHED; PG8_LDA(At, 1, 0); PG8_STAGE(PG8_SA(0, 1), a2 + hstepA, voffA);
            PG8_WAIT_L(8); PG8_BAR; PG8_WAIT_L(0); PG8_MMA(0, 0, At, B0); PG8_BAR; PG8_SCHED;
            PG8_LDB(B1, 1, 1); PG8_STAGE(PG8_SB(1, 0), b3, voffB);
            PG8_BAR; PG8_WAIT_L(0); PG8_MMA(0, 1, At, B1); PG8_BAR;
            PG8_LDA(At, 1, 1); PG8_STAGE(PG8_SA(1, 0), a3, voffA);
            PG8_BAR; PG8_WAIT_L(0); PG8_MMA(1, 0, At, B0); PG8_BAR; PG8_SCHED;
            PG8_STAGE(PG8_SB(1, 1), b3 + hstep, voffB);
            PG8_WAIT_V(6); PG8_BAR; PG8_MMA(1, 1, At, B1); PG8_BAR;
            }
        }
        if constexpr (ALIGN_EPI) { if (wr == 0) PG8_BAR; }
        if constexpr (!Epi::AFTER_DRAIN) { if constexpr (Epi::PREFETCH) E(acc, cur, wr, wc, fr, fq, ui); else if constexpr (Epi::DUAL) { if (cur.seg == 0) E.mid(acc, cur, wr, wc, fr, fq); else E(acc, cur, wr, wc, fr, fq); } else E(acc, cur, wr, wc, fr, fq); S.done(cur); }
        if (!has_next) break;
        if (!(Epi::DUAL && cur.seg == 0))
#pragma unroll
        for (int a = 0; a < 2; ++a)
#pragma unroll
            for (int b = 0; b < 2; ++b)
#pragma unroll
                for (int m = 0; m < 4; ++m)
#pragma unroll
                    for (int n = 0; n < 2; ++n) acc[a][b][m][n] = (f32x4){0.f, 0.f, 0.f, 0.f};
        cur = nxt; cA = nA; cB = nB; ++ui;
        if constexpr (Epi::PREFETCH) E.prefetch(cur, ui, wid, lane);
        if constexpr (ALIGN_EPI) { if (wr == 1) PG8_BAR; }
    }
    PG8_WAIT_V(0);
    if constexpr (!ALIGN_EPI) { if (wr == 0) PG8_BAR; }
    PG8_BAR;
    if constexpr (Epi::AFTER_DRAIN) { E.fused(acc, cur, wr, wc, fr, fq, lds, wid, lane); S.done(cur); }
#undef PG8_SA
#undef PG8_SB
#undef PG8_STAGE
#undef PG8_LDA
#undef PG8_LDB
#undef PG8_MMA
#undef PG8_WAIT_V
#undef PG8_WAIT_L
#undef PG8_BAR
#undef PG8_SCHED
}
}

#define GAS __attribute__((address_space(1)))
#define LAS __attribute__((address_space(3)))
typedef GAS unsigned gu32;
typedef GAS unsigned long long gu64;
#define RLX_AGENT __ATOMIC_RELAXED, __HIP_MEMORY_SCOPE_AGENT
#define LDS_WAIT() asm volatile("s_waitcnt lgkmcnt(0)" ::: "memory")
#define VM_WAIT() asm volatile("s_waitcnt vmcnt(0)" ::: "memory")
#define XB_TMO      128
#define XB_XCNT(j)  (256  + 64 * (j))
#define XB_XSUB(j)  (1280 + 64 * (j))
#define XB_XGEN(j)  (2304 + 64 * (j))
#define XB_TOP      3328
#define XB_TOPGEN   3392
#define XB_LSUB(j)  (3456 + 64 * (j))
#define XB_LGEN(j)  (4480 + 64 * (j))
#define XCD_BAR_WORDS 5504
#define XB_SPIN_CAP (1u << 18)

__device__ __forceinline__ unsigned xb_ld(unsigned* p)              { return __hip_atomic_load(p, __ATOMIC_RELAXED, __HIP_MEMORY_SCOPE_AGENT); }
__device__ __forceinline__ unsigned xb_add(unsigned* p, unsigned v) { return __hip_atomic_fetch_add(p, v, __ATOMIC_RELAXED, __HIP_MEMORY_SCOPE_AGENT); }
__device__ __forceinline__ unsigned xb_xcc_id() { return (unsigned)__builtin_amdgcn_s_getreg((3 << 11) | 20) & 0xFu; }
#define XB_SPIN(cond, bar) do { unsigned _sp = 0; while (cond) { __builtin_amdgcn_s_sleep(1); \
    if ((++_sp & 255u) == 0u) { if (xb_ld(&(bar)[XB_TMO])) break; if (_sp > XB_SPIN_CAP) { atomicAdd(&(bar)[XB_TMO], 1u); break; } } } } while (0)

struct XcdBarrier {
    unsigned* bar; unsigned x; int wv;
    volatile LAS unsigned* st;
};

__device__ __forceinline__ XcdBarrier xcd_barrier_post(unsigned* bar, volatile LAS unsigned* st, int wv) {
    XcdBarrier b; b.bar = bar; b.x = xb_xcc_id(); b.st = st; b.wv = wv;
    if (wv == 0 && lane_now() == 0) (void)xb_add(&bar[XB_XCNT(b.x)], 1u);
    return b;
}
__device__ __forceinline__ void xcd_barrier_complete(unsigned* bar, unsigned x, unsigned& nloc, unsigned& nx) {
    const unsigned G = gridDim.x * gridDim.y * gridDim.z;
    unsigned sum, cnt, mine, sp = 0u;
    for (;;) {
        sum = 0u; cnt = 0u; mine = 0u;
#pragma unroll
        for (unsigned j = 0; j < 16; ++j) { const unsigned c = xb_ld(&bar[XB_XCNT(j)]); sum += c; cnt += (c > 0u) ? 1u : 0u; mine = (j == x) ? c : mine; }
        if (sum == G) break;
        __builtin_amdgcn_s_sleep(1);
        if ((++sp & 255u) == 0u) { if (xb_ld(&bar[XB_TMO])) break; if (sp > XB_SPIN_CAP) { atomicAdd(&bar[XB_TMO], 1u); break; } }
    }
    nloc = mine > 0u ? mine : 1u; nx = cnt > 0u ? cnt : 1u;
}

__device__ __forceinline__ void xcd_barrier(const XcdBarrier& b) {
    asm volatile("s_waitcnt vmcnt(0)" ::: "memory");
    __syncthreads();
    if (b.wv == 0 && lane_now() == 0) {
        unsigned* bar = b.bar;
        __builtin_amdgcn_s_waitcnt(0);
        unsigned nloc = b.st[0], nx = b.st[1];
        if (nloc == 0u) { xcd_barrier_complete(bar, b.x, nloc, nx); b.st[0] = nloc; b.st[1] = nx; }
        const unsigned old = xb_add(&bar[XB_XSUB(b.x)], 1u);
        const unsigned gen = old / nloc;
        if (old + 1u == (gen + 1u) * nloc) {
            __builtin_amdgcn_fence(__ATOMIC_RELEASE, "agent");
            asm volatile("s_waitcnt vmcnt(0)" ::: "memory");
            const unsigned og = xb_add(&bar[XB_TOP], 1u);
            const unsigned tg = og / nx;
            if (og + 1u == (tg + 1u) * nx) xb_add(&bar[XB_TOPGEN], 1u);
            else XB_SPIN(xb_ld(&bar[XB_TOPGEN]) == tg, bar);
            __builtin_amdgcn_fence(__ATOMIC_ACQUIRE, "agent");
            xb_add(&bar[XB_XGEN(b.x)], 1u);
            asm volatile("s_waitcnt vmcnt(0)" ::: "memory");
        } else {
            XB_SPIN(xb_ld(&bar[XB_XGEN(b.x)]) == gen, bar);
            __builtin_amdgcn_fence(__ATOMIC_ACQUIRE, "agent");
            asm volatile("s_waitcnt vmcnt(0)" ::: "memory");
        }
    }
    __syncthreads();
}
__device__ __forceinline__ void xcd_barrier_local(const XcdBarrier& b) {
    asm volatile("s_waitcnt vmcnt(0)" ::: "memory");
    __syncthreads();
    if (b.wv == 0 && lane_now() == 0) {
        unsigned* bar = b.bar;
        __builtin_amdgcn_s_waitcnt(0);
        const unsigned nloc = b.st[0];
        const unsigned old = xb_add(&bar[XB_LSUB(b.x)], 1u);
        const unsigned gen = old / nloc;
        if (old + 1u == (gen + 1u) * nloc) xb_add(&bar[XB_LGEN(b.x)], 1u);
        else XB_SPIN(xb_ld(&bar[XB_LGEN(b.x)]) == gen, bar);
        __builtin_amdgcn_fence(__ATOMIC_ACQUIRE, "agent");
        asm volatile("s_waitcnt vmcnt(0)" ::: "memory");
    }
    __syncthreads();
}

namespace ret {
typedef short s16x4 __attribute__((ext_vector_type(4)));
typedef short v4i16_t __attribute__((ext_vector_type(4)));
typedef LAS const unsigned char* lptr;
constexpr int QS_STRIDE = 144, KD_STRIDE = 192, VS_STRIDE = 320, OUT_STRIDE = 528;
constexpr int OFF_QS = 0, OFF_ST = 18432, OFF_KS = 36864, OFF_KD = 55296, OFF_VS = 79872, OFF_END = 120832, OFF_OUT = OFF_KS, OFF_SSQ = OFF_END;
static_assert(OFF_OUT + 128 * OUT_STRIDE <= OFF_END && OFF_SSQ + 1024 <= 131072, "retention LDS map");
__device__ __forceinline__ s16x4 vtr(lptr p) { return __builtin_bit_cast(s16x4, __builtin_amdgcn_ds_read_tr16_b64_v4i16((LAS v4i16_t*)p)); }
__device__ __forceinline__ bf16x8 cat8(const s16x4 lo, const s16x4 hi) { return (bf16x8){lo[0], lo[1], lo[2], lo[3], hi[0], hi[1], hi[2], hi[3]}; }

__device__ __forceinline__ void stage_chunk(LAS unsigned char* lds, const bf16* rowbase, int h, float lg, int tid, bool with_qk) {
#pragma unroll
    for (int i = 0; i < 2; ++i) { const int it = tid + 512 * i, row = it >> 3, ch = it & 7;
        const u32x4 k = *(const u32x4*)(rowbase + (size_t)row * PP + C_KR + h * HD + ch * 8);
        f32x4 a, b; pg8::unpack8(k, a, b); const float d = __builtin_amdgcn_exp2f(lg * (float)(127 - row));
        *(LAS u32x4*)(lds + OFF_KD + row * KD_STRIDE + ch * 16) = pg8::pack8(a * d, b * d);
        if (with_qk) { *(LAS u32x4*)(lds + OFF_KS + row * QS_STRIDE + ch * 16) = k;
            *(LAS u32x4*)(lds + OFF_QS + row * QS_STRIDE + ch * 16) = *(const u32x4*)(rowbase + (size_t)row * PP + C_QR + h * HD + ch * 8); } }
#pragma unroll
    for (int i = 0; i < 4; ++i) { const int it = tid + 512 * i, row = it >> 4, ch = it & 15;
        *(LAS u32x4*)(lds + OFF_VS + row * VS_STRIDE + ch * 16) = *(const u32x4*)(rowbase + (size_t)row * PP + C_VR + h * DV + ch * 8); }
}
__device__ __forceinline__ void state_update(f32x16& st, lptr lds, int dkb, int dvb, float gC, int lane) {
    const int hi = lane >> 5, g = (lane >> 4) & 1, qq = (lane & 15) >> 2, pp = lane & 3;
    lptr ka = lds + OFF_KD + (8 * hi + qq) * KD_STRIDE + (32 * dkb + 16 * g + 4 * pp) * 2;
    lptr va = lds + OFF_VS + (8 * hi + qq) * VS_STRIDE + (32 * dvb + 16 * g + 4 * pp) * 2;
#pragma unroll
    for (int r = 0; r < 16; ++r) st[r] *= gC;
#pragma unroll
    for (int ks = 0; ks < 8; ++ks) {
        const bf16x8 a = cat8(vtr(ka + ks * 16 * KD_STRIDE), vtr(ka + (ks * 16 + 4) * KD_STRIDE));
        const bf16x8 b = cat8(vtr(va + ks * 16 * VS_STRIDE), vtr(va + (ks * 16 + 4) * VS_STRIDE));
        st = __builtin_amdgcn_mfma_f32_32x32x16_bf16(a, b, st, 0, 0, 0);
    }
}

__device__ __forceinline__ void ret_group_state(LAS unsigned char* lds, const bf16* PROJ, float* GST, int ui, int tid) {
    const int lane = tid & 63, wave = __builtin_amdgcn_readfirstlane(tid >> 6), hi = lane >> 5;
    const int bh = ui >> 3, s = ui & 7, h = bh & 3, b = bh >> 2, dkb = wave & 1, dvb = wave >> 1;
    const float lg = ret_lg2(h), gC = __builtin_amdgcn_exp2f(lg * 128.f);
    f32x16 st = {};
    const bf16* rb0 = PROJ + ((size_t)b * SEQ + (size_t)(8 * s) * 128) * PP;
    const size_t koff0 = (size_t)(tid >> 3) * PP + C_KR + h * HD + (tid & 7) * 8, voff0 = (size_t)(tid >> 4) * PP + C_VR + h * DV + (tid & 15) * 8;
    u32x4 kk[3][2], vv[3][4];
#pragma unroll
    for (int c = 0; c < 3; ++c) { const bf16* rb = rb0 + (size_t)c * 128 * PP;
#pragma unroll
        for (int i = 0; i < 2; ++i) kk[c][i] = *(const u32x4*)(rb + koff0 + (size_t)(64 * i) * PP);
#pragma unroll
        for (int i = 0; i < 4; ++i) vv[c][i] = *(const u32x4*)(rb + voff0 + (size_t)(32 * i) * PP); }
#pragma unroll
    for (int c = 0; c < 8; ++c) { const int q = c % 3;
        __syncthreads();
#pragma unroll
        for (int i = 0; i < 2; ++i) { const int row = (tid >> 3) + 64 * i, ch = tid & 7;
            f32x4 a, bq; pg8::unpack8(kk[q][i], a, bq); const float d = __builtin_amdgcn_exp2f(lg * (float)(127 - row));
            *(LAS u32x4*)(lds + OFF_KD + row * KD_STRIDE + ch * 16) = pg8::pack8(a * d, bq * d); }
#pragma unroll
        for (int i = 0; i < 4; ++i) { const int row = (tid >> 4) + 32 * i, ch = tid & 15; *(LAS u32x4*)(lds + OFF_VS + row * VS_STRIDE + ch * 16) = vv[q][i]; }
        if (c + 3 < 8) { const bf16* rb = rb0 + (size_t)(c + 3) * 128 * PP;
#pragma unroll
            for (int i = 0; i < 2; ++i) kk[q][i] = *(const u32x4*)(rb + koff0 + (size_t)(64 * i) * PP);
#pragma unroll
            for (int i = 0; i < 4; ++i) vv[q][i] = *(const u32x4*)(rb + voff0 + (size_t)(32 * i) * PP); }
        __syncthreads();
        state_update(st, (lptr)lds, dkb, dvb, gC, lane);
    }
    f32x4* gq = (f32x4*)(GST + (size_t)ui * (HD * DV)) + wave * 256 + lane;
#pragma unroll
    for (int q = 0; q < 4; ++q) gq[q * 64] = (f32x4){st[4 * q], st[4 * q + 1], st[4 * q + 2], st[4 * q + 3]};
    __syncthreads();
}

__device__ __forceinline__ void ret_outputs(LAS unsigned char* lds, const bf16* PROJ, const float* GST, bf16* RB, int ui, int tid) {
    const int lane = tid & 63, wave = __builtin_amdgcn_readfirstlane(tid >> 6), hi = lane >> 5, l31 = lane & 31;
    const int g = (lane >> 4) & 1, qq = (lane & 15) >> 2, pp = lane & 3;
    const int bh = ui >> 3, s = ui & 7, h = bh & 3, b = bh >> 2, dkb = wave & 1, dvb = wave >> 1;
    const int qblk = wave & 3, dvh = wave >> 2;
    const float lg = ret_lg2(h), gC = __builtin_amdgcn_exp2f(lg * 128.f);
    const bf16* rb0 = PROJ + ((size_t)b * SEQ + (size_t)(8 * s) * 128) * PP;
    const size_t qoff0 = (size_t)(tid >> 3) * PP + h * HD + (tid & 7) * 8, voff0 = (size_t)(tid >> 4) * PP + C_VR + h * DV + (tid & 15) * 8;
    u32x4 kk[2], qv[2], vv[4];
#pragma unroll
    for (int i = 0; i < 2; ++i) { kk[i] = __builtin_nontemporal_load((const u32x4*)(rb0 + qoff0 + C_KR + (size_t)(64 * i) * PP)); qv[i] = __builtin_nontemporal_load((const u32x4*)(rb0 + qoff0 + C_QR + (size_t)(64 * i) * PP)); }
#pragma unroll
    for (int i = 0; i < 4; ++i) vv[i] = __builtin_nontemporal_load((const u32x4*)(rb0 + voff0 + (size_t)(32 * i) * PP));
    f32x16 st = {};
    for (int sp = 0; sp < s; ++sp) {
        const float w = __builtin_amdgcn_exp2f(lg * 1024.f * (float)(s - 1 - sp));
        const f32x4* gq = (const f32x4*)(GST + (size_t)(bh * 8 + sp) * (HD * DV)) + wave * 256 + lane;
#pragma unroll
        for (int q = 0; q < 4; ++q) { const f32x4 v = gq[q * 64];
#pragma unroll
            for (int i = 0; i < 4; ++i) st[4 * q + i] += w * v[i]; }
    }
    const float qdec = __builtin_amdgcn_exp2f(lg * (float)(32 * qblk + l31 + 1));
    for (int c = 0; c < 8; ++c) {
        const size_t row0 = (size_t)b * SEQ + (size_t)(8 * s + c) * 128;
        __syncthreads();
#pragma unroll
        for (int gq = 0; gq < 4; ++gq) { u32x2 w; w.x = pg8::cvt_pk_bf16(st[4 * gq], st[4 * gq + 1]); w.y = pg8::cvt_pk_bf16(st[4 * gq + 2], st[4 * gq + 3]);
            *(LAS u32x2*)(lds + OFF_ST + (32 * dvb + l31) * QS_STRIDE + (32 * dkb + 8 * gq + 4 * hi) * 2) = w; }
#pragma unroll
        for (int i = 0; i < 2; ++i) { const int row = (tid >> 3) + 64 * i, ch = tid & 7;
            f32x4 a, bq; pg8::unpack8(kk[i], a, bq); const float d = __builtin_amdgcn_exp2f(lg * (float)(127 - row));
            *(LAS u32x4*)(lds + OFF_KD + row * KD_STRIDE + ch * 16) = pg8::pack8(a * d, bq * d);
            *(LAS u32x4*)(lds + OFF_KS + row * QS_STRIDE + ch * 16) = kk[i]; *(LAS u32x4*)(lds + OFF_QS + row * QS_STRIDE + ch * 16) = qv[i]; }
#pragma unroll
        for (int i = 0; i < 4; ++i) { const int row = (tid >> 4) + 32 * i, ch = tid & 15; *(LAS u32x4*)(lds + OFF_VS + row * VS_STRIDE + ch * 16) = vv[i]; }
        if (c + 1 < 8) { const bf16* rb = rb0 + (size_t)(c + 1) * 128 * PP;
#pragma unroll
            for (int i = 0; i < 2; ++i) { kk[i] = __builtin_nontemporal_load((const u32x4*)(rb + qoff0 + C_KR + (size_t)(64 * i) * PP)); qv[i] = __builtin_nontemporal_load((const u32x4*)(rb + qoff0 + C_QR + (size_t)(64 * i) * PP)); }
#pragma unroll
            for (int i = 0; i < 4; ++i) vv[i] = __builtin_nontemporal_load((const u32x4*)(rb + voff0 + (size_t)(32 * i) * PP)); }
        __syncthreads();
        bf16x8 qf[4];
#pragma unroll
        for (int d0 = 0; d0 < 4; ++d0) qf[d0] = *(const LAS bf16x8*)(lds + OFF_QS + (32 * qblk + l31) * QS_STRIDE + (16 * d0 + 8 * hi) * 2);
        f32x16 o[2];
#pragma unroll
        for (int d = 0; d < 2; ++d) { o[d] = f32x16{};
#pragma unroll
            for (int d0 = 0; d0 < 4; ++d0) { const bf16x8 a = *(const LAS bf16x8*)(lds + OFF_ST + (32 * (2 * dvh + d) + l31) * QS_STRIDE + (16 * d0 + 8 * hi) * 2);
                o[d] = __builtin_amdgcn_mfma_f32_32x32x16_bf16(a, qf[d0], o[d], 0, 0, 0); }
#pragma unroll
            for (int r = 0; r < 16; ++r) o[d][r] *= qdec; }
        for (int kb = 0; kb <= qblk; ++kb) {
            f32x16 sT = {};
#pragma unroll
            for (int d0 = 0; d0 < 4; ++d0) { const bf16x8 a = *(const LAS bf16x8*)(lds + OFF_KS + (32 * kb + l31) * QS_STRIDE + (16 * d0 + 8 * hi) * 2);
                sT = __builtin_amdgcn_mfma_f32_32x32x16_bf16(a, qf[d0], sT, 0, 0, 0); }
            const int dq = 32 * (qblk - kb) + l31;
#pragma unroll
            for (int r = 0; r < 16; ++r) { const int dist = dq - ((r & 3) + 8 * (r >> 2) + 4 * hi); sT[r] = (dist >= 0) ? sT[r] * __builtin_amdgcn_exp2f(lg * (float)dist) : 0.f; }
            u32x4 pw[2];
#pragma unroll
            for (int sx = 0; sx < 2; ++sx) { pw[sx].x = pg8::cvt_pk_bf16(sT[8 * sx], sT[8 * sx + 1]); pw[sx].y = pg8::cvt_pk_bf16(sT[8 * sx + 2], sT[8 * sx + 3]);
                pw[sx].z = pg8::cvt_pk_bf16(sT[8 * sx + 4], sT[8 * sx + 5]); pw[sx].w = pg8::cvt_pk_bf16(sT[8 * sx + 6], sT[8 * sx + 7]); }
#pragma unroll
            for (int d = 0; d < 2; ++d)
#pragma unroll
                for (int sx = 0; sx < 2; ++sx) { lptr vp = (lptr)lds + OFF_VS + (32 * kb + 16 * sx + 4 * hi + qq) * VS_STRIDE + (32 * (2 * dvh + d) + 16 * g + 4 * pp) * 2;
                    const bf16x8 a = cat8(vtr(vp), vtr(vp + 8 * VS_STRIDE));
                    o[d] = __builtin_amdgcn_mfma_f32_32x32x16_bf16(a, __builtin_bit_cast(bf16x8, pw[sx]), o[d], 0, 0, 0); }
        }
        state_update(st, (lptr)lds, dkb, dvb, gC, lane);
        float ss = 0.f;
#pragma unroll
        for (int d = 0; d < 2; ++d)
#pragma unroll
            for (int r = 0; r < 16; ++r) ss += o[d][r] * o[d][r];
        ss += __shfl_xor(ss, 32);
        __syncthreads();
#pragma unroll
        for (int d = 0; d < 2; ++d)
#pragma unroll
            for (int gq = 0; gq < 4; ++gq) *(LAS f32x4*)(lds + OFF_OUT + (32 * qblk + l31) * OUT_STRIDE + (32 * (2 * dvh + d) + 8 * gq + 4 * hi) * 4) = (f32x4){o[d][4 * gq], o[d][4 * gq + 1], o[d][4 * gq + 2], o[d][4 * gq + 3]};
        if (hi == 0) *(LAS float*)(lds + OFF_SSQ + (dvh * 128 + 32 * qblk + l31) * 4) = ss;
        __syncthreads();
        { const int row = tid >> 2, seg = tid & 3;
          const float rstd = rsqrtf((*(const LAS float*)(lds + OFF_SSQ + row * 4) + *(const LAS float*)(lds + OFF_SSQ + (128 + row) * 4)) * (1.f / DV) + SUBLN_EPS);
          const bf16* gsrc = PROJ + (row0 + row) * PP + C_GR + h * DV + seg * 32; bf16* dst = RB + (row0 + row) * 512 + h * DV + seg * 32;
#pragma unroll
          for (int cc = 0; cc < 4; ++cc) { const f32x4 v0 = *(const LAS f32x4*)(lds + OFF_OUT + row * OUT_STRIDE + (seg * 32 + cc * 8) * 4), v1 = *(const LAS f32x4*)(lds + OFF_OUT + row * OUT_STRIDE + (seg * 32 + cc * 8 + 4) * 4);
              f32x4 g0, g1; pg8::unpack8(*(const u32x4*)(gsrc + cc * 8), g0, g1); f32x4 r0, r1;
#pragma unroll
              for (int i = 0; i < 4; ++i) { r0[i] = v0[i] * rstd * g0[i]; r1[i] = v1[i] * rstd * g1[i]; }
              *(u32x4*)(dst + cc * 8) = pg8::pack8(r0, r1); } }
    }
    __syncthreads();
}
}

namespace attn {
typedef short s16x4 __attribute__((ext_vector_type(4)));
typedef short v4i16_t __attribute__((ext_vector_type(4)));
typedef LAS const unsigned char* lptr;
constexpr int KSLOT = 16384, L_K2 = 8192, L_V = 65536, VSLOT = 16384;
#ifndef ATT_SKIP
#define ATT_SKIP 1
#endif
#ifndef ATT_THR
#define ATT_THR 60.0f
#endif
__device__ __forceinline__ void glds16s(const void* sbase, unsigned voff, unsigned lds_dst) { unsigned keep;
    asm volatile("s_mov_b32 %0, m0\n\ts_mov_b32 m0, %3\n\ts_nop 0\n\tglobal_load_lds_dwordx4 %1, %2\n\ts_mov_b32 m0, %0" : "=&s"(keep) : "v"(voff), "s"(sbase), "s"(lds_dst) : "memory"); }
__device__ __forceinline__ void glds16(const void* gsrc, unsigned lds_dst) { unsigned keep;
    asm volatile("s_mov_b32 %0, m0\n\ts_mov_b32 m0, %2\n\ts_nop 0\n\tglobal_load_lds_dwordx4 %1, off\n\ts_mov_b32 m0, %0" : "=&s"(keep) : "v"(gsrc), "s"(lds_dst) : "memory"); }
__device__ __forceinline__ s16x4 vtr(lptr p) { return __builtin_bit_cast(s16x4, __builtin_amdgcn_ds_read_tr16_b64_v4i16((LAS v4i16_t*)p)); }
__device__ __forceinline__ bf16x8 cat8(const s16x4 lo, const s16x4 hi) { return (bf16x8){lo[0], lo[1], lo[2], lo[3], hi[0], hi[1], hi[2], hi[3]}; }
#define ATT_WAIT_BAR() asm volatile("s_waitcnt vmcnt(0) lgkmcnt(0)\n\ts_barrier" ::: "memory")
#define ATT_WAIT_BAR4() asm volatile("s_waitcnt vmcnt(4) lgkmcnt(0)\n\ts_barrier" ::: "memory")

#define ATT_SB() __builtin_amdgcn_sched_barrier(0)
__device__ __forceinline__ float max3f(float a, float b, float c) { float r; asm("v_max3_f32 %0, %1, %2, %3" : "=v"(r) : "v"(a), "v"(b), "v"(c)); return r; }
__device__ __forceinline__ bf16x8 vfrag(lptr vp, int ks, int d) { const lptr va = vp + d * 4096 + (32 * (ks >> 1) + 16 * (ks & 1)) * 64; return cat8(vtr(va), vtr(va + 8 * 64)); }
__device__ __forceinline__ void vload4(bf16x8 (&buf)[8], int half, lptr vp, int ks) {
#pragma unroll
    for (int d = 0; d < 4; ++d) buf[4 * half + d] = vfrag(vp, ks, d);
}
__device__ __forceinline__ void pv_step(f32x16 (&o)[4], const u32x4& pwk, const bf16x8 (&buf)[8], int half) {
    const bf16x8 pb = __builtin_bit_cast(bf16x8, pwk);
#pragma unroll
    for (int d = 0; d < 4; ++d) o[d] = __builtin_amdgcn_mfma_f32_32x32x16_bf16(buf[4 * half + d], pb, o[d], 0, 0, 0);
}
__device__ __forceinline__ void kload8(bf16x8 (&kf)[8], lptr kp) {
#pragma unroll
    for (int d0 = 0; d0 < 4; ++d0) { kf[2 * d0] = *(const LAS bf16x8*)(kp + d0 * 2048); kf[2 * d0 + 1] = *(const LAS bf16x8*)(kp + d0 * 2048 + 512); }
}
__device__ __forceinline__ void kload4(bf16x8 (&kf)[8], lptr kp, int half) {
#pragma unroll
    for (int d0 = 2 * half; d0 < 2 * half + 2; ++d0) { kf[2 * d0] = *(const LAS bf16x8*)(kp + d0 * 2048); kf[2 * d0 + 1] = *(const LAS bf16x8*)(kp + d0 * 2048 + 512); }
}
template <int MODE> __device__ __forceinline__ void qk_scores(const bf16x8 (&kf)[8], const bf16x8 (&qr)[4], f32x16 (&o)[4], f32x16& p0, f32x16& p1, float& cinit, float shift, bool band, int kb, int qrel, lptr vp, bf16x8 (&tmp)[8]) {
#pragma unroll
    for (int r = 0; r < 16; ++r) { p0[r] = cinit; p1[r] = cinit; }
#pragma unroll
    for (int d0 = 0; d0 < 4; ++d0) {
        p0 = __builtin_amdgcn_mfma_f32_32x32x16_bf16(kf[2 * d0], qr[d0], p0, 0, 0, 0);
        p1 = __builtin_amdgcn_mfma_f32_32x32x16_bf16(kf[2 * d0 + 1], qr[d0], p1, 0, 0, 0);
    }
    ATT_SB();
    vload4(tmp, 0, vp, 0); vload4(tmp, 1, vp, 1);
    ATT_SB();
}
template <int MODE> __device__ __forceinline__ void softmax_head(f32x16 (&o)[4], float& lsum, f32x16& p0, f32x16& p1, float& cinit, float shift, bool band, int kb, int qrel) {
    if (!(MODE & 2)) {
    if (band) {
#pragma unroll
        for (int r = 0; r < 16; ++r) { const int kv = kb + (r & 3) + 8 * (r >> 2); if (kv > qrel) p0[r] = -INFINITY; if (kv + 32 > qrel) p1[r] = -INFINITY; }
    }
    ATT_SB(); asm volatile("s_nop 7\n\ts_nop 7"); ATT_SB();
    float rm = max3f(p0[0], p0[1], p1[0]), rb = max3f(p0[2], p0[3], p1[1]);
    rm = max3f(rm, p1[2], p1[3]);
#pragma unroll
    for (int r = 4; r < 16; r += 4) { rm = max3f(rm, p0[r], p0[r + 1]); rb = max3f(rb, p0[r + 2], p0[r + 3]); rm = max3f(rm, p1[r], p1[r + 1]); rb = max3f(rb, p1[r + 2], p1[r + 3]); }
    rm = max3f(rm, rb, rb);
    { auto rr = __builtin_amdgcn_permlane32_swap(__float_as_uint(rm), __float_as_uint(rm), false, false); rm = fmaxf(__uint_as_float(rr[0]), __uint_as_float(rr[1])); }
    if (__any(rm > ATT_THR)) {
        const float dl = fmaxf(rm, 0.f), f = __builtin_amdgcn_exp2f(-dl);
        cinit -= dl;
#pragma unroll
        for (int r = 0; r < 16; ++r) { p0[r] -= dl; p1[r] -= dl; }
        lsum *= f;
#pragma unroll
        for (int d = 0; d < 4; ++d)
#pragma unroll
            for (int r = 0; r < 16; ++r) o[d][r] *= f;
    }
    }
    cinit += shift;
}
struct AW { float b1, b2, b3, a8, c1, c2, c3; };
template <int MODE> __device__ __forceinline__ u32x4 exp_pack(const f32x16& p, int s, float& lsum, float cks, const AW& aw) {
    float e[8];
#pragma unroll
    for (int j = 0; j < 8; ++j) e[j] = (MODE & 2) ? p[8 * s + j] : __builtin_amdgcn_exp2f(p[8 * s + j]);
    const float g0 = __builtin_fmaf(aw.b3, e[3], __builtin_fmaf(aw.b2, e[2], __builtin_fmaf(aw.b1, e[1], e[0])));
    const float g1 = __builtin_fmaf(aw.b3, e[7], __builtin_fmaf(aw.b2, e[6], __builtin_fmaf(aw.b1, e[5], e[4])));
    lsum = __builtin_fmaf(cks, __builtin_fmaf(aw.a8, g1, g0), lsum);
    u32x4 w; w.x = pg8::cvt_pk_bf16(e[0], e[1]); w.y = pg8::cvt_pk_bf16(e[2], e[3]); w.z = pg8::cvt_pk_bf16(e[4], e[5]); w.w = pg8::cvt_pk_bf16(e[6], e[7]);
    return w;
}
__device__ __forceinline__ void qk_half(const bf16x8 (&kf)[8], const bf16x8 (&qr)[4], f32x16& p0, f32x16& p1, int half) {
    if (half == 0) {
        p0 = __builtin_amdgcn_mfma_f32_32x32x16_bf16(kf[0], qr[0], f32x16{}, 0, 0, 0); p1 = __builtin_amdgcn_mfma_f32_32x32x16_bf16(kf[1], qr[0], f32x16{}, 0, 0, 0);
        p0 = __builtin_amdgcn_mfma_f32_32x32x16_bf16(kf[2], qr[1], p0, 0, 0, 0); p1 = __builtin_amdgcn_mfma_f32_32x32x16_bf16(kf[3], qr[1], p1, 0, 0, 0);
    } else {
        p0 = __builtin_amdgcn_mfma_f32_32x32x16_bf16(kf[4], qr[2], p0, 0, 0, 0); p1 = __builtin_amdgcn_mfma_f32_32x32x16_bf16(kf[5], qr[2], p1, 0, 0, 0);
        p0 = __builtin_amdgcn_mfma_f32_32x32x16_bf16(kf[6], qr[3], p0, 0, 0, 0); p1 = __builtin_amdgcn_mfma_f32_32x32x16_bf16(kf[7], qr[3], p1, 0, 0, 0);
    }
}
__device__ __forceinline__ void softmax_head2(f32x16 (&o)[4], float& lsum, f32x16& p0, f32x16& p1, float& c, bool band, int kb, int qrel) {
    if (band) {
#pragma unroll
        for (int r = 0; r < 16; ++r) { const int kv = kb + (r & 3) + 8 * (r >> 2); if (kv > qrel) p0[r] = -INFINITY; if (kv + 32 > qrel) p1[r] = -INFINITY; }
    }
    ATT_SB();
    float rm = max3f(p0[0], p0[1], p1[0]), rb = max3f(p0[2], p0[3], p1[1]);
    rm = max3f(rm, p1[2], p1[3]);
#pragma unroll
    for (int r = 4; r < 16; r += 4) { rm = max3f(rm, p0[r], p0[r + 1]); rb = max3f(rb, p0[r + 2], p0[r + 3]); rm = max3f(rm, p1[r], p1[r + 1]); rb = max3f(rb, p1[r + 2], p1[r + 3]); }
    rm = max3f(rm, rb, rb) + c;
    { auto rr = __builtin_amdgcn_permlane32_swap(__float_as_uint(rm), __float_as_uint(rm), false, false); rm = fmaxf(__uint_as_float(rr[0]), __uint_as_float(rr[1])); }
    if (__any(rm > ATT_THR)) {
        const float dl = fmaxf(rm, 0.f), f = __builtin_amdgcn_exp2f(-dl);
        c -= dl; lsum *= f;
#pragma unroll
        for (int d = 0; d < 4; ++d)
#pragma unroll
            for (int r = 0; r < 16; ++r) o[d][r] *= f;
    }
}
__device__ __forceinline__ u32x4 exp_pack2(const f32x16& p, int s, float c, float& lsum, float cks, const AW& aw) {
    float e[8];
#pragma unroll
    for (int j = 0; j < 8; ++j) e[j] = __builtin_amdgcn_exp2f(p[8 * s + j] + c);
    const float g0 = __builtin_fmaf(aw.b3, e[3], __builtin_fmaf(aw.b2, e[2], __builtin_fmaf(aw.b1, e[1], e[0])));
    const float g1 = __builtin_fmaf(aw.b3, e[7], __builtin_fmaf(aw.b2, e[6], __builtin_fmaf(aw.b1, e[5], e[4])));
    lsum = __builtin_fmaf(cks, __builtin_fmaf(aw.a8, g1, g0), lsum);
    u32x4 w; w.x = pg8::cvt_pk_bf16(e[0], e[1]); w.y = pg8::cvt_pk_bf16(e[2], e[3]); w.z = pg8::cvt_pk_bf16(e[4], e[5]); w.w = pg8::cvt_pk_bf16(e[6], e[7]);
    return w;
}
struct ESl { float g0, g1; };
__device__ __forceinline__ void exp_slice(ESl& x, u32x4& w, const f32x16& p, int s, int d, float c, const AW& aw) {
    const float a = __builtin_amdgcn_exp2f(p[8 * s + 2 * d] + c), b = __builtin_amdgcn_exp2f(p[8 * s + 2 * d + 1] + c);
    const unsigned pk = pg8::cvt_pk_bf16(a, b);
    if (d == 0) { w.x = pk; x.g0 = __builtin_fmaf(aw.b1, b, a); } else if (d == 1) { w.y = pk; x.g0 = __builtin_fmaf(aw.b3, b, __builtin_fmaf(aw.b2, a, x.g0)); }
    else if (d == 2) { w.z = pk; x.g1 = __builtin_fmaf(aw.b1, b, a); } else { w.w = pk; x.g1 = __builtin_fmaf(aw.b3, b, __builtin_fmaf(aw.b2, a, x.g1)); }
}
#define ATT_PIN1(v) asm volatile("" : "+v"(v))
__device__ __forceinline__ void pv_exp_step(f32x16 (&o)[4], const u32x4& pwk, bf16x8 (&buf)[8], int half, lptr vp, int vks, u32x4& wn, const f32x16& pnx, int s, float c, float& lsum, float cks, const AW& aw) {
    const bf16x8 pb = __builtin_bit_cast(bf16x8, pwk); ESl x;
#pragma unroll
    for (int d = 0; d < 4; ++d) {
        o[d] = __builtin_amdgcn_mfma_f32_32x32x16_bf16(buf[4 * half + d], pb, o[d], 0, 0, 0);
        exp_slice(x, wn, pnx, s, d, c, aw);
        if (vks >= 0) buf[4 * half + d] = vfrag(vp, vks, d);
        if (d == 3) lsum = __builtin_fmaf(cks, __builtin_fmaf(aw.a8, x.g1, x.g0), lsum);
        if (d == 0) ATT_PIN1(wn.x); else if (d == 1) ATT_PIN1(wn.y); else if (d == 2) ATT_PIN1(wn.z); else { ATT_PIN1(wn.w); ATT_PIN1(lsum); }
        ATT_SB();
    }
}
__device__ __forceinline__ void qk_exp_half(const bf16x8 (&kf)[8], const bf16x8 (&qr)[4], f32x16& p0, f32x16& p1, bool nxt, u32x4& wn, const f32x16& pcur, float c, float& lsum, const AW& aw) {
    ESl x;
#pragma unroll
    for (int d = 0; d < 4; ++d) {
        if (nxt) { if (d == 0) p0 = __builtin_amdgcn_mfma_f32_32x32x16_bf16(kf[4], qr[2], p0, 0, 0, 0); else if (d == 1) p1 = __builtin_amdgcn_mfma_f32_32x32x16_bf16(kf[5], qr[2], p1, 0, 0, 0);
                   else if (d == 2) p0 = __builtin_amdgcn_mfma_f32_32x32x16_bf16(kf[6], qr[3], p0, 0, 0, 0); else p1 = __builtin_amdgcn_mfma_f32_32x32x16_bf16(kf[7], qr[3], p1, 0, 0, 0); }
        exp_slice(x, wn, pcur, 0, d, c, aw);
        if (d == 3) lsum = __builtin_fmaf(1.f, __builtin_fmaf(aw.a8, x.g1, x.g0), lsum);
        if (d == 0) ATT_PIN1(wn.x); else if (d == 1) ATT_PIN1(wn.y); else if (d == 2) ATT_PIN1(wn.z); else { ATT_PIN1(wn.w); ATT_PIN1(lsum); }
        ATT_SB();
    }
}
template <int MODE> __device__ __forceinline__ void attn_unit(LAS unsigned char* lds, const bf16* PROJ, const bf16* KVP, bf16* AB, const float* gsub, float lam, int bh, int qb, float dq2, int tid, unsigned* aq_next = nullptr, LAS int* slot_next = nullptr) {
    const int lane = tid & 63, r32 = lane & 31, hi = lane >> 5, g = (lane >> 4) & 1, qq = (lane & 15) >> 2, pp = lane & 3;
    const int wid = __builtin_amdgcn_readfirstlane(tid >> 6), map = wid >> 2, qblk = wid & 3;
    const int b = bh >> 2, h = bh & 3, q0 = qb * 128;
    const size_t rowbase = (size_t)b * SEQ;
    const float sl2 = alibi_sl2(h);
    const unsigned lds0 = (unsigned)(uintptr_t)lds;
    const char* kvw = (const char*)(KVP + (size_t)bh * 128 * 16384) + wid * 1024;
    const unsigned lane16 = (unsigned)lane * 16u;
#define ATT_DMA_K(t, kslot) do { const char* _g = kvw + (size_t)(t) * 32768; const unsigned _k = lds0 + (kslot) * KSLOT + wid * 1024; \
        glds16s(_g, lane16, (unsigned)__builtin_amdgcn_readfirstlane(_k)); glds16s(_g + 8192, lane16, (unsigned)__builtin_amdgcn_readfirstlane(_k + L_K2)); } while (0)
#define ATT_DMA_V(t, vslot) do { const char* _g = kvw + (size_t)(t) * 32768 + 16384; const unsigned _v = lds0 + L_V + (vslot) * VSLOT + wid * 1024; \
        glds16s(_g, lane16, (unsigned)__builtin_amdgcn_readfirstlane(_v)); glds16s(_g + 8192, lane16, (unsigned)__builtin_amdgcn_readfirstlane(_v + 8192)); } while (0)
    const int NT = 2 * (qb + 1);
    int t0 = 0;
#if ATT_SKIP
    { const float dneed = (152.f + dq2) / sl2;
      const int tq = (int)__builtin_floorf(((float)q0 - dneed - 63.f) * (1.f / 64.f)) + 1;
      t0 = __builtin_amdgcn_readfirstlane(tq > 0 ? tq : 0); }
#endif
    ATT_DMA_K(t0, 0); ATT_DMA_V(t0, 0); ATT_DMA_K(t0 + 1, 1); ATT_DMA_V(t0 + 1, 1);
    if (t0 + 2 < NT) { ATT_DMA_K(t0 + 2, 2); ATT_DMA_V(t0 + 2, 2); }
    const bf16* Qw = PROJ + (rowbase + q0 + 32 * qblk + r32) * PP + (map ? C_Q2 : C_Q1) + h * HD;
    bf16x8 qr[4];
#pragma unroll
    for (int d0 = 0; d0 < 4; ++d0) qr[d0] = *(const bf16x8*)(Qw + d0 * 16 + hi * 8);
    auto uni = [](float x) { return __builtin_bit_cast(float, __builtin_amdgcn_readfirstlane(__builtin_bit_cast(int, x))); };
    const AW aw = {uni(__builtin_amdgcn_exp2f(sl2)), uni(__builtin_amdgcn_exp2f(2.f * sl2)), uni(__builtin_amdgcn_exp2f(3.f * sl2)), uni(__builtin_amdgcn_exp2f(8.f * sl2)),
                   uni(__builtin_amdgcn_exp2f(16.f * sl2)), uni(__builtin_amdgcn_exp2f(32.f * sl2)), uni(__builtin_amdgcn_exp2f(48.f * sl2))};
    const float whi = __builtin_amdgcn_exp2f(sl2 * (float)(4 * hi - 63));
    float lsum = 0.f;
    f32x16 o[4];
#pragma unroll
    for (int d = 0; d < 4; ++d) o[d] = f32x16{};
    float cinit = sl2 * 63.f;
    const float shift = 64.f * sl2;
    const int qrel = 32 * qblk + r32;
    const lptr ldsc = (lptr)lds;
    const lptr vp0 = ldsc + L_V + (4 * hi + qq) * 64 + (16 * g + 4 * pp) * 2;
    const lptr kp0 = ldsc + (map ? L_K2 : 0) + hi * 1024 + r32 * 16;
    u32x4 pw[4];
#pragma unroll
    for (int i = 0; i < 4; ++i) pw[i] = (u32x4){0u, 0u, 0u, 0u};
    bf16x8 hold[8], tmp[8];
    int sl_cur = 0;
    asm volatile("" : "+v"(qr[0]), "+v"(qr[1]), "+v"(qr[2]), "+v"(qr[3]));
    ATT_WAIT_BAR();
    f32x16 pA0, pA1, pB0, pB1;
    kload8(hold, kp0);
    qk_half(hold, qr, pA0, pA1, 0); qk_half(hold, qr, pA0, pA1, 1);
    auto step = [&](int t, f32x16& pc0, f32x16& pc1, f32x16& pn0, f32x16& pn1) __attribute__((always_inline)) {
        if (t > t0) { if (t + 2 < NT) ATT_WAIT_BAR4(); else ATT_WAIT_BAR(); }
        const bool nxt = (t + 1 < NT), band = (t >= NT - 2); const int kb = 64 * (t - (NT - 2)) + 4 * hi;
        const lptr vp = vp0 + sl_cur * VSLOT;
        if (nxt) kload4(hold, kp0 + ((sl_cur + 1) & 3) * KSLOT, 0);
        vload4(tmp, 0, vp, 0); vload4(tmp, 1, vp, 1);
        ATT_SB();
        if (nxt) qk_half(hold, qr, pn0, pn1, 0);
        if (nxt) kload4(hold, kp0 + ((sl_cur + 1) & 3) * KSLOT, 1);
        ATT_SB();
        softmax_head2(o, lsum, pc0, pc1, cinit, band, kb, qrel);
        ATT_SB();
        if (t + 3 < NT) { ATT_DMA_K(t + 3, (sl_cur + 3) & 3); ATT_DMA_V(t + 3, (sl_cur + 3) & 3); }
        ATT_SB();
        { u32x4 wa, wb;
        qk_exp_half(hold, qr, pn0, pn1, nxt, wa, pc0, cinit, lsum, aw);
        pv_exp_step(o, wa, tmp, 0, vp, 2, wb, pc0, 1, cinit, lsum, aw.c1, aw);
        pv_exp_step(o, wb, tmp, 1, vp, 3, wa, pc1, 0, cinit, lsum, aw.c2, aw);
        pv_exp_step(o, wa, tmp, 0, vp, -1, wb, pc1, 1, cinit, lsum, aw.c3, aw);
        pv_step(o, wb, tmp, 1); ATT_SB(); }
        cinit += shift;
        sl_cur = (sl_cur + 1) & 3;
    };
    for (int t = t0; t < NT; t += 2) { step(t, pA0, pA1, pB0, pB1); if (t + 1 < NT) step(t + 1, pB0, pB1, pA0, pA1); }
    float rl;
    { const float lw = lsum * whi; auto rr = __builtin_amdgcn_permlane32_swap(__float_as_uint(lw), __float_as_uint(lw), false, false); rl = __builtin_amdgcn_rcpf(__uint_as_float(rr[0]) + __uint_as_float(rr[1])); }
    ATT_WAIT_BAR();
    LAS f32x4* xch = (LAS f32x4*)(lds + qblk * 16384) + lane;
    if (map == 1) {
#pragma unroll
        for (int d = 0; d < 4; ++d)
#pragma unroll
            for (int g4 = 0; g4 < 4; ++g4) xch[(d * 4 + g4) * 64] = (f32x4){o[d][4 * g4] * rl, o[d][4 * g4 + 1] * rl, o[d][4 * g4 + 2] * rl, o[d][4 * g4 + 3] * rl};
    }
    ATT_WAIT_BAR();
    if (aq_next && tid == 256) *slot_next = (int)__hip_atomic_fetch_add(aq_next, 1u, __ATOMIC_RELAXED, __HIP_MEMORY_SCOPE_AGENT);
    if (map == 0) {
        float ss = 0.f;
#pragma unroll
        for (int d = 0; d < 4; ++d)
#pragma unroll
            for (int g4 = 0; g4 < 4; ++g4) { const f32x4 x2 = xch[(d * 4 + g4) * 64];
#pragma unroll
                for (int i = 0; i < 4; ++i) { const float a = o[d][4 * g4 + i] * rl - lam * x2[i]; o[d][4 * g4 + i] = a; ss += a * a; } }
        ss += __shfl_xor(ss, 32);
        const float rstd = rsqrtf(ss * (1.f / DV) + SUBLN_EPS) * (1.f - LAM_INIT);
        bf16* dst = AB + (rowbase + q0 + 32 * qblk + r32) * 512 + h * DV + 8 * hi;
#pragma unroll
        for (int d = 0; d < 4; ++d)
#pragma unroll
            for (int pq = 0; pq < 2; ++pq) { u32x2 w[2];
#pragma unroll
                for (int e = 0; e < 2; ++e) { const int gq = 2 * pq + e; const f32x4 gg = *(const LAS f32x4*)(lds + 132096 + (32 * d + 8 * gq + 4 * hi) * 4);
                    w[e].x = pg8::cvt_pk_bf16(o[d][4 * gq] * rstd * gg[0], o[d][4 * gq + 1] * rstd * gg[1]); w[e].y = pg8::cvt_pk_bf16(o[d][4 * gq + 2] * rstd * gg[2], o[d][4 * gq + 3] * rstd * gg[3]); }
                auto rx = __builtin_amdgcn_permlane32_swap(w[0].x, w[1].x, false, false); auto ry = __builtin_amdgcn_permlane32_swap(w[0].y, w[1].y, false, false);
                *(u32x4*)(dst + 32 * d + 16 * pq) = (u32x4){rx[0], ry[0], rx[1], ry[1]}; }
    }
    ATT_WAIT_BAR();
#undef ATT_DMA_K
#undef ATT_DMA_V
}
template <int MODE> __device__ __forceinline__ void attn_phase(LAS unsigned char* lds, const bf16* PROJ, const bf16* KVP, const unsigned* KN, bf16* AB, const float* gsub, const float* lq1, const float* lk1, const float* lq2, const float* lk2, int vcu, int G, int tid, unsigned* aq = nullptr) {
    const int lane = tid & 63;
    const float lam = __expf(wave_sum(lq1[lane] * lk1[lane])) - __expf(wave_sum(lq2[lane] * lk2[lane])) + LAM_INIT;
    auto bound = [&](int bh) { float dq2 = 0.f;
#pragma unroll
        for (int mp = 0; mp < 2; ++mp) { const float kn = __uint_as_float(__hip_atomic_load(KN + bh * 2 + mp, __ATOMIC_RELAXED, __HIP_MEMORY_SCOPE_AGENT)), qn = __uint_as_float(__hip_atomic_load(KN + 64 + bh * 2 + mp, __ATOMIC_RELAXED, __HIP_MEMORY_SCOPE_AGENT));
            dq2 = fmaxf(dq2, 2.f * __builtin_sqrtf(2.f * qn) * __builtin_sqrtf(2.f * kn) * 1.0001f); }
        return dq2; };
    if (tid < 32) ((LAS f32x4*)(lds + 132096))[tid] = ((const f32x4*)gsub)[tid];
    LAS int* slot = (LAS int*)(lds + 131072 + 768);
    for (int v = vcu; v < 256; v += G) {
        const int b = v >> 5, w = v & 31;
        const float bd0 = bound(b * 4), bd1 = bound(b * 4 + 1), bd2 = bound(b * 4 + 2), bd3 = bound(b * 4 + 3);
        for (int it = 0;; ++it) {
            int h, qb;
            if (aq) {
                if (it == 0) { if (tid == 0) *slot = (int)__hip_atomic_fetch_add(aq, 1u, __ATOMIC_RELAXED, __HIP_MEMORY_SCOPE_AGENT); __syncthreads(); }
                const int u = __builtin_amdgcn_readfirstlane(*slot);
                if (u >= 256) break;
                h = 3 - (u >> 6); qb = 63 - (u & 63);
            } else { if (it >= 8) break; h = (it & 1) ? 3 - (it >> 1) : (it >> 1); qb = (it & 4) ? 63 - w : w; }
            const int bh = b * 4 + h;
            attn_unit<MODE>(lds, PROJ, KVP, AB, gsub, lam, bh, qb, (h == 0) ? bd0 : (h == 1) ? bd1 : (h == 2) ? bd2 : bd3, tid, aq, slot);
        }
    }
}
}

constexpr int NWAVES = 8;
constexpr int RING_OFF = 0, RING_BYTES = 131072;
constexpr int LDSCTL_OFF = RING_BYTES, MISC_OFF = LDSCTL_OFF + 320;
constexpr int LDS_BYTES = 163840;
constexpr size_t CTL_ZERO_BYTES = 1 * MiB;
constexpr int CW_BAR = 4096;
constexpr int CW_AQ = 2048;
constexpr int CW_MIS = 1024;
constexpr int CW_KN = 32768;
constexpr int N_PHASES = 10;
constexpr int HALO_OFF = RING_BYTES + 1024;
constexpr int MAX_LAUNCH = 4;
static_assert((CW_BAR + MAX_LAUNCH * XCD_BAR_WORDS) * 4 <= (int)CTL_ZERO_BYTES, "barrier words inside the memset region");
static_assert(HALO_OFF + 2048 + 2 * 4096 + 16384 + 4096 <= LDS_BYTES, "halo + conv weight tables + rstd partials + boundary rows inside the LDS allocation");

struct Frame {
    LAS unsigned char* lds; volatile LAS unsigned* MISC; gu32* ctl;
    int tid, lane, wave, vcu, G;
};

__device__ __forceinline__ void p0_transpose_item(const float* W, int K, int N, bf16* WT, const float* rs, int mode, LAS float* scr, int item, int lane) {
    const int nblk = N / 32, kb = item / nblk, nb = item % nblk, k0 = 64 * kb, n0 = 32 * nb, s0 = wt_src_col(n0, mode);
#pragma unroll
    for (int i = 0; i < 8; ++i) { const int kk = 8 * i + (lane >> 3), c4 = (lane & 7) * 4; const float s = rs ? rs[k0 + kk] : 1.f;
        const f32x4 v = __builtin_nontemporal_load((const f32x4*)(W + (size_t)(k0 + kk) * N + s0 + c4)) * s; LAS float* d = scr + kk * 33 + c4; d[0] = v.x; d[1] = v.y; d[2] = v.z; d[3] = v.w; }
    LDS_WAIT(); asm volatile("" ::: "memory");
    const int c = lane & 7;
#pragma unroll
    for (int j = 0; j < 4; ++j) { const int n = (lane >> 3) + 8 * j; const LAS float* s = scr + (8 * c) * 33 + n;
        u32x4 o; o.x = pk2(s[0 * 33], s[1 * 33]); o.y = pk2(s[2 * 33], s[3 * 33]); o.z = pk2(s[4 * 33], s[5 * 33]); o.w = pk2(s[6 * 33], s[7 * 33]);
        *(u32x4*)(WT + (size_t)(n0 + n) * K + k0 + 8 * c) = o; }
    LDS_WAIT(); asm volatile("" ::: "memory");
}
__device__ __forceinline__ void rms_row_to_bf16(const float* xrow, const float* g, bf16* orow, int lane) {
    const f32x4* xr = (const f32x4*)xrow + lane; f32x4 v[4]; float s = 0.f;
#pragma unroll
    for (int j = 0; j < 4; ++j) { v[j] = xr[64 * j]; s += (v[j].x * v[j].x + v[j].y * v[j].y) + (v[j].z * v[j].z + v[j].w * v[j].w); }
    const float rstd = rsqrtf(wave_sum(s) * (1.f / DM) + NORM_EPS);
    u32x2* o = (u32x2*)orow + lane;
#pragma unroll
    for (int j = 0; j < 4; ++j) { const f32x4 gg = ((const f32x4*)g)[lane + 64 * j];
        u32x2 w; w.x = pk2(v[j].x * rstd * gg.x, v[j].y * rstd * gg.y); w.y = pk2(v[j].z * rstd * gg.z, v[j].w * rstd * gg.w); o[64 * j] = w; }
}

struct Args { const float* in[17]; float* out; unsigned char* ws; int ph_lo, ph_hi, li, opt; };

__global__ void __launch_bounds__(NWAVES * 64, 2) mk_fwd(Args args) {
    extern __shared__ __attribute__((aligned(16))) unsigned char lds[];
    Frame F;
    F.lds = (LAS unsigned char*)lds; F.MISC = (volatile LAS unsigned*)(F.lds + MISC_OFF);
    F.tid = threadIdx.x; F.lane = F.tid & 63; F.wave = __builtin_amdgcn_readfirstlane(F.tid >> 6);
    F.G = gridDim.x; { const int bx = blockIdx.x; F.vcu = (F.G % 8 == 0) ? (bx % 8) * (F.G / 8) + bx / 8 : bx; }
    unsigned char* ws = args.ws;
    F.ctl = (gu32*)(ws + WS_CTL);
    const float* x = args.in[0]; const float* g_mix = args.in[1]; const float* w_in = args.in[2];
    const float* w_dp = args.in[8]; const float* w_rp = args.in[9]; const float* w_out = args.in[10];
    const float* g_ffn = args.in[11]; const float* w_up = args.in[12]; const float* conv_w = args.in[13]; const float* conv_b = args.in[14];
    const float* w_down = args.in[15]; const float* g_final = args.in[16];
    float* out = args.out;
    bf16* WIN = (bf16*)(ws + WS_WIN); bf16* WD = (bf16*)(ws + WS_WD); bf16* WR = (bf16*)(ws + WS_WR); bf16* WO = (bf16*)(ws + WS_WO); bf16* WUP = (bf16*)(ws + WS_WUP); bf16* WDN = (bf16*)(ws + WS_WDN);
    bf16* XN = (bf16*)(ws + WS_XN); bf16* PROJ = (bf16*)(ws + WS_PROJ); bf16* AB = (bf16*)(ws + WS_A); bf16* RB = (bf16*)(ws + WS_R);
    bf16* X1B = (bf16*)(ws + WS_X1B); bf16* GB = (bf16*)(ws + WS_G); bf16* UB = (bf16*)(ws + WS_U); float* SSQ1 = (float*)(ws + WS_SSQ1);
    bf16* KVP = (bf16*)(ws + WS_KVP); bf16* MG = XN; bf16* X2B = XN; float* SSQ2 = (float*)(ws + WS_SSQ2); float* GST = (float*)(ws + WS_GST); float* HB = (float*)(ws + WS_HB);
    for (int u = F.tid; u < (LDS_BYTES - LDSCTL_OFF) / 4; u += NWAVES * 64) ((LAS unsigned*)(F.lds + LDSCTL_OFF))[u] = 0u;
    __syncthreads();
    XcdBarrier bar = xcd_barrier_post((unsigned*)(F.ctl + CW_BAR) + args.li * XCD_BAR_WORDS, F.MISC + 8, F.wave);
    const int lo = args.ph_lo, hi = args.ph_hi;
    if (F.tid == 0 && (bar.x != (blockIdx.x & 7u) || F.G != 256)) atomicOr((unsigned*)(F.ctl + CW_MIS + 64 * args.li), 1u);
    bool local_ok = false;
#define IN(k) (lo <= (k) && (k) < hi)
#define SEAM(k) do { if (IN(k) && IN((k) + 1)) { if (local_ok && (k) != 0 && (k) != 4) xcd_barrier_local(bar); else xcd_barrier(bar); } } while (0)

    if (IN(0)) {
        LAS float* scr = (LAS float*)(F.lds + RING_OFF + F.wave * 16384);
        const int gw = F.vcu * NWAVES + F.wave, NGW = F.G * NWAVES;
        constexpr int I_IN = (DM / 64) * (DIN / 32), I_D = (512 / 64) * (DM / 32), I_O = (DM / 64) * (DM / 32), I_UP = (DM / 64) * (FF2 / 32), I_DN = (FF / 64) * (DM / 32);
        constexpr int NITEMS = I_IN + 2 * I_D + I_O + I_UP + I_DN;
        for (int it = gw; it < NITEMS; it += NGW) {
            int r = it;
            if (r < I_IN) { p0_transpose_item(w_in, DM, DIN, WIN, nullptr, 0, scr, r, F.lane); continue; } r -= I_IN;
            if (r < I_D) { p0_transpose_item(w_dp, 512, DM, WD, nullptr, 0, scr, r, F.lane); continue; } r -= I_D;
            if (r < I_D) { p0_transpose_item(w_rp, 512, DM, WR, nullptr, 0, scr, r, F.lane); continue; } r -= I_D;
            if (r < I_O) { p0_transpose_item(w_out, DM, DM, WO, nullptr, 0, scr, r, F.lane); continue; } r -= I_O;
            if (r < I_UP) { p0_transpose_item(w_up, DM, FF2, WUP, g_ffn, 1, scr, r, F.lane); continue; } r -= I_UP;
            p0_transpose_item(w_down, FF, DM, WDN, nullptr, 0, scr, r, F.lane);
        }
        { float* cs = (float*)(ws + WS_CONV);
          for (int i = (int)blockIdx.x * (NWAVES * 64) + F.tid; i < 4 * FF2; i += F.G * (NWAVES * 64)) { const int row = i / FF2, c = i % FF2;
              cs[i] = ((row < 3) ? conv_w[i] : conv_b[c]) * ((c < FF) ? -LOG2E : -1.f / LOG2E); } }
        for (int m = gw; m < M; m += 4 * NGW) {
            f32x4 v[4][4]; int mr[4];
#pragma unroll
            for (int r = 0; r < 4; ++r) { mr[r] = (m + r * NGW < M) ? m + r * NGW : m; const f32x4* xr = (const f32x4*)(x + (size_t)mr[r] * DM) + 2 * F.lane;
#pragma unroll
                for (int j = 0; j < 2; ++j) { v[r][2 * j] = __builtin_nontemporal_load(xr + 128 * j); v[r][2 * j + 1] = __builtin_nontemporal_load(xr + 128 * j + 1); } }
            float rs_[4];
#pragma unroll
            for (int r = 0; r < 4; ++r) { float q = 0.f;
#pragma unroll
                for (int j = 0; j < 4; ++j) q += (v[r][j].x * v[r][j].x + v[r][j].y * v[r][j].y) + (v[r][j].z * v[r][j].z + v[r][j].w * v[r][j].w);
                rs_[r] = rsqrtf(wave_sum(q) * (1.f / DM) + NORM_EPS); }
#pragma unroll
            for (int j = 0; j < 2; ++j) { const f32x4 g0 = ((const f32x4*)g_mix)[2 * F.lane + 128 * j], g1 = ((const f32x4*)g_mix)[2 * F.lane + 128 * j + 1];
#pragma unroll
                for (int r = 0; r < 4; ++r) { const float ra = rs_[r]; u32x4 w;
                    w.x = pk2(v[r][2 * j].x * ra * g0.x, v[r][2 * j].y * ra * g0.y); w.y = pk2(v[r][2 * j].z * ra * g0.z, v[r][2 * j].w * ra * g0.w);
                    w.z = pk2(v[r][2 * j + 1].x * ra * g1.x, v[r][2 * j + 1].y * ra * g1.y); w.w = pk2(v[r][2 * j + 1].z * ra * g1.z, v[r][2 * j + 1].w * ra * g1.w);
                    ((u32x4*)(XN + (size_t)mr[r] * DM) + F.lane)[64 * j] = w; } }
        }
    }
    SEAM(0);
    if (lo == 0 && hi > 1) local_ok = __builtin_amdgcn_readfirstlane((int)xb_ld((unsigned*)(F.ctl + CW_MIS + 64 * args.li))) == 0;
    if (IN(1)) {
        pg8::Gemm g{XN, WIN, M, DIN, DM}; pg8::StaticOrder S; S.init(M, DIN, F.G, (int)blockIdx.x);
        pg8::EpiProj E{PROJ, KVP, (unsigned*)(F.ctl + CW_KN)};
        pg8::gemm_phase<pg8::EpiProj, pg8::StaticOrder, true, true>(F.lds + RING_OFF, g, S, E, F.wave);
    }
    SEAM(1);
    if (IN(2)) { if (!(args.opt & 1)) for (int ui = F.vcu; ui < 256; ui += F.G) ret::ret_group_state(F.lds + RING_OFF, PROJ, GST, ui, F.tid); }
    SEAM(2);
    if (IN(3)) { const int tidL = F.wave * 64 + lane_now();
        if (!(args.opt & 1)) for (int ui = F.vcu; ui < 256; ui += F.G) ret::ret_outputs(F.lds + RING_OFF, PROJ, GST, RB, ui ^ 7, tidL);
        if (!(args.opt & 2)) attn::attn_phase<0>(F.lds + RING_OFF, PROJ, KVP, (const unsigned*)(F.ctl + CW_KN), AB, args.in[7], args.in[3], args.in[4], args.in[5], args.in[6], F.vcu, F.G, tidL, (F.G == 256) ? (unsigned*)(F.ctl + CW_AQ + 64 * (8 * args.li + (int)(blockIdx.x & 7))) : nullptr);
#ifdef PROBE_MODE
        if (args.opt & 4) attn::attn_phase<PROBE_MODE>(F.lds + RING_OFF, PROJ, KVP, (const unsigned*)(F.ctl + CW_KN), XN, args.in[7], args.in[3], args.in[4], args.in[5], args.in[6], F.vcu, F.G, tidL);
#endif
    }
    SEAM(3);
    if (IN(4)) {
        pg8::Gemm g{AB, WD, M, DM, 512, RB, WR}; pg8::DualOrder S; S.init(M, DM, F.G, (int)blockIdx.x);
        pg8::EpiMerge2 E{PROJ, MG};
        pg8::gemm_phase<pg8::EpiMerge2, pg8::DualOrder, true, true>(F.lds + RING_OFF, g, S, E, F.wave);
    }
    SEAM(4);
    if (IN(5)) {
        pg8::Gemm g{MG, WO, M, DM, DM}; pg8::StaticOrder S; S.init(M, DM, F.G, (int)blockIdx.x);
        pg8::EpiOutProj E{x, X1B, SSQ1};
        pg8::gemm_phase<pg8::EpiOutProj, pg8::StaticOrder, true, true>(F.lds + RING_OFF, g, S, E, F.wave);
    }
    SEAM(5);
    if (IN(6)) {
        pg8::Gemm g{X1B, WUP, M, FF2, DM}; pg8::StaticOrder S; S.init(M, FF2, F.G, (int)blockIdx.x);
        pg8::EpiUpConv E{SSQ1, GB, HB, (const float*)(ws + WS_CONV), (const float*)(ws + WS_CONV) + 3 * FF2, (LAS float*)(F.lds + HALO_OFF)};
        pg8::gemm_phase<pg8::EpiUpConv, pg8::StaticOrder, true, true>(F.lds + RING_OFF, g, S, E, F.wave);
    }
    SEAM(6);
    if (IN(7)) {
        const bool gp = (F.G == 256);
        const int nw = gp ? 32 : F.G, w = gp ? (int)(blockIdx.x >> 3) : (int)blockIdx.x, pm0 = gp ? (int)(blockIdx.x & 7) * 32 : 0, npm = gp ? 32 : M / 256;
        const int nit = npm * (FF / 4);
        const int tidL = F.wave * 64 + lane_now();
        for (int it = w * (NWAVES * 64) + tidL; it < nit; it += nw * (NWAVES * 64)) {
            const int pm = pm0 + it / (FF / 4), gc = (it % (FF / 4)) * 4;
            if ((pm & 31) == 0) continue;
            const int uc = (gc >> 7) * 256 + (gc & 127);
            const float* h0 = HB + (size_t)(pm - 1) * 4 * FF2, * h1 = HB + (size_t)pm * 4 * FF2;
            const f32x4 gm2 = *(const f32x4*)(h0 + 2 * FF2 + uc), gm1 = *(const f32x4*)(h0 + 3 * FF2 + uc), g0 = *(const f32x4*)(h1 + uc), g1 = *(const f32x4*)(h1 + FF2 + uc);
            const f32x4 um2 = *(const f32x4*)(h0 + 2 * FF2 + uc + 128), um1 = *(const f32x4*)(h0 + 3 * FF2 + uc + 128), u0 = *(const f32x4*)(h1 + uc + 128), u1 = *(const f32x4*)(h1 + FF2 + uc + 128);
            f32x4 wg[3], wu[3];
            const float* cs = (const float*)(ws + WS_CONV);
#pragma unroll
            for (int k = 0; k < 3; ++k) { wg[k] = *(const f32x4*)(cs + k * FF2 + gc); wu[k] = *(const f32x4*)(cs + k * FF2 + FF + gc); }
            const f32x4 bg = *(const f32x4*)(cs + 3 * FF2 + gc), bu = *(const f32x4*)(cs + 3 * FF2 + FF + gc);
            const f32x4 zg0 = bg + wg[2] * g0 + wg[1] * gm1 + wg[0] * gm2, zu0 = bu + wu[2] * u0 + wu[1] * um1 + wu[0] * um2;
            const f32x4 zg1 = bg + wg[2] * g1 + wg[1] * g0 + wg[0] * gm1, zu1 = bu + wu[2] * u1 + wu[1] * u0 + wu[0] * um1;
            f32x4 r0, r1;
#pragma unroll
            for (int i = 0; i < 4; ++i) { r0[i] = (zg0[i] * zu0[i]) * __builtin_amdgcn_rcpf(1.f + __builtin_amdgcn_exp2f(zg0[i])); r1[i] = (zg1[i] * zu1[i]) * __builtin_amdgcn_rcpf(1.f + __builtin_amdgcn_exp2f(zg1[i])); }
            u32x2 w0, w1; w0.x = pg8::cvt_pk_bf16(r0[0], r0[1]); w0.y = pg8::cvt_pk_bf16(r0[2], r0[3]); w1.x = pg8::cvt_pk_bf16(r1[0], r1[1]); w1.y = pg8::cvt_pk_bf16(r1[2], r1[3]);
            *(u32x2*)(GB + (size_t)pm * 256 * FF + gc) = w0; *(u32x2*)(GB + ((size_t)pm * 256 + 1) * FF + gc) = w1;
        }
    }
    SEAM(7);
    if (IN(8)) {
        pg8::Gemm g{GB, WDN, M, DM, FF}; pg8::StaticOrder S; S.init(M, DM, F.G, (int)blockIdx.x);
        pg8::EpiDown E{X1B, X2B, SSQ2};
        pg8::gemm_phase<pg8::EpiDown, pg8::StaticOrder, true, true>(F.lds + RING_OFF, g, S, E, F.wave);
    }
    SEAM(8);
    if (IN(9)) {
        const int laneL = lane_now();
        const bool gp = (F.G == 256);
        const int gw = (gp ? (int)(blockIdx.x >> 3) : F.vcu) * NWAVES + F.wave, NGW = (gp ? 32 : F.G) * NWAVES, m0 = gp ? (int)(blockIdx.x & 7) * 8192 : 0, nm = gp ? 8192 : M;
        for (int mm = gw; mm < nm; mm += 4 * NGW) {
            u32x4 xv[4][2];
#pragma unroll
            for (int r = 0; r < 4; ++r) { const int m = m0 + ((mm + r * NGW < nm) ? mm + r * NGW : mm); const u32x4* xr = (const u32x4*)(X2B + (size_t)m * DM) + laneL;
                xv[r][0] = __builtin_nontemporal_load(xr); xv[r][1] = __builtin_nontemporal_load(xr + 64); }
            float q4; { const int rr = laneL >> 4, mr = m0 + ((mm + rr * NGW < nm) ? mm + rr * NGW : mm); q4 = SSQ2[(size_t)mr * 16 + (laneL & 15)]; }
            q4 += __shfl_xor(q4, 1); q4 += __shfl_xor(q4, 2); q4 += __shfl_xor(q4, 4); q4 += __shfl_xor(q4, 8);
#pragma unroll
            for (int r = 0; r < 4; ++r) { const int m = m0 + ((mm + r * NGW < nm) ? mm + r * NGW : mm);
                const float rstd = rsqrtf(__shfl(q4, 16 * r) * (1.f / DM) + NORM_EPS);
                f32x4* orow = (f32x4*)(out + (size_t)m * DM) + 2 * laneL;
#pragma unroll
                for (int j = 0; j < 2; ++j) { f32x4 a, b; pg8::unpack8(xv[r][j], a, b);
                    const f32x4 g0 = ((const f32x4*)g_final)[2 * laneL + 128 * j], g1 = ((const f32x4*)g_final)[2 * laneL + 128 * j + 1];
                    __builtin_nontemporal_store(a * rstd * g0, orow + 128 * j); __builtin_nontemporal_store(b * rstd * g1, orow + 128 * j + 1); } }
        }
    }
#undef IN
#undef SEAM
}

static void launch_mk(Args a, int lo, int hi, int li, int grid, hipStream_t stream, int opt = 0) {
    a.ph_lo = lo; a.ph_hi = hi; a.li = li; a.opt = opt;
    hipLaunchKernelGGL(mk_fwd, dim3(grid), dim3(NWAVES * 64), LDS_BYTES, stream, a);
}
extern "C" void kernel_launch(void* const* d_in, const int* in_sizes, int n_in, void* d_out, int out_size, void* d_ws, size_t ws_size, hipStream_t stream) {
    static int grid = 0;
    if (grid == 0) {
        if (n_in != 17 || out_size != M * DM || ws_size < WS_END) { fprintf(stderr, "kernel_launch: unexpected shapes (n_in %d out %d ws %zu)\n", n_in, out_size, ws_size); grid = -1; return; }
        int dev = 0, cus = 0, per_cu = 0;
        if (hipGetDevice(&dev) != hipSuccess || hipDeviceGetAttribute(&cus, hipDeviceAttributeMultiprocessorCount, dev) != hipSuccess) { grid = -1; return; }
        if (hipFuncSetAttribute((const void*)mk_fwd, hipFuncAttributeMaxDynamicSharedMemorySize, LDS_BYTES) != hipSuccess) { fprintf(stderr, "kernel_launch: hipFuncSetAttribute failed\n"); grid = -1; return; }
        if (hipOccupancyMaxActiveBlocksPerMultiprocessor(&per_cu, (const void*)mk_fwd, NWAVES * 64, LDS_BYTES) != hipSuccess || per_cu < 1) { fprintf(stderr, "kernel_launch: occupancy query says %d\n", per_cu); }
        (void)hipGetLastError();
        grid = cus;
    }
    if (grid < 0) return;
    if (hipMemsetAsync((char*)d_ws + WS_CTL, 0, CTL_ZERO_BYTES, stream) != hipSuccess) return;
    unsigned char* ws = (unsigned char*)d_ws;
    Args a{};
    for (int i = 0; i < 17; ++i) a.in[i] = (const float*)d_in[i];
    a.out = (float*)d_out; a.ws = ws;
    launch_mk(a, 0, N_PHASES, 0, grid, stream);
}
```
